# Optimizing an MI355X kernel written in HIP

```python
import jax
import jax.numpy as jnp
from jax import lax

D_MODEL = 1024
BATCH = 16
SEQ = 2048
DEPTH = 1

GRID_W = 64
CTX_LEN = 256
EPS = 1e-6
NEG_INF = -1e30

NA_HEADS = 8
NA_HEAD_DIM = 64
NA_WIDTH = NA_HEADS * NA_HEAD_DIM
NA_WIN_ROWS = 8
NA_WIN_COLS = 16
ROPE_THETA = 10000.0

LRU_WIDTH = D_MODEL
LRU_BLOCKS = 8
LRU_BLOCK = LRU_WIDTH // LRU_BLOCKS
LRU_CONV = 4
LRU_C = 8.0

N_GROUPS = 4
EXPERTS_PER_GROUP = 8
N_EXPERTS = N_GROUPS * EXPERTS_PER_GROUP
TOP_K = 2
D_EXPERT = 512
MOE_BLOCK = 256

K_OFF = 0
V_OFF = K_OFF + NA_WIDTH
LX_OFF = V_OFF + NA_WIDTH
CTX_COLS = LX_OFF + LRU_WIDTH
Q_OFF = CTX_COLS
LG_OFF = Q_OFF + NA_WIDTH
GA_OFF = LG_OFF + LRU_WIDTH
GB_OFF = GA_OFF + D_MODEL
PROJ_COLS = GB_OFF + D_MODEL

kernel_name = 'hybrid_natten_rglru_hmoe_dit_block'


def _rms(x):
    x32 = x.astype(jnp.float32)
    return x32 * lax.rsqrt(jnp.mean(x32 * x32, axis=-1, keepdims=True) + EPS)


def ada_rmsnorm(x, gain, shift, scale):
    n = _rms(x) * gain.astype(jnp.float32)
    return (n * (1.0 + scale.astype(jnp.float32)) + shift.astype(jnp.float32)).astype(x.dtype)


def axial_rope(x, row_pos, col_pos):
    hd = x.shape[-1]
    half = hd // 2
    nf = half // 2
    inv_freq = ROPE_THETA ** (-jnp.arange(nf, dtype=jnp.float32) / nf)

    def rot(xp, pos):
        ang = pos[:, None] * inv_freq
        cos = jnp.cos(ang)[:, None, :]
        sin = jnp.sin(ang)[:, None, :]
        x1, x2 = xp[..., :nf], xp[..., nf:]
        return jnp.concatenate([x1 * cos - x2 * sin, x1 * sin + x2 * cos], axis=-1)

    x32 = x.astype(jnp.float32)
    out = jnp.concatenate([rot(x32[..., :half], row_pos), rot(x32[..., half:], col_pos)], axis=-1)
    return out.astype(x.dtype)


def neighbourhood_attention(q, k, v, k_ctx, v_ctx, rpb):
    bsz, length, n_heads, hd = q.shape
    rows = length // GRID_W
    kr = min(NA_WIN_ROWS, rows)
    t = jnp.arange(length)
    row_pos = (t // GRID_W).astype(jnp.float32)
    col_pos = (t % GRID_W).astype(jnp.float32)
    scale = hd ** -0.5
    grid = (bsz, rows, GRID_W, n_heads, hd)
    q_plain = q.reshape(grid)
    q_rot = axial_rope(q, row_pos, col_pos).reshape(grid)
    k_rot = axial_rope(k, row_pos, col_pos).reshape(grid)
    v_g = v.reshape(grid)
    r = jnp.arange(rows)
    r_start = jnp.clip(r - kr // 2, 0, rows - kr)
    r_win = r_start[:, None] + jnp.arange(kr)[None, :]
    n_win = kr * GRID_W
    k_win = k_rot[:, r_win].reshape(bsz, rows, n_win, n_heads, hd)
    v_win = v_g[:, r_win].reshape(bsz, rows, n_win, n_heads, hd)
    cq = jnp.arange(GRID_W)
    c_start = jnp.clip(cq - NA_WIN_COLS // 2, 0, GRID_W - NA_WIN_COLS)
    band = (cq[None, :] >= c_start[:, None]) & (cq[None, :] < c_start[:, None] + NA_WIN_COLS)
    mask = jnp.broadcast_to(band[:, None, :], (GRID_W, kr, GRID_W)).reshape(GRID_W, n_win)
    dr = r_win - r[:, None] + (NA_WIN_ROWS - 1)
    dc = jnp.clip(cq[None, :] - cq[:, None], 1 - NA_WIN_COLS, NA_WIN_COLS - 1) + (NA_WIN_COLS - 1)
    bias = rpb.astype(jnp.float32)[:, dr][..., dc]
    bias = bias.transpose(0, 1, 3, 2, 4).reshape(n_heads, rows, GRID_W, n_win)
    s_lat = jnp.einsum('brqhd,brjhd->bhrqj', q_rot, k_win).astype(jnp.float32) * scale + bias[None]
    s_lat = jnp.where(mask, s_lat, NEG_INF)
    s_ctx = jnp.einsum('brqhd,bchd->bhrqc', q_plain, k_ctx).astype(jnp.float32) * scale
    p = jax.nn.softmax(jnp.concatenate([s_lat, s_ctx], axis=-1), axis=-1).astype(v.dtype)
    o = (jnp.einsum('bhrqj,brjhd->brqhd', p[..., :n_win], v_win)
         + jnp.einsum('bhrqc,bchd->brqhd', p[..., n_win:], v_ctx))
    return o.reshape(bsz, length, n_heads * hd)


def context_attention(q, k, v):
    bsz, n_ctx, n_heads, hd = q.shape
    s = jnp.einsum('bqhd,bkhd->bhqk', q, k).astype(jnp.float32) * (hd ** -0.5)
    p = jax.nn.softmax(s, axis=-1).astype(v.dtype)
    return jnp.einsum('bhqk,bkhd->bqhd', p, v).reshape(bsz, n_ctx, n_heads * hd)


def short_conv(x, w, b):
    n_ch = x.shape[-1]
    pad_l = LRU_CONV // 2
    y = lax.conv_general_dilated(x, w[:, None, :], window_strides=(1,),
                                 padding=[(pad_l, LRU_CONV - 1 - pad_l)],
                                 dimension_numbers=('NWC', 'WIO', 'NWC'),
                                 feature_group_count=n_ch)
    return y + b


def _scan_combine(left, right):
    a1, b1 = left
    a2, b2 = right
    return a1 * a2, a2 * b1 + b2


def lru_direction(xc, h0, wa, ba, wx, bx, lam, reverse):
    bsz, length, n_ch = xc.shape
    xb = xc.reshape(bsz, length, LRU_BLOCKS, LRU_BLOCK)
    r = jax.nn.sigmoid(jnp.einsum('blnc,ncd->blnd', xb, wa).reshape(bsz, length, n_ch) + ba)
    i = jax.nn.sigmoid(jnp.einsum('blnc,ncd->blnd', xb, wx).reshape(bsz, length, n_ch) + bx)
    log_a = -LRU_C * r.astype(jnp.float32) * jax.nn.softplus(-lam.astype(jnp.float32))
    a = jnp.exp(log_a)
    u = jnp.sqrt(-jnp.expm1(2.0 * log_a)) * (i * xc).astype(jnp.float32)
    a_cum, h = lax.associative_scan(_scan_combine, (a, u), axis=1, reverse=reverse)
    if h0 is not None:
        h = h + a_cum * h0[:, None, :]
    return h


def branch_merge(proj, o_att, o_lru, w_up_attn, w_up_lru, w_out):
    g_a = jax.nn.sigmoid(proj[..., GA_OFF:GA_OFF + D_MODEL])
    g_b = jax.nn.sigmoid(proj[..., GB_OFF:GB_OFF + D_MODEL])
    y = g_a * (o_att @ w_up_attn) + g_b * (o_lru @ w_up_lru)
    return y @ w_out


def hier_moe(h, wg, bg, we, be, w1, w3, w2):
    n_tok, d = h.shape
    h32 = h.astype(jnp.float32)
    p_grp = jax.nn.softmax(h32 @ wg.astype(jnp.float32) + bg.astype(jnp.float32), axis=-1)
    p_top, g_idx = lax.top_k(p_grp, 1)
    le = (h32 @ we.astype(jnp.float32) + be.astype(jnp.float32)).reshape(n_tok, N_GROUPS, EXPERTS_PER_GROUP)
    le_sel = le[jnp.arange(n_tok), g_idx[:, 0]]
    ev, e_idx = lax.top_k(le_sel, TOP_K)
    gate = p_top * jax.nn.softmax(ev, axis=-1)
    eid = g_idx * EXPERTS_PER_GROUP + e_idx
    n_asg = n_tok * TOP_K
    flat_e = eid.reshape(n_asg)
    flat_tok = jnp.repeat(jnp.arange(n_tok), TOP_K)
    flat_w = gate.reshape(n_asg)
    order = jnp.argsort(flat_e)
    e_s, tok_s, w_s = flat_e[order], flat_tok[order], flat_w[order]
    counts = jnp.bincount(flat_e, length=N_EXPERTS)
    starts = jnp.cumsum(counts) - counts
    padded = (counts + MOE_BLOCK - 1) // MOE_BLOCK * MOE_BLOCK
    p_ends = jnp.cumsum(padded)
    p_starts = p_ends - padded
    dest = p_starts[e_s] + (jnp.arange(n_asg) - starts[e_s])
    n_blk = -(-(n_asg + N_EXPERTS * (MOE_BLOCK - 1)) // MOE_BLOCK)
    buf_tok = jnp.full((n_blk * MOE_BLOCK,), n_tok, dtype=jnp.int32).at[dest].set(tok_s)
    buf_w = jnp.zeros((n_blk * MOE_BLOCK,), jnp.float32).at[dest].set(w_s)
    blk_e = jnp.minimum(jnp.searchsorted(p_ends, jnp.arange(n_blk) * MOE_BLOCK, side='right'), N_EXPERTS - 1)
    h_pad = jnp.concatenate([h, jnp.zeros((1, d), h.dtype)], axis=0)
    xb = h_pad[buf_tok].reshape(n_blk, MOE_BLOCK, d)

    def expert_block(args):
        xblk, e = args
        return (jax.nn.silu(xblk @ w1[e]) * (xblk @ w3[e])) @ w2[e]

    yb = lax.map(expert_block, (xb, blk_e)).reshape(n_blk * MOE_BLOCK, d)
    out = jnp.zeros((n_tok + 1, d), jnp.float32).at[buf_tok].add(yb.astype(jnp.float32) * buf_w[:, None])
    return out[:n_tok].astype(h.dtype)


def hybrid_layer(x, ctx, c, c_ctx, w_mod, b_mod, g_mix, g_ffn, w_in, rpb, conv_w, conv_b,
                 lru_wa, lru_ba, lru_wx, lru_bx, lru_lambda, w_up_attn, w_up_lru, w_out,
                 wg, bg, we, be, w1, w3, w2, last):
    bsz, length, d = x.shape
    n_ctx = ctx.shape[1]
    mod = (jax.nn.silu(c) @ w_mod + b_mod)[:, None, :]
    sh1, sc1, ga1, sh2, sc2, ga2 = jnp.split(mod, 6, axis=-1)
    n_cm = 2 if last else 6
    mod_c = jnp.split(jax.nn.silu(c_ctx) @ w_mod[:, :n_cm * d] + b_mod[:n_cm * d], n_cm)

    h = ada_rmsnorm(x, g_mix, sh1, sc1)
    hc = ada_rmsnorm(ctx, g_mix, mod_c[0], mod_c[1])
    proj = h @ w_in
    proj_c = hc @ (w_in[:, :CTX_COLS] if last else w_in)

    def heads(t):
        return t.reshape(t.shape[0], t.shape[1], NA_HEADS, NA_HEAD_DIM)

    q = heads(proj[..., Q_OFF:Q_OFF + NA_WIDTH])
    k = heads(proj[..., K_OFF:K_OFF + NA_WIDTH])
    v = heads(proj[..., V_OFF:V_OFF + NA_WIDTH])
    k_c = heads(proj_c[..., K_OFF:K_OFF + NA_WIDTH])
    v_c = heads(proj_c[..., V_OFF:V_OFF + NA_WIDTH])
    o_att = neighbourhood_attention(q, k, v, k_c, v_c, rpb)

    x_l = short_conv(proj[..., LX_OFF:LX_OFF + LRU_WIDTH], conv_w, conv_b)
    x_c = short_conv(proj_c[..., LX_OFF:LX_OFF + LRU_WIDTH], conv_w, conv_b)
    fwd = (lru_wa[0], lru_ba[0], lru_wx[0], lru_bx[0], lru_lambda[0])
    bwd = (lru_wa[1], lru_ba[1], lru_wx[1], lru_bx[1], lru_lambda[1])
    hc_f = lru_direction(x_c, None, *fwd, reverse=False)
    hc_b = lru_direction(x_c, None, *bwd, reverse=True)
    h_f = lru_direction(x_l, hc_f[:, -1], *fwd, reverse=False)
    h_b = lru_direction(x_l, hc_b[:, 0], *bwd, reverse=True)
    o_lru = ((h_f + h_b) * jax.nn.gelu(proj[..., LG_OFF:LG_OFF + LRU_WIDTH].astype(jnp.float32))).astype(x.dtype)
    x = x + ga1 * branch_merge(proj, o_att, o_lru, w_up_attn, w_up_lru, w_out)
    if not last:
        q_c = heads(proj_c[..., Q_OFF:Q_OFF + NA_WIDTH])
        oc_att = context_attention(q_c, k_c, v_c)
        oc_lru = ((hc_f + hc_b) * jax.nn.gelu(proj_c[..., LG_OFF:LG_OFF + LRU_WIDTH].astype(jnp.float32))).astype(ctx.dtype)
        ctx = ctx + mod_c[2] * branch_merge(proj_c, oc_att, oc_lru, w_up_attn, w_up_lru, w_out)

    h2 = ada_rmsnorm(x, g_ffn, sh2, sc2)
    x = x + ga2 * hier_moe(h2.reshape(bsz * length, d), wg, bg, we, be, w1, w3, w2).reshape(bsz, length, d)
    if not last:
        hc2 = ada_rmsnorm(ctx, g_ffn, mod_c[3], mod_c[4])
        ctx = ctx + mod_c[5] * hier_moe(hc2.reshape(bsz * n_ctx, d), wg, bg, we, be, w1, w3, w2).reshape(bsz, n_ctx, d)
    return x, ctx


def setup_inputs(seed: int = 0) -> dict:
    key = jax.random.key(seed)
    ks = jax.random.split(key, 32)
    f32 = jnp.float32
    d = D_MODEL

    def nrm(k, shape, scale):
        return jax.random.normal(k, shape, f32) * scale

    u = jax.random.uniform(ks[16], (DEPTH, 2, LRU_WIDTH), f32, 0.9, 0.999)
    a0 = u ** (1.0 / LRU_C)
    return {
        'x': nrm(ks[0], (BATCH, SEQ, d), 1.0),
        'c': nrm(ks[1], (BATCH, d), 1.0),
        'ctx': nrm(ks[2], (BATCH, CTX_LEN, d), 1.0),
        'c_ctx': nrm(ks[3], (d,), 1.0),
        'w_mod': nrm(ks[4], (DEPTH, d, 6 * d), 0.5 * d ** -0.5),
        'b_mod': nrm(ks[5], (DEPTH, 6 * d), 0.02),
        'g_mix': 1.0 + nrm(ks[6], (DEPTH, d), 0.02),
        'g_ffn': 1.0 + nrm(ks[7], (DEPTH, d), 0.02),
        'w_in': nrm(ks[8], (DEPTH, d, PROJ_COLS), d ** -0.5),
        'rpb': nrm(ks[9], (DEPTH, NA_HEADS, 2 * NA_WIN_ROWS - 1, 2 * NA_WIN_COLS - 1), 0.1),
        'conv_w': nrm(ks[10], (DEPTH, LRU_CONV, LRU_WIDTH), LRU_CONV ** -0.5),
        'conv_b': nrm(ks[11], (DEPTH, LRU_WIDTH), 0.02),
        'lru_wa': nrm(ks[12], (DEPTH, 2, LRU_BLOCKS, LRU_BLOCK, LRU_BLOCK), LRU_BLOCK ** -0.5),
        'lru_ba': nrm(ks[13], (DEPTH, 2, LRU_WIDTH), 0.02),
        'lru_wx': nrm(ks[14], (DEPTH, 2, LRU_BLOCKS, LRU_BLOCK, LRU_BLOCK), LRU_BLOCK ** -0.5),
        'lru_bx': nrm(ks[15], (DEPTH, 2, LRU_WIDTH), 0.02),
        'lru_lambda': jnp.log(a0) - jnp.log1p(-a0),
        'w_up_attn': nrm(ks[17], (DEPTH, NA_WIDTH, d), NA_WIDTH ** -0.5),
        'w_up_lru': nrm(ks[18], (DEPTH, LRU_WIDTH, d), LRU_WIDTH ** -0.5),
        'w_out': nrm(ks[19], (DEPTH, d, d), d ** -0.5),
        'router_group_w': nrm(ks[20], (DEPTH, d, N_GROUPS), d ** -0.5),
        'router_group_b': nrm(ks[21], (DEPTH, N_GROUPS), 0.01),
        'router_expert_w': nrm(ks[22], (DEPTH, d, N_EXPERTS), d ** -0.5),
        'router_expert_b': nrm(ks[23], (DEPTH, N_EXPERTS), 0.01),
        'expert_w_gate': nrm(ks[24], (DEPTH, N_EXPERTS, d, D_EXPERT), d ** -0.5),
        'expert_w_up': nrm(ks[25], (DEPTH, N_EXPERTS, d, D_EXPERT), d ** -0.5),
        'expert_w_down': nrm(ks[26], (DEPTH, N_EXPERTS, D_EXPERT, d), D_EXPERT ** -0.5),
        'g_final': 1.0 + nrm(ks[27], (d,), 0.02),
    }


def reference(x, c, ctx, c_ctx, w_mod, b_mod, g_mix, g_ffn, w_in, rpb, conv_w, conv_b,
              lru_wa, lru_ba, lru_wx, lru_bx, lru_lambda, w_up_attn, w_up_lru, w_out,
              router_group_w, router_group_b, router_expert_w, router_expert_b,
              expert_w_gate, expert_w_up, expert_w_down, g_final):
    for l in range(DEPTH):
        x, ctx = hybrid_layer(x, ctx, c, c_ctx, w_mod[l], b_mod[l], g_mix[l], g_ffn[l], w_in[l], rpb[l],
                              conv_w[l], conv_b[l], lru_wa[l], lru_ba[l], lru_wx[l], lru_bx[l], lru_lambda[l],
                              w_up_attn[l], w_up_lru[l], w_out[l],
                              router_group_w[l], router_group_b[l], router_expert_w[l], router_expert_b[l],
                              expert_w_gate[l], expert_w_up[l], expert_w_down[l], last=(l == DEPTH - 1))
    return (_rms(x) * g_final.astype(jnp.float32)).astype(x.dtype)
```

```cpp
#include <hip/hip_runtime.h>
#include <cstdio>
#include <cstdint>

typedef float f32x2 __attribute__((ext_vector_type(2)));
typedef unsigned u32x2 __attribute__((ext_vector_type(2)));
#define EXTRA_LAUNCHES
namespace pg8 {
#define PG8_LAS __attribute__((address_space(3)))
typedef unsigned short bf16_t;
typedef short bf16x8 __attribute__((ext_vector_type(8)));
typedef float f32x4 __attribute__((ext_vector_type(4)));
typedef unsigned u32x4 __attribute__((ext_vector_type(4)));
constexpr int BM = 256, BK = 64, HALF = 128, HTB = HALF * BK * 2  , STAGE_BYTES = 8 * HTB, NXCD = 8, WGM = 8;

__host__ __device__ __forceinline__ int lds_byte(int r, int c) { const int st = (r >> 4) * 2 + (c >> 5), rr = r & 15, cc = c & 31, ob = rr * 64 + cc * 2; return st * 1024 + (ob ^ (((ob >> 9) & 1) << 5)); }
__host__ __device__ __forceinline__ void stage_rc(int b, int& R, int& C) { const int st = b / 1024, sb = b % 1024, swz = sb ^ (((sb >> 9) & 1) << 5); R = (st >> 1) * 16 + swz / 64; C = (st & 1) * 32 + (swz % 64) / 2; }
__host__ __device__ __forceinline__ int perm32(int rho) { const int n = rho >> 4, i = rho & 15; return 8 * (i >> 2) + 4 * n + (i & 3); }

struct Unit { int pm, pn; size_t bofs; };
struct Gemm { const bf16_t* A; const bf16_t* Bt; int M, N, K; };

struct StaticOrder {
    int nM, nN, nwg, G, c;
    __host__ __device__ __forceinline__ void init(int M, int N, int G_, int c_) { nM = M / BM; nN = N / BM; nwg = nM * nN; G = G_; c = c_; }
    __host__ __device__ __forceinline__ bool next(int i, Unit& u) const {
        const long L = (long)i * G + c; if (L >= nwg) return false;
        int wgid = (int)L; { const int q = nwg / NXCD, r = nwg % NXCD, xcd = wgid % NXCD, off = wgid / NXCD; wgid = (xcd < r ? xcd * (q + 1) : r * (q + 1) + (xcd - r) * q) + off; }
        const int nig = WGM * nN, gid = wgid / nig, fm = gid * WGM, gsz = (nM - fm) < WGM ? (nM - fm) : WGM;
        u.pm = fm + ((wgid % nig) % gsz); u.pn = (wgid % nig) / gsz; u.bofs = 0; return true;
    }
    __device__ __forceinline__ void a_ready(const Unit&) const {}
    __device__ __forceinline__ void done(const Unit&) const {}
};


template <class Epi, class Sched, bool ALIGN_EPI = false, bool SP2 = false>
__device__ __forceinline__ void gemm_phase(PG8_LAS unsigned char* lds, const Gemm g, const Sched& S, const Epi& E, int wid) {
    const int lane = (int)__builtin_amdgcn_mbcnt_hi(~0u, __builtin_amdgcn_mbcnt_lo(~0u, 0u)), tid = wid * 64 + lane, wr = wid >> 2, wc = wid & 3, fr = lane & 15, fq = lane >> 4;
    const int K = g.K, nt = K / BK;
    unsigned voffA[2], voffB[2];
#pragma unroll
    for (int i = 0; i < 2; ++i) { int R, C; stage_rc(tid * 16 + i * 8192, R, C); const int Rb = Epi::PERM ? ((R & ~31) + perm32(R & 31)) : R;
        voffA[i] = (unsigned)(R * K + C) * 2u; voffB[i] = (unsigned)(Rb * K + C) * 2u; }
    const size_t kstep = (size_t)(BK * 2);
    const size_t hstep = (size_t)HALF * K * 2;
    const size_t tstep = 2 * hstep;
    const unsigned ldsw = (unsigned)wid * 1024u;
    const int aoff = lds_byte(wr * 64 + fr, fq * 8), boff = lds_byte(wc * 32 + fr, fq * 8);
#define PG8_SA(b, h) (((b) * 2 + (h)) * HTB)
#define PG8_SB(b, h) ((4 + (b) * 2 + (h)) * HTB)
#define PG8_STAGE(bufoff, gbase, voff) do { _Pragma("unroll") for (int _i = 0; _i < 2; ++_i) \
        __builtin_amdgcn_global_load_lds((const unsigned*)((const char*)(gbase) + (voff)[_i]), (PG8_LAS unsigned*)(lds + (bufoff) + ldsw + _i * 8192), 16, 0, 0); } while (0)
#define PG8_LDA(dst, b, h) do { _Pragma("unroll") for (int m = 0; m < 4; ++m) _Pragma("unroll") for (int k = 0; k < 2; ++k) dst[m][k] = *(const PG8_LAS bf16x8*)(lds + PG8_SA(b, h) + aoff + m * 2048 + k * 1024); } while (0)
#define PG8_LDB(dst, b, h) do { _Pragma("unroll") for (int n = 0; n < 2; ++n) _Pragma("unroll") for (int k = 0; k < 2; ++k) dst[n][k] = *(const PG8_LAS bf16x8*)(lds + PG8_SB(b, h) + boff + n * 2048 + k * 1024); } while (0)
#define PG8_MMA(ai, bj, At, Bt) do { __builtin_amdgcn_s_setprio(1); _Pragma("unroll") for (int m = 0; m < 4; ++m) _Pragma("unroll") for (int n = 0; n < 2; ++n) _Pragma("unroll") for (int k = 0; k < 2; ++k) \
        acc[ai][bj][m][n] = __builtin_amdgcn_mfma_f32_16x16x32_bf16(Bt[n][k], At[m][k], acc[ai][bj][m][n], 0, 0, 0); __builtin_amdgcn_s_setprio(0); } while (0)
#define PG8_WAIT_V(n) asm volatile("s_waitcnt vmcnt(" #n ")" ::: "memory")
#define PG8_WAIT_L(n) asm volatile("s_waitcnt lgkmcnt(" #n ")" ::: "memory")
#define PG8_BAR __builtin_amdgcn_s_barrier()
#define PG8_SCHED __builtin_amdgcn_sched_barrier(0)
    Unit cur, nxt; int ui = 0;
    if (!S.next(0, cur)) return;
    f32x4 acc[2][2][4][2];
#pragma unroll
    for (int a = 0; a < 2; ++a)
#pragma unroll
        for (int b = 0; b < 2; ++b)
#pragma unroll
            for (int m = 0; m < 4; ++m)
#pragma unroll
                for (int n = 0; n < 2; ++n) acc[a][b][m][n] = (f32x4){0.f, 0.f, 0.f, 0.f};
    bf16x8 At[4][2], B0[2][2], B1[2][2];
    const char* cA = (const char*)g.A + (size_t)cur.pm * tstep; const char* cB = (const char*)g.Bt + (size_t)cur.pn * tstep + cur.bofs;
    S.a_ready(cur);
    if constexpr (SP2) {
        PG8_STAGE(PG8_SB(0, 0), cB, voffB); PG8_STAGE(PG8_SB(0, 1), cB + hstep, voffB); PG8_STAGE(PG8_SA(0, 0), cA, voffA); PG8_STAGE(PG8_SA(0, 1), cA + hstep, voffA);
        if (wr == 1) PG8_BAR;
        PG8_WAIT_V(2); PG8_BAR;
        PG8_STAGE(PG8_SB(1, 0), cB + kstep, voffB); PG8_STAGE(PG8_SA(1, 0), cA + kstep, voffA); PG8_STAGE(PG8_SB(1, 1), cB + hstep + kstep, voffB);
        PG8_WAIT_V(6); PG8_BAR;
    } else {
        PG8_STAGE(PG8_SB(0, 0), cB, voffB); PG8_STAGE(PG8_SA(0, 0), cA, voffA); PG8_STAGE(PG8_SB(0, 1), cB + hstep, voffB); PG8_STAGE(PG8_SA(0, 1), cA + hstep, voffA);
        if (wr == 1) PG8_BAR;
        PG8_WAIT_V(4); PG8_BAR;
        PG8_STAGE(PG8_SB(1, 0), cB + kstep, voffB); PG8_STAGE(PG8_SA(1, 0), cA + kstep, voffA); PG8_STAGE(PG8_SB(1, 1), cB + hstep + kstep, voffB);
        PG8_WAIT_V(6); PG8_BAR;
    }
    for (;;) {
        const bool has_next = S.next(ui + 1, nxt);
        const char* nA = has_next ? (const char*)g.A + (size_t)nxt.pm * tstep : cA; const char* nB = has_next ? (const char*)g.Bt + (size_t)nxt.pn * tstep + nxt.bofs : cB;
        for (int t = 0; t < nt; t += 2) {
            const bool last = (t == nt - 2);
            const char* a1 = cA + (size_t)(t + 1) * kstep;
            const char* a2 = last ? nA : cA + (size_t)(t + 2) * kstep; const char* b2 = last ? nB : cB + (size_t)(t + 2) * kstep;
            const char* a3 = a2 + kstep; const char* b3 = b2 + kstep;
            if (last && has_next) S.a_ready(nxt);
            if constexpr (SP2) {
            PG8_LDB(B0, 0, 0); PG8_LDB(B1, 0, 1); PG8_SCHED; PG8_LDA(At, 0, 0); PG8_STAGE(PG8_SA(1, 1), a1 + hstep, voffA);
            PG8_WAIT_V(8); PG8_WAIT_L(0); PG8_BAR; PG8_MMA(0, 0, At, B0); PG8_MMA(0, 1, At, B1); PG8_BAR; PG8_SCHED;
            PG8_LDA(At, 0, 1); PG8_STAGE(PG8_SB(0, 0), b2, voffB); PG8_STAGE(PG8_SB(0, 1), b2 + hstep, voffB); PG8_STAGE(PG8_SA(0, 0), a2, voffA);
            PG8_WAIT_V(8); PG8_WAIT_L(0); PG8_BAR; PG8_MMA(1, 0, At, B0); PG8_MMA(1, 1, At, B1); PG8_BAR; PG8_SCHED;
            PG8_LDB(B0, 1, 0); PG8_LDB(B1, 1, 1); PG8_SCHED; PG8_LDA(At, 1, 0); PG8_STAGE(PG8_SA(0, 1), a2 + hstep, voffA);
            PG8_WAIT_V(8); PG8_WAIT_L(0); PG8_BAR; PG8_MMA(0, 0, At, B0); PG8_MMA(0, 1, At, B1); PG8_BAR; PG8_SCHED;
            PG8_LDA(At, 1, 1); PG8_STAGE(PG8_SB(1, 0), b3, voffB); PG8_STAGE(PG8_SB(1, 1), b3 + hstep, voffB); PG8_STAGE(PG8_SA(1, 0), a3, voffA);
            PG8_WAIT_V(8); PG8_WAIT_L(0); PG8_BAR; PG8_MMA(1, 0, At, B0); PG8_MMA(1, 1, At, B1); PG8_BAR; PG8_SCHED;
            } else {
            PG8_LDB(B0, 0, 0); PG8_SCHED; PG8_LDA(At, 0, 0); PG8_STAGE(PG8_SA(1, 1), a1 + hstep, voffA);
            PG8_WAIT_L(8); PG8_BAR; PG8_WAIT_L(0); PG8_MMA(0, 0, At, B0); PG8_BAR; PG8_SCHED;
            PG8_LDB(B1, 0, 1); PG8_STAGE(PG8_SB(0, 0), b2, voffB);
            PG8_BAR; PG8_WAIT_L(0); PG8_MMA(0, 1, At, B1); PG8_BAR;
            PG8_LDA(At, 0, 1); PG8_STAGE(PG8_SA(0, 0), a2, voffA);
            PG8_BAR; PG8_WAIT_L(0); PG8_MMA(1, 0, At, B0); PG8_BAR; PG8_SCHED;
            PG8_STAGE(PG8_SB(0, 1), b2 + hstep, voffB);
            PG8_WAIT_V(6); PG8_BAR; PG8_MMA(1, 1, At, B1); PG8_BAR;
            PG8_LDB(B0, 1, 0); PG8_SCHED; PG8_LDA(At, 1, 0); PG8_STAGE(PG8_SA(0, 1), a2 + hstep, voffA);
            PG8_WAIT_L(8); PG8_BAR; PG8_WAIT_L(0); PG8_MMA(0, 0, At, B0); PG8_BAR; PG8_SCHED;
            PG8_LDB(B1, 1, 1); PG8_STAGE(PG8_SB(1, 0), b3, voffB);
            PG8_BAR; PG8_WAIT_L(0); PG8_MMA(0, 1, At, B1); PG8_BAR;
            PG8_LDA(At, 1, 1); PG8_STAGE(PG8_SA(1, 0), a3, voffA);
            PG8_BAR; PG8_WAIT_L(0); PG8_MMA(1, 0, At, B0); PG8_BAR; PG8_SCHED;
            PG8_STAGE(PG8_SB(1, 1), b3 + hstep, voffB);
            PG8_WAIT_V(6); PG8_BAR; PG8_MMA(1, 1, At, B1); PG8_BAR;
            }
        }
        if constexpr (ALIGN_EPI) { if (wr == 0) PG8_BAR; }
        if constexpr (!Epi::AFTER_DRAIN) { E(acc, cur, wr, wc, fr, fq); S.done(cur); }
        if (!has_next) break;
#pragma unroll
        for (int a = 0; a < 2; ++a)
#pragma unroll
            for (int b = 0; b < 2; ++b)
#pragma unroll
                for (int m = 0; m < 4; ++m)
#pragma unroll
                    for (int n = 0; n < 2; ++n) acc[a][b][m][n] = (f32x4){0.f, 0.f, 0.f, 0.f};
        cur = nxt; cA = nA; cB = nB; ++ui;
        if constexpr (ALIGN_EPI) { if (wr == 1) PG8_BAR; }
    }
    PG8_WAIT_V(0);
    if constexpr (!ALIGN_EPI) { if (wr == 0) PG8_BAR; }
    PG8_BAR;
    if constexpr (Epi::AFTER_DRAIN) { E.fused(acc, cur, wr, wc, fr, fq, lds, wid, lane); S.done(cur); }
#undef PG8_SA
#undef PG8_SB
#undef PG8_STAGE
#undef PG8_LDA
#undef PG8_LDB
#undef PG8_MMA
#undef PG8_WAIT_V
#undef PG8_WAIT_L
#undef PG8_BAR
#undef PG8_SCHED
}
}
using pg8::bf16_t; using pg8::f32x4; using pg8::u32x4;
#define LAS __attribute__((address_space(3)))

constexpr int D = 1024, NBATCH = 16, SEQ = 2048, CTXL = 256;
constexpr int TL = NBATCH * SEQ;
constexpr int TC = NBATCH * CTXL;
constexpr int TALL = TL + TC;
constexpr int PROJ = 5632;
constexpr int NEXP = 32, DEXP = 512;
constexpr int MOE_ROWS = 288 * 256;
constexpr float EPS = 1e-6f;
constexpr int NWAVES = 8, NTHREADS = 512;

constexpr size_t MiB = 1u << 20;
constexpr size_t WS_CTL = 0;
constexpr size_t CTL_ZERO_BYTES = 256 * 1024;
constexpr size_t WS_MOD = 1 * MiB;
constexpr size_t WS_TOK = 2 * MiB;
constexpr size_t WS_RWT = 3 * MiB;
constexpr size_t WS_WIN = 13 * MiB;
constexpr size_t WS_WA = 24 * MiB;
constexpr size_t WS_WL = 25 * MiB;
constexpr size_t WS_WO = 27 * MiB;
constexpr size_t WS_LW = 29 * MiB;
constexpr size_t WS_W13 = 30 * MiB;
constexpr size_t WS_W2 = 94 * MiB;
constexpr size_t WS_K = 126 * MiB;
constexpr size_t WS_V = 162 * MiB;
constexpr size_t WS_LX = 198 * MiB;
constexpr size_t WS_XB = WS_K;
constexpr size_t WS_Q = 270 * MiB;
constexpr size_t WS_LG = 302 * MiB;
constexpr size_t WS_H2 = WS_Q;
constexpr size_t WS_X1B = WS_LG;
constexpr size_t WS_GA = 366 * MiB;
constexpr size_t WS_GB = 430 * MiB;
constexpr size_t WS_YB = WS_GA;
constexpr size_t WS_END = 510 * MiB;
constexpr int CW_COUNT = 0, CW_CURSOR = 64, CW_NBLK = 128, CW_BLKE = 192;
constexpr int CW_BCNT = 16384;
constexpr int CW_BAR = 1024;

constexpr int RING_BYTES = 131072;
constexpr int MISC_OFF = 147456;
constexpr int LDS_BYTES = 163840;

__device__ __forceinline__ unsigned f2bf(float f) { unsigned u = __float_as_uint(f); return (u + 0x7fffu + ((u >> 16) & 1u)) >> 16; }
__device__ __forceinline__ float bf2f(unsigned h) { return __uint_as_float(h << 16); }
typedef __bf16 bf16x2_t __attribute__((ext_vector_type(2)));
__device__ __forceinline__ unsigned pk2(float lo, float hi) { const f32x2 v = {lo, hi}; const bf16x2_t b = __builtin_convertvector(v, bf16x2_t); return __builtin_bit_cast(unsigned, b); }
__device__ __forceinline__ float bflo(unsigned w) { return __uint_as_float(w << 16); }
__device__ __forceinline__ float bfhi(unsigned w) { return __uint_as_float(w & 0xffff0000u); }
__device__ __forceinline__ void unpack8(u32x4 w, float (&v)[8]) { v[0] = bflo(w.x); v[1] = bfhi(w.x); v[2] = bflo(w.y); v[3] = bfhi(w.y); v[4] = bflo(w.z); v[5] = bfhi(w.z); v[6] = bflo(w.w); v[7] = bfhi(w.w); }
__device__ __forceinline__ u32x4 pack8(const float (&v)[8]) { u32x4 w; w.x = pk2(v[0], v[1]); w.y = pk2(v[2], v[3]); w.z = pk2(v[4], v[5]); w.w = pk2(v[6], v[7]); return w; }
__device__ __forceinline__ float fast_exp(float x) { return __builtin_amdgcn_exp2f(x * 1.4426950408889634f); }
__device__ __forceinline__ float sigmoid_fast(float x) { return __builtin_amdgcn_rcpf(1.0f + fast_exp(-x)); }
__device__ __forceinline__ float silu_fast(float x) { return x * sigmoid_fast(x); }
__device__ __forceinline__ float gelu_tanh_fast(float x) { const float u2 = 1.5957691216057308f * (x + 0.044715f * x * x * x); return x * sigmoid_fast(u2); }
__device__ __forceinline__ float sigmoidf_(float x) { return 1.0f / (1.0f + expf(-x)); }
__device__ __forceinline__ float siluf_(float x) { return x / (1.0f + expf(-x)); }
__device__ __forceinline__ float wave_sum(float v) {
#pragma unroll
    for (int o = 1; o < 64; o <<= 1) v += __shfl_xor(v, o);
    return v;
}

template <int CTRL> __device__ __forceinline__ float dpp_f(float v) { return __int_as_float(__builtin_amdgcn_update_dpp(0, __float_as_int(v), CTRL, 0xF, 0xF, true)); }
__device__ __forceinline__ float row16_sum(float v) { v += dpp_f<0xB1>(v); v += dpp_f<0x4E>(v); v += dpp_f<0x141>(v); v += dpp_f<0x140>(v); return v; }
__device__ __forceinline__ float comb32(float a, float b) { const auto r = __builtin_amdgcn_permlane32_swap(__float_as_uint(a), __float_as_uint(b), false, false); return __uint_as_float(r[0]) + __uint_as_float(r[1]); }
__device__ __forceinline__ float comb16(float a, float b) { const auto r = __builtin_amdgcn_permlane16_swap(__float_as_uint(a), __float_as_uint(b), false, false); return __uint_as_float(r[0]) + __uint_as_float(r[1]); }
__device__ __forceinline__ float lane_f(float v, int l) { return __int_as_float(__builtin_amdgcn_readlane(__float_as_int(v), l)); }
__device__ __forceinline__ float wave_sum_fast(float v) { v = row16_sum(v); return (lane_f(v, 0) + lane_f(v, 16)) + (lane_f(v, 32) + lane_f(v, 48)); }
__device__ __forceinline__ float half_max(float v) { const auto r = __builtin_amdgcn_permlane32_swap(__float_as_uint(v), __float_as_uint(v), false, false); return fmaxf(__uint_as_float(r[0]), __uint_as_float(r[1])); }
__device__ __forceinline__ float half_sum(float v) { const auto r = __builtin_amdgcn_permlane32_swap(__float_as_uint(v), __float_as_uint(v), false, false); return __uint_as_float(r[0]) + __uint_as_float(r[1]); }

struct EpiProj {
    bf16_t *Kb, *Vb, *LXb, *Qb, *LGb, *GAb, *GBb; const f32x2* rope;
    __device__ __forceinline__ void operator()(int row, int col, const float (&v)[8]) const {
        float o[8];
        if (col < 512) {
            if (row < TL) { const int t = row & 2047, p = col & 63, pos = (p < 32) ? (t >> 6) : (t & 63), i0 = (p & 31) >> 1;
#pragma unroll
                for (int j = 0; j < 4; ++j) { const f32x2 cs = rope[pos * 16 + i0 + j]; o[2 * j] = v[2 * j] * cs.x - v[2 * j + 1] * cs.y; o[2 * j + 1] = v[2 * j] * cs.y + v[2 * j + 1] * cs.x; }
            } else {
#pragma unroll
                for (int j = 0; j < 8; ++j) o[j] = v[j]; }
            *(u32x4*)(Kb + (size_t)row * 512 + col) = pack8(o);
        } else if (col < 1024) { *(u32x4*)(Vb + (size_t)row * 512 + (col - 512)) = pack8(v);
        } else if (col < 2048) { *(u32x4*)(LXb + (size_t)row * 1024 + (col - 1024)) = pack8(v);
        } else if (col < 2560) { *(u32x4*)(Qb + (size_t)row * 512 + (col - 2048)) = pack8(v);
        } else if (col < 3584) {
#pragma unroll
            for (int j = 0; j < 8; ++j) o[j] = gelu_tanh_fast(v[j]);
            *(u32x4*)(LGb + (size_t)row * 1024 + (col - 2560)) = pack8(o);
        } else {
#pragma unroll
            for (int j = 0; j < 8; ++j) o[j] = sigmoid_fast(v[j]);
            bf16_t* dst = (col < 4608) ? GAb + (size_t)row * 1024 + (col - 3584) : GBb + (size_t)row * 1024 + (col - 4608);
            *(u32x4*)dst = pack8(o);
        }
    }
};
struct EpiUpAttn {
    const bf16_t* GA; bf16_t* OUT;
    struct P { u32x4 g; };
    __device__ __forceinline__ void load(int row, int col, P& p) const { p.g = *(const u32x4*)(GA + (size_t)row * 1024 + col); }
    __device__ __forceinline__ void apply(int row, int col, const float (&v)[8], const P& p) const {
        float g[8], o[8]; unpack8(p.g, g);
#pragma unroll
        for (int j = 0; j < 8; ++j) o[j] = g[j] * v[j];
        *(u32x4*)(OUT + (size_t)row * 1024 + col) = pack8(o);
    }
};
struct EpiUpLru {
    const bf16_t* Y; const bf16_t* GB; bf16_t* OUT;
    struct P { u32x4 g, y; };
    __device__ __forceinline__ void load(int row, int col, P& p) const { p.g = *(const u32x4*)(GB + (size_t)row * 1024 + col); p.y = *(const u32x4*)(Y + (size_t)row * 1024 + col); }
    __device__ __forceinline__ void apply(int row, int col, const float (&v)[8], const P& p) const {
        float g[8], y[8], o[8]; unpack8(p.g, g); unpack8(p.y, y);
#pragma unroll
        for (int j = 0; j < 8; ++j) o[j] = y[j] + g[j] * v[j];
        *(u32x4*)(OUT + (size_t)row * 1024 + col) = pack8(o);
    }
};
struct EpiOut {
    const float* x; const float* mod; bf16_t* x1;
    struct P { f32x4 x0, x1v, g0, g1; };
    __device__ __forceinline__ void load(int row, int col, P& p) const { const float* ga1 = mod + (row >> 11) * 6144 + 2048 + col; const float* xr = x + (size_t)row * D + col;
        p.x0 = *(const f32x4*)xr; p.x1v = *(const f32x4*)(xr + 4); p.g0 = *(const f32x4*)ga1; p.g1 = *(const f32x4*)(ga1 + 4); }
    __device__ __forceinline__ void apply(int row, int col, const float (&v)[8], const P& p) const {
        const float o[8] = {p.x0.x + p.g0.x * v[0], p.x0.y + p.g0.y * v[1], p.x0.z + p.g0.z * v[2], p.x0.w + p.g0.w * v[3], p.x1v.x + p.g1.x * v[4], p.x1v.y + p.g1.y * v[5], p.x1v.z + p.g1.z * v[6], p.x1v.w + p.g1.w * v[7]};
        *(u32x4*)(x1 + (size_t)row * D + col) = pack8(o);
    }
};
struct EpiMoe1 {
    bf16_t* HM;
    __device__ __forceinline__ void operator()(int row, int col, const float (&v)[8]) const {
        u32x2 w; w.x = pk2(silu_fast(v[0]) * v[1], silu_fast(v[2]) * v[3]); w.y = pk2(silu_fast(v[4]) * v[5], silu_fast(v[6]) * v[7]);
        *(u32x2*)(HM + (size_t)row * DEXP + (col >> 1)) = w;
    }
};
struct EpiMoe2 {
    bf16_t* YB;
    __device__ __forceinline__ void operator()(int row, int col, const float (&v)[8]) const { *(u32x4*)(YB + (size_t)row * D + col) = pack8(v); }
};
template <class F> struct EpiF {
    static constexpr bool PERM = true, AFTER_DRAIN = false; F f;
    __device__ __forceinline__ void operator()(const f32x4 (&acc)[2][2][4][2], const pg8::Unit& u, int wr, int wc, int fr, int fq) const {
#pragma unroll
        for (int ai = 0; ai < 2; ++ai)
#pragma unroll
            for (int m = 0; m < 4; ++m) { const int row = u.pm * 256 + ai * 128 + wr * 64 + m * 16 + fr;
#pragma unroll
                for (int bj = 0; bj < 2; ++bj) { const int col = u.pn * 256 + bj * 128 + wc * 32 + 8 * fq; const f32x4 a = acc[ai][bj][m][0], b = acc[ai][bj][m][1];
                    const float v[8] = {a[0], a[1], a[2], a[3], b[0], b[1], b[2], b[3]}; f(row, col, v); } }
    }
};
template <class F> struct EpiF2 {
    static constexpr bool PERM = true, AFTER_DRAIN = false; F f;
    __device__ __forceinline__ void operator()(const f32x4 (&acc)[2][2][4][2], const pg8::Unit& u, int wr, int wc, int fr, int fq) const {
#pragma unroll
        for (int ai = 0; ai < 2; ++ai)
#pragma unroll
            for (int mp = 0; mp < 2; ++mp) {
                typename F::P pre[2][2];
#pragma unroll
                for (int mm = 0; mm < 2; ++mm)
#pragma unroll
                    for (int bj = 0; bj < 2; ++bj) f.load(u.pm * 256 + ai * 128 + wr * 64 + (2 * mp + mm) * 16 + fr, u.pn * 256 + bj * 128 + wc * 32 + 8 * fq, pre[mm][bj]);
#pragma unroll
                for (int mm = 0; mm < 2; ++mm)
#pragma unroll
                    for (int bj = 0; bj < 2; ++bj) { const int m = 2 * mp + mm; const f32x4 a = acc[ai][bj][m][0], b = acc[ai][bj][m][1];
                        const float v[8] = {a[0], a[1], a[2], a[3], b[0], b[1], b[2], b[3]};
                        f.apply(u.pm * 256 + ai * 128 + wr * 64 + m * 16 + fr, u.pn * 256 + bj * 128 + wc * 32 + 8 * fq, v, pre[mm][bj]); }
                asm volatile("" ::: "memory");
            }
    }
};

struct ProjOrder {
    pg8::StaticOrder so; int G, c;
    __device__ __forceinline__ void init(int G_, int c_) { so.init(TL, PROJ, G_, c_); G = G_; c = c_; }
    __device__ __forceinline__ bool next(int i, pg8::Unit& u) const {
        const int L = i * G + c;
        if (L < so.nwg) return so.next(i, u);
        const int j = L - so.nwg; if (j >= 128) return false;
        u.pm = 128 + (j >> 3); u.pn = j & 7; u.bofs = 0; return true;
    }
    __device__ __forceinline__ void a_ready(const pg8::Unit&) const {}
    __device__ __forceinline__ void done(const pg8::Unit&) const {}
};
struct MoeOrder {
    const unsigned* ctl; int G, vcu, nunits; size_t estride;
    __device__ __forceinline__ void init(const unsigned* ctl_, int G_, int bx, size_t es) { ctl = ctl_; G = G_; vcu = (G_ % 8 == 0) ? (bx % 8) * (G_ / 8) + bx / 8 : bx; nunits = (int)ctl_[CW_NBLK] * 4; estride = es; }
    __device__ __forceinline__ bool next(int i, pg8::Unit& u) const {
        const int L = i * G + vcu; if (L >= nunits) return false;
        u.pm = L >> 2; u.pn = L & 3; u.bofs = (size_t)ctl[CW_BLKE + u.pm] * estride; return true;
    }
    __device__ __forceinline__ void a_ready(const pg8::Unit&) const {}
    __device__ __forceinline__ void done(const pg8::Unit&) const {}
};

#define XB_TMO      128
#define XB_XCNT(j)  (256  + 64 * (j))
#define XB_XSUB(j)  (1280 + 64 * (j))
#define XB_XGEN(j)  (2304 + 64 * (j))
#define XB_TOP      3328
#define XB_TOPGEN   3392
#define XCD_BAR_WORDS 3456
#define XB_SPIN_CAP (1u << 18)

__device__ __forceinline__ unsigned xb_ld(unsigned* p)              { return __hip_atomic_load(p, __ATOMIC_RELAXED, __HIP_MEMORY_SCOPE_AGENT); }
__device__ __forceinline__ unsigned xb_add(unsigned* p, unsigned v) { return __hip_atomic_fetch_add(p, v, __ATOMIC_RELAXED, __HIP_MEMORY_SCOPE_AGENT); }
__device__ __forceinline__ unsigned xb_xcc_id() { return (unsigned)__builtin_amdgcn_s_getreg((3 << 11) | 20) & 0xFu; }
#define XB_SPIN(cond, bar) do { unsigned _sp = 0; while (cond) { __builtin_amdgcn_s_sleep(1); \
    if ((++_sp & 255u) == 0u) { if (xb_ld(&(bar)[XB_TMO])) break; if (_sp > XB_SPIN_CAP) { atomicAdd(&(bar)[XB_TMO], 1u); break; } } } } while (0)

struct XcdBarrier {
    unsigned* bar; unsigned x;
    volatile LAS unsigned* st;
};

__device__ __forceinline__ XcdBarrier xcd_barrier_post(unsigned* bar, volatile LAS unsigned* st, bool leader) {
    XcdBarrier b; b.bar = bar; b.x = xb_xcc_id(); b.st = st;
    if (leader) (void)xb_add(&bar[XB_XCNT(b.x)], 1u);
    return b;
}
__device__ __forceinline__ void xcd_barrier_complete(unsigned* bar, unsigned x, unsigned& nloc, unsigned& nx) {
    const unsigned G = gridDim.x * gridDim.y * gridDim.z;
    unsigned sum, cnt, mine, sp = 0u;
    for (;;) {
        sum = 0u; cnt = 0u; mine = 0u;
#pragma unroll
        for (unsigned j = 0; j < 16; ++j) { const unsigned c = xb_ld(&bar[XB_XCNT(j)]); sum += c; cnt += (c > 0u) ? 1u : 0u; mine = (j == x) ? c : mine; }
        if (sum == G) break;
        __builtin_amdgcn_s_sleep(1);
        if ((++sp & 255u) == 0u) { if (xb_ld(&bar[XB_TMO])) break; if (sp > XB_SPIN_CAP) { atomicAdd(&bar[XB_TMO], 1u); break; } }
    }
    nloc = mine > 0u ? mine : 1u; nx = cnt > 0u ? cnt : 1u;
}

__device__ __forceinline__ void xcd_barrier(const XcdBarrier& b, int wave) {
    const bool leader_ = wave == 0 && __builtin_amdgcn_mbcnt_hi(~0u, __builtin_amdgcn_mbcnt_lo(~0u, 0u)) == 0u;
    asm volatile("s_waitcnt vmcnt(0)" ::: "memory");
    __syncthreads();
    if (leader_) {
        unsigned* bar = b.bar;
        __builtin_amdgcn_s_waitcnt(0);
        unsigned nloc = b.st[0], nx = b.st[1];
        if (nloc == 0u) { xcd_barrier_complete(bar, b.x, nloc, nx); b.st[0] = nloc; b.st[1] = nx; }
        const unsigned old = xb_add(&bar[XB_XSUB(b.x)], 1u);
        const unsigned gen = old / nloc;
        if (old + 1u == (gen + 1u) * nloc) {
            __builtin_amdgcn_fence(__ATOMIC_RELEASE, "agent");
            asm volatile("s_waitcnt vmcnt(0)" ::: "memory");
            const unsigned og = xb_add(&bar[XB_TOP], 1u);
            const unsigned tg = og / nx;
            if (og + 1u == (tg + 1u) * nx) xb_add(&bar[XB_TOPGEN], 1u);
            else XB_SPIN(xb_ld(&bar[XB_TOPGEN]) == tg, bar);
            __builtin_amdgcn_fence(__ATOMIC_ACQUIRE, "agent");
            xb_add(&bar[XB_XGEN(b.x)], 1u);
            asm volatile("s_waitcnt vmcnt(0)" ::: "memory");
        } else {
            XB_SPIN(xb_ld(&bar[XB_XGEN(b.x)]) == gen, bar);
            __builtin_amdgcn_fence(__ATOMIC_ACQUIRE, "agent");
            asm volatile("s_waitcnt vmcnt(0)" ::: "memory");
        }
    }
    __syncthreads();
}

__device__ __forceinline__ int win_perm(int n) {
    const bool qk = (n < 512) || (n >= 2048 && n < 2560);
    if (!qk) return n;
    const int d = n & 63, base = n - d, half = d >> 5, dd = d & 31, i = dd & 15, comp = dd >> 4;
    return base + half * 32 + 2 * i + comp;
}
template <int K, int N, int MODE, int ROWMUL>
__device__ __forceinline__ void prep_item(const float* W, bf16_t* WT, int rowoff, unsigned dstride, LAS float* scr, int item, int lane, float wscale = 1.0f) {
    constexpr int nblk = N / 32, per = (K / 64) * nblk;
    const int bi = item / per, r = item % per, kb = r / nblk, nb = r % nblk, k0 = 64 * kb, n0 = 32 * nb;
    const float* src = W + (size_t)bi * K * N;
    { float t_[32];
#pragma unroll
      for (int i = 0; i < 32; ++i) t_[i] = __builtin_nontemporal_load(src + (size_t)(k0 + 2 * i + (lane >> 5)) * N + n0 + (lane & 31));
#pragma unroll
      for (int i = 0; i < 32; ++i) scr[(2 * i + (lane >> 5)) * 33 + (lane & 31)] = t_[i]; }
    asm volatile("s_waitcnt lgkmcnt(0)" ::: "memory");
    const int c = lane & 7;
#pragma unroll
    for (int j = 0; j < 4; ++j) { const int n = (lane >> 3) + 8 * j; const LAS float* s = scr + (8 * c) * 33 + n;
        u32x4 o; o.x = pk2(s[0 * 33] * wscale, s[1 * 33] * wscale); o.y = pk2(s[2 * 33] * wscale, s[3 * 33] * wscale); o.z = pk2(s[4 * 33] * wscale, s[5 * 33] * wscale); o.w = pk2(s[6 * 33] * wscale, s[7 * 33] * wscale);
        int ng = n0 + n; if (MODE == 1) ng = win_perm(ng);
        *(u32x4*)(WT + (size_t)bi * dstride + (size_t)(ROWMUL * ng + rowoff) * K + k0 + 8 * c) = o; }
    asm volatile("s_waitcnt lgkmcnt(0)" ::: "memory");
}
__device__ __forceinline__ unsigned char* lds_ptr(LAS unsigned char* ldsl, int i);
__device__ __forceinline__ void p0_prep(unsigned char* ws, LAS unsigned char* ldsl, int gw, int ngw, int lane, int wave) {
    LAS float* scr = (LAS float*)(ldsl + wave * 8448);
#define in_(i) ((const float*)lds_ptr(ldsl, (i)))
    constexpr int I0 = 16 * 176, I1 = 8 * 32, I2 = 16 * 32, I3 = 16 * 32, I4 = 16 * 2 * 4, I5 = I4, I6 = 32 * 16 * 16, I7 = I6, I8 = 32 * 8 * 32;
    constexpr int TOT = I0 + I1 + I2 + I3 + I4 + I5 + I6 + I7 + I8;
    for (int it = gw; it < TOT; it += ngw) {
        int r = it;
        if (r < I0) { prep_item<1024, PROJ, 1, 1>(in_(8), (bf16_t*)(ws + WS_WIN), 0, 0u, scr, r, lane); continue; } r -= I0;
        if (r < I1) { prep_item<512, 1024, 0, 1>(in_(17), (bf16_t*)(ws + WS_WA), 0, 0u, scr, r, lane); continue; } r -= I1;
        if (r < I2) { prep_item<1024, 1024, 0, 1>(in_(18), (bf16_t*)(ws + WS_WL), 0, 0u, scr, r, lane); continue; } r -= I2;
        if (r < I3) { prep_item<1024, 1024, 0, 1>(in_(19), (bf16_t*)(ws + WS_WO), 0, 0u, scr, r, lane); continue; } r -= I3;
        if (r < I4) { prep_item<128, 128, 0, 1>(in_(12), (bf16_t*)(ws + WS_LW), 0, 256u * 128u, scr, r, lane, -1.4426950408889634f); continue; } r -= I4;
        if (r < I5) { prep_item<128, 128, 0, 1>(in_(14), (bf16_t*)(ws + WS_LW), 128, 256u * 128u, scr, r, lane, -1.4426950408889634f); continue; } r -= I5;
        if (r < I6) { prep_item<1024, 512, 0, 2>(in_(24), (bf16_t*)(ws + WS_W13), 0, 1024u * 1024u, scr, r, lane); continue; } r -= I6;
        if (r < I7) { prep_item<1024, 512, 0, 2>(in_(25), (bf16_t*)(ws + WS_W13), 1, 1024u * 1024u, scr, r, lane); continue; } r -= I7;
        prep_item<512, 1024, 0, 1>(in_(26), (bf16_t*)(ws + WS_W2), 0, 1024u * 512u, scr, r, lane);
    }
#undef in_
}
__device__ __forceinline__ void p0_mod(const float* c, const float* c_ctx, const float* w_mod, const float* b_mod, const float* wg, const float* we, f32x4* W4g, const float* lam, float* SPt, float* mod, f32x2* rope, LAS float* lds_f, int tid) {
    LAS float* sc = lds_f;
    LAS float* red = lds_f + 17 * 1024;
    for (int i = tid; i < 17 * 1024; i += NTHREADS) { const float v = (i < 16 * 1024) ? c[i] : c_ctx[i - 16 * 1024]; sc[i] = siluf_(v); }
    for (int idx = blockIdx.x * NTHREADS + tid; idx < 36 * 256; idx += gridDim.x * NTHREADS) { const int cc = idx >> 8, kq = idx & 255; f32x4 w;
        if (cc < 4) { const float* s = wg + (size_t)(4 * kq) * 4 + cc; w.x = s[0]; w.y = s[4]; w.z = s[8]; w.w = s[12]; }
        else { const float* s = we + (size_t)(4 * kq) * 32 + (cc - 4); w.x = s[0]; w.y = s[32]; w.z = s[64]; w.w = s[96]; }
        W4g[idx] = w; }
    if (blockIdx.x == 1) for (int i = tid; i < 2048; i += NTHREADS) { const float lm = lam[i]; SPt[i] = (-lm > 20.f) ? -lm : log1pf(expf(-lm)); }
    if (blockIdx.x == 0) for (int i = tid; i < 64 * 16; i += NTHREADS) { const int pos = i >> 4, f = i & 15; const double inv = exp(-(double)f / 16.0 * log(10000.0)); const double ang = (double)pos * inv;
        rope[i] = (f32x2){(float)cos(ang), (float)sin(ang)}; }
    __syncthreads();
    for (int cb = blockIdx.x; cb < 256; cb += gridDim.x) {
        const int ks = tid / 24, col = tid % 24;
        if (ks < 21) {
            float acc[17];
#pragma unroll
            for (int b = 0; b < 17; ++b) acc[b] = 0.f;
            for (int k = ks; k < 1024; k += 21) { const float w = w_mod[(size_t)k * 6144 + cb * 24 + col];
#pragma unroll
                for (int b = 0; b < 17; ++b) acc[b] += sc[b * 1024 + k] * w; }
#pragma unroll
            for (int b = 0; b < 17; ++b) red[(ks * 17 + b) * 24 + col] = acc[b];
        }
        __syncthreads();
        if (tid < 17 * 24) { const int b = tid / 24, cc = tid % 24; float s = b_mod[cb * 24 + cc];
            for (int q = 0; q < 21; ++q) s += red[(q * 17 + b) * 24 + cc];
            mod[b * 6144 + cb * 24 + cc] = s; }
        __syncthreads();
    }
}

__device__ __forceinline__ void p1_adanorm(const float* x, const float* ctx, const float* gain, const float* mod, bf16_t* H, int gw, int ngw, int lane) {
    f32x4 nA[4], nB[4];
#define AD_SRC(r_) ((r_) < TL ? x + (size_t)(r_) * D : ctx + (size_t)((r_) - TL) * D)
#define AD_LOAD(dst, r_) do { if ((r_) < TALL) { const float* s_ = AD_SRC(r_); _Pragma("unroll") for (int j = 0; j < 4; ++j) dst[j] = __builtin_nontemporal_load((const f32x4*)(s_ + lane * 4 + 256 * j)); } } while (0)
#define AD_ROW(src_, r_) do { const int row_ = (r_); const int mb = row_ < TL ? (row_ >> 11) : 16; const float* shift = mod + mb * 6144; const float* scale = shift + 1024; \
        f32x4 v[4]; float ss = 0.f; \
        _Pragma("unroll") for (int j = 0; j < 4; ++j) { v[j] = src_[j]; ss += v[j].x * v[j].x + v[j].y * v[j].y + v[j].z * v[j].z + v[j].w * v[j].w; } \
        AD_LOAD(src_, row_ + 2 * ngw); \
        const float rstd = rsqrtf(wave_sum_fast(ss) * (1.0f / D) + EPS); \
        _Pragma("unroll") for (int j = 0; j < 4; ++j) { const int k = lane * 4 + 256 * j; const f32x4 g = *(const f32x4*)(gain + k), sh = *(const f32x4*)(shift + k), sc = *(const f32x4*)(scale + k); \
            const f32x4 o = (v[j] * rstd * g) * (1.0f + sc) + sh; \
            u32x2 w; w.x = pk2(o.x, o.y); w.y = pk2(o.z, o.w); *(u32x2*)(H + (size_t)row_ * D + k) = w; } } while (0)
    AD_LOAD(nA, gw); AD_LOAD(nB, gw + ngw);
    for (int row = gw; row < TALL; row += 2 * ngw) { AD_ROW(nA, row); if (row + ngw < TALL) AD_ROW(nB, row + ngw); }
#undef AD_SRC
#undef AD_LOAD
#undef AD_ROW
}

__device__ __forceinline__ void p1_router_tables(const float* gain, const float* mod, const f32x4* W4g, const float* bg, const float* be, float* WT, float* biasb, int gw, int ngw, int lane) {
    for (int it = gw; it < 16 * 48; it += ngw) {
        const int b = it / 48, j = it % 48; const float* shift = mod + b * 6144 + 3072; const float* scale = shift + 1024;
        float part = 0.f;
#pragma unroll
        for (int i = 0; i < 4; ++i) { const int kq = lane + 64 * i; const f32x4 g = *(const f32x4*)(gain + 4 * kq), sc = *(const f32x4*)(scale + 4 * kq), sh = *(const f32x4*)(shift + 4 * kq);
            f32x4 w = (f32x4){0.f, 0.f, 0.f, 0.f}; if (j < 36) w = W4g[j * 256 + kq];
            *(f32x4*)(WT + (size_t)(b * 48 + j) * 1024 + 4 * kq) = g * (1.0f + sc) * w;
            part += sh.x * w.x + sh.y * w.y + sh.z * w.z + sh.w * w.w; }
        part = wave_sum_fast(part);
        if (lane == 0) biasb[b * 48 + j] = part + (j < 4 ? bg[j] : j < 36 ? be[j - 4] : 0.f);
    }
}
constexpr int RT_CHUNK_FLOATS = 48 * 132, RT_LG_OFF = 2 * RT_CHUNK_FLOATS * 4;
__device__ __forceinline__ void p8_route(const bf16_t* x1, const float* WT, const float* biasb, unsigned* ctl, int* tok, LAS unsigned char* lds, int lane, int tid, int wave) {
    LAS unsigned* hist = (LAS unsigned*)(lds + MISC_OFF + 256);
    if (tid < 32) hist[tid] = 0u;
    LAS float* Lg = (LAS float*)(lds + RT_LG_OFF + wave * 3072);
    const int i = lane & 15, kk = lane >> 4;
    for (int blk = blockIdx.x; blk < TL / 128; blk += gridDim.x) {
        const int R0 = 128 * blk + 16 * wave, b = (128 * blk) >> 11;
        const bf16_t* xr = x1 + (size_t)(R0 + i) * D + 4 * kk; const float* wtb = WT + (size_t)b * 48 * 1024;
        f32x4 a0 = (f32x4){0.f, 0.f, 0.f, 0.f}, a1 = a0, a2 = a0; float ss = 0.f;
        f32x4 stg[3];
#define RT_LOAD(c_) do { _Pragma("unroll") for (int q = 0; q < 3; ++q) { const int id = tid + NTHREADS * q, col = id >> 5, k4 = id & 31; stg[q] = *(const f32x4*)(wtb + (size_t)col * 1024 + 128 * (c_) + 4 * k4); } } while (0)
#define RT_STORE(buf_) do { _Pragma("unroll") for (int q = 0; q < 3; ++q) { const int id = tid + NTHREADS * q, col = id >> 5, k4 = id & 31; *(LAS f32x4*)((LAS float*)lds + (buf_) * RT_CHUNK_FLOATS + col * 132 + 4 * k4) = stg[q]; } } while (0)
        __syncthreads();
        RT_LOAD(0); RT_STORE(0);
        u32x2 cx[8];
#pragma unroll
        for (int u = 0; u < 8; ++u) cx[u] = *(const u32x2*)(xr + 16 * u);
        __syncthreads();
#pragma unroll 1
        for (int c = 0; c < 8; ++c) {
            if (c < 7) RT_LOAD(c + 1);
            u32x2 nx[8];
            if (c < 7) {
#pragma unroll
                for (int u = 0; u < 8; ++u) nx[u] = *(const u32x2*)(xr + 128 * (c + 1) + 16 * u); }
            const LAS float* wl = (const LAS float*)lds + (c & 1) * RT_CHUNK_FLOATS + i * 132 + 4 * kk;
#pragma unroll
            for (int u = 0; u < 8; ++u) { const f32x4 xa = (f32x4){bflo(cx[u].x), bfhi(cx[u].x), bflo(cx[u].y), bfhi(cx[u].y)}, b0 = *(const LAS f32x4*)(wl + 16 * u), b1 = *(const LAS f32x4*)(wl + 16 * 132 + 16 * u), b2 = *(const LAS f32x4*)(wl + 32 * 132 + 16 * u);
                ss += xa.x * xa.x + xa.y * xa.y + xa.z * xa.z + xa.w * xa.w;
                a0 = __builtin_amdgcn_mfma_f32_16x16x4f32(xa.x, b0.x, a0, 0, 0, 0); a1 = __builtin_amdgcn_mfma_f32_16x16x4f32(xa.x, b1.x, a1, 0, 0, 0); a2 = __builtin_amdgcn_mfma_f32_16x16x4f32(xa.x, b2.x, a2, 0, 0, 0);
                a0 = __builtin_amdgcn_mfma_f32_16x16x4f32(xa.y, b0.y, a0, 0, 0, 0); a1 = __builtin_amdgcn_mfma_f32_16x16x4f32(xa.y, b1.y, a1, 0, 0, 0); a2 = __builtin_amdgcn_mfma_f32_16x16x4f32(xa.y, b2.y, a2, 0, 0, 0);
                a0 = __builtin_amdgcn_mfma_f32_16x16x4f32(xa.z, b0.z, a0, 0, 0, 0); a1 = __builtin_amdgcn_mfma_f32_16x16x4f32(xa.z, b1.z, a1, 0, 0, 0); a2 = __builtin_amdgcn_mfma_f32_16x16x4f32(xa.z, b2.z, a2, 0, 0, 0);
                a0 = __builtin_amdgcn_mfma_f32_16x16x4f32(xa.w, b0.w, a0, 0, 0, 0); a1 = __builtin_amdgcn_mfma_f32_16x16x4f32(xa.w, b1.w, a1, 0, 0, 0); a2 = __builtin_amdgcn_mfma_f32_16x16x4f32(xa.w, b2.w, a2, 0, 0, 0); }
            if (c < 7) { RT_STORE((c + 1) & 1);
#pragma unroll
                for (int u = 0; u < 8; ++u) cx[u] = nx[u]; }
            __syncthreads();
        }
#undef RT_LOAD
#undef RT_STORE
        ss = half_sum(ss); { const auto r = __builtin_amdgcn_permlane16_swap(__float_as_uint(ss), __float_as_uint(ss), false, false); ss = __uint_as_float(r[0]) + __uint_as_float(r[1]); }
        const float rstd = rsqrtf(ss * (1.0f / D) + EPS);
#pragma unroll
        for (int rg = 0; rg < 4; ++rg) { Lg[(4 * kk + rg) * 48 + i] = a0[rg]; Lg[(4 * kk + rg) * 48 + 16 + i] = a1[rg]; Lg[(4 * kk + rg) * 48 + 32 + i] = a2[rg]; }
        if (lane < 16) {
            const int row = R0 + lane; const float* bb = biasb + b * 48; const LAS float* lr = Lg + lane * 48;
            float acc[36];
#pragma unroll
            for (int c4 = 0; c4 < 9; ++c4) { const f32x4 v = *(const LAS f32x4*)(lr + 4 * c4), bv = *(const f32x4*)(bb + 4 * c4);
                acc[4 * c4] = rstd * v.x + bv.x; acc[4 * c4 + 1] = rstd * v.y + bv.y; acc[4 * c4 + 2] = rstd * v.z + bv.z; acc[4 * c4 + 3] = rstd * v.w + bv.w; }
            int gi = 0; float gm = -1e30f;
#pragma unroll
            for (int g = 0; g < 4; ++g) if (acc[g] > gm) { gm = acc[g]; gi = g; }
            float gs = 0.f;
#pragma unroll
            for (int g = 0; g < 4; ++g) gs += expf(acc[g] - gm);
            const float p_top = 1.0f / gs;
            float le[8];
#pragma unroll
            for (int j = 0; j < 8; ++j) le[j] = gi == 0 ? acc[4 + j] : gi == 1 ? acc[12 + j] : gi == 2 ? acc[20 + j] : acc[28 + j];
            int e1 = 0; float v1 = -1e30f;
#pragma unroll
            for (int j = 0; j < 8; ++j) if (le[j] > v1) { v1 = le[j]; e1 = j; }
            int e2 = 0; float v2 = -1e30f;
#pragma unroll
            for (int j = 0; j < 8; ++j) if (j != e1 && le[j] > v2) { v2 = le[j]; e2 = j; }
            const float p2 = expf(v2 - v1), inv = 1.0f / (1.0f + p2);
            const int eid0 = gi * 8 + e1, eid1 = gi * 8 + e2;
            const int s0 = (int)__hip_atomic_fetch_add(&hist[eid0], 1u, __ATOMIC_RELAXED, __HIP_MEMORY_SCOPE_WORKGROUP), s1 = (int)__hip_atomic_fetch_add(&hist[eid1], 1u, __ATOMIC_RELAXED, __HIP_MEMORY_SCOPE_WORKGROUP);
            int* tr = tok + row * 8; tr[0] = eid0; tr[1] = eid1; ((float*)tr)[2] = p_top * inv; ((float*)tr)[3] = p_top * p2 * inv; tr[4] = s0; tr[5] = s1; ((float*)tr)[6] = rstd;
        }
    }
    __syncthreads();
    if (tid < 32) ctl[CW_BCNT + blockIdx.x * 32 + tid] = hist[tid];
}

__device__ __forceinline__ void p9_scatter(const bf16_t* x1, const float* gain, const float* mod, unsigned* ctl, int* tok, bf16_t* XB, LAS unsigned* sl, int gw, int ngw, int lane, int tid) {
    const int G = gridDim.x;
    { const int e = tid & 31, part = tid >> 5; unsigned sall = 0, sbef = 0;
      for (int bb = part; bb < G; bb += 16) { const unsigned v = ctl[CW_BCNT + bb * 32 + e]; sall += v; if (bb < (int)blockIdx.x) sbef += v; }
      sl[part * 32 + e] = sall; sl[512 + part * 32 + e] = sbef; }
    __syncthreads();
    if (tid < 64) {
        unsigned cnt = 0, bef = 0;
        if (lane < 32) for (int q = 0; q < 16; ++q) { cnt += sl[q * 32 + lane]; bef += sl[512 + q * 32 + lane]; }
        const unsigned padded = (cnt + 255u) & ~255u; unsigned incl = padded;
#pragma unroll
        for (int o = 1; o < 32; o <<= 1) { const unsigned t = __shfl_up(incl, o); if ((lane & 31) >= o) incl += t; }
        const unsigned excl = incl - padded;
        if (lane < 32) sl[1024 + lane] = excl + bef;
        if (blockIdx.x == 0) {
            const unsigned total = __shfl(incl, 31);
            if (lane == 0) ctl[CW_NBLK] = total >> 8;
            if (lane < 32) for (unsigned i = excl >> 8; i < (incl >> 8); ++i) ctl[CW_BLKE + i] = (unsigned)lane;
        }
    }
    __syncthreads();
    for (int blk = blockIdx.x; blk < TL / 128; blk += gridDim.x) {
        const int R0 = 128 * blk + 16 * (tid >> 6); const float* shift = mod + (R0 >> 11) * 6144 + 3072; const float* scale = shift + 1024;
        f32x4 G[4], S[4];
#pragma unroll
        for (int j = 0; j < 4; ++j) { const int k = lane * 4 + 256 * j; G[j] = *(const f32x4*)(gain + k) * (1.0f + *(const f32x4*)(scale + k)); S[j] = *(const f32x4*)(shift + k); }
#pragma unroll 4
        for (int rr = 0; rr < 16; ++rr) { const int row = R0 + rr; const int* tr = tok + row * 8;
            const int e0 = tr[0], e1 = tr[1]; const float rstd = ((const float*)tr)[6];
            const unsigned d0 = sl[1024 + e0] + (unsigned)tr[4], d1 = sl[1024 + e1] + (unsigned)tr[5];
            u32x2 w[4];
#pragma unroll
            for (int j = 0; j < 4; ++j) { const u32x2 xb = *(const u32x2*)(x1 + (size_t)row * D + lane * 4 + 256 * j); const f32x4 o = (f32x4){bflo(xb.x), bfhi(xb.x), bflo(xb.y), bfhi(xb.y)} * rstd * G[j] + S[j]; w[j].x = pk2(o.x, o.y); w[j].y = pk2(o.z, o.w); }
#pragma unroll
            for (int j = 0; j < 4; ++j) { *(u32x2*)(XB + (size_t)d0 * D + lane * 4 + 256 * j) = w[j]; *(u32x2*)(XB + (size_t)d1 * D + lane * 4 + 256 * j) = w[j]; }
            if (lane == 0) { tok[row * 8 + 4] = (int)d0; tok[row * 8 + 5] = (int)d1; } }
    }
}

__device__ __forceinline__ void p12_final(const bf16_t* x1, float* outp, const float* mod, const int* tok, const bf16_t* YB, const float* gfin, int gw, int ngw, int lane) {
    u32x2 nxv[4]; u32x2 nya[4], nyb[4]; float nw0 = 0.f, nw1 = 0.f; int t2d0 = 0, t2d1 = 0; float t2w0 = 0.f, t2w1 = 0.f;
    if (gw < TL) { const int d0 = tok[gw * 8 + 4], d1 = tok[gw * 8 + 5]; nw0 = ((const float*)tok)[gw * 8 + 2]; nw1 = ((const float*)tok)[gw * 8 + 3];
#pragma unroll
        for (int j = 0; j < 4; ++j) { const int k = lane * 4 + 256 * j; nxv[j] = *(const u32x2*)(x1 + (size_t)gw * D + k); nya[j] = *(const u32x2*)(YB + (size_t)d0 * D + k); nyb[j] = *(const u32x2*)(YB + (size_t)d1 * D + k); } }
    if (gw + ngw < TL) { const int r2 = gw + ngw; t2d0 = tok[r2 * 8 + 4]; t2d1 = tok[r2 * 8 + 5]; t2w0 = ((const float*)tok)[r2 * 8 + 2]; t2w1 = ((const float*)tok)[r2 * 8 + 3]; }
    for (int row = gw; row < TL; row += ngw) {
        const float* ga2 = mod + (row >> 11) * 6144 + 5120; float* dst = outp + (size_t)row * D;
        const float w0 = nw0, w1 = nw1;
        f32x4 xv[4]; u32x2 ya[4], yb[4];
#pragma unroll
        for (int j = 0; j < 4; ++j) { xv[j] = (f32x4){bflo(nxv[j].x), bfhi(nxv[j].x), bflo(nxv[j].y), bfhi(nxv[j].y)}; ya[j] = nya[j]; yb[j] = nyb[j]; }
        const int nrow = row + ngw;
        if (nrow < TL) { nw0 = t2w0; nw1 = t2w1;
#pragma unroll
            for (int j = 0; j < 4; ++j) { const int k = lane * 4 + 256 * j; nxv[j] = *(const u32x2*)(x1 + (size_t)nrow * D + k); nya[j] = *(const u32x2*)(YB + (size_t)t2d0 * D + k); nyb[j] = *(const u32x2*)(YB + (size_t)t2d1 * D + k); }
            const int r2 = nrow + ngw;
            if (r2 < TL) { t2d0 = tok[r2 * 8 + 4]; t2d1 = tok[r2 * 8 + 5]; t2w0 = ((const float*)tok)[r2 * 8 + 2]; t2w1 = ((const float*)tok)[r2 * 8 + 3]; } }
        f32x4 v[4]; float ss = 0.f;
#pragma unroll
        for (int j = 0; j < 4; ++j) { const int k = lane * 4 + 256 * j; const f32x4 g = *(const f32x4*)(ga2 + k); const u32x2 a = ya[j], bq = yb[j];
            f32x4 y; y.x = w0 * bflo(a.x) + w1 * bflo(bq.x); y.y = w0 * bfhi(a.x) + w1 * bfhi(bq.x); y.z = w0 * bflo(a.y) + w1 * bflo(bq.y); y.w = w0 * bfhi(a.y) + w1 * bfhi(bq.y);
            v[j] = xv[j] + g * y; ss += v[j].x * v[j].x + v[j].y * v[j].y + v[j].z * v[j].z + v[j].w * v[j].w; }
        const float rstd = rsqrtf(wave_sum_fast(ss) * (1.0f / D) + EPS);
#pragma unroll
        for (int j = 0; j < 4; ++j) { const int k = lane * 4 + 256 * j; const f32x4 g = *(const f32x4*)(gfin + k); *(f32x4*)(dst + k) = v[j] * rstd * g; }
    }
}

typedef float f32x16 __attribute__((ext_vector_type(16)));
typedef short v4i16_t __attribute__((ext_vector_type(4)));
using pg8::bf16x8;
constexpr int ATT_CK_OFF = 2048, ATT_CV_OFF = ATT_CK_OFF + 32768, ATT_RING_OFF = ATT_CV_OFF + 32768, ATT_SK_OFF = ATT_RING_OFF + 32768, ATT_SV_OFF = ATT_SK_OFF + 11 * 2048;
static_assert(ATT_SV_OFF + 11 * 2048 <= MISC_OFF, "attention LDS map");
__device__ __forceinline__ void p3_attn(const bf16_t* Qb, bf16_t* Ob, const bf16_t* Kb, const bf16_t* Vb, const float* rpb, const f32x2* rope, LAS unsigned char* lds, int wave, int lane) {
    constexpr float L2E = 1.4426950408889634f, SC = 0.125f * L2E;
    const int tid = wave * 64 + lane, ql = lane & 31, hl = lane >> 5, skey = tid >> 3, sch = tid & 7;
    LAS float* rpbL = (LAS float*)lds;
    const int vq = (lane & 15) >> 2, vcol = (16 * ((lane >> 4) & 1) + 4 * (lane & 3)) * 2;
    const int g = wave & 1, sside = skey >= 24 && skey < 40;
    for (int it = blockIdx.x; it < NBATCH * 8 * 2; it += gridDim.x) {
        const int rh = it & 1, h = (it >> 1) & 7, b = it >> 4;
        __syncthreads();
        if (tid < 15 * 32) { const int c = tid & 31, dr = tid >> 5; rpbL[tid] = c < 31 ? rpb[(h * 15 + dr) * 31 + c] * L2E : -1e30f; }
#pragma unroll
        for (int i = 0; i < 4; ++i) { const int key = skey + 64 * i; const size_t row = (size_t)(TL + b * CTXL + key) * 512 + h * 64 + 8 * sch;
            *(LAS u32x4*)(lds + ATT_CK_OFF + key * 128 + ((sch ^ (key & 7)) * 16)) = *(const u32x4*)(Kb + row);
            *(LAS u32x4*)(lds + ATT_CV_OFF + key * 128 + sch * 16) = *(const u32x4*)(Vb + row); }
#pragma unroll 1
        for (int pass = 0; pass < 4; ++pass) {
            const int R0 = 16 * rh + 4 * pass, r = R0 + (wave >> 1);
            const int cq = 32 * g + ql, rs = min(max(r - 4, 0), 24), cstart = min(max(cq - 8, 0), 48);
            const int kmin = min(max(R0 - 4, 0), 24), kmax = min(max(R0 - 1, 0), 24) + 7, nsteps = kmax - kmin + 1;
            const bf16_t* qp = Qb + (size_t)(b * SEQ + r * 64 + cq) * 512 + h * 64; bf16_t* op = Ob + (size_t)(b * SEQ + r * 64 + cq) * 512 + h * 64;
#define ATT_PUT(slot_, krel_, kv_, vv_) do { *(LAS u32x4*)(lds + (slot_) + skey * 128 + ((sch ^ (skey & 7)) * 16)) = (kv_); *(LAS u32x4*)(lds + (slot_) + 8192 + skey * 128 + sch * 16) = (vv_); \
                if (sside) { *(LAS u32x4*)(lds + ATT_SK_OFF + ((krel_) * 16 + skey - 24) * 128 + ((sch ^ (skey & 7)) * 16)) = (kv_); *(LAS u32x4*)(lds + ATT_SV_OFF + ((krel_) * 16 + skey - 24) * 128 + sch * 16) = (vv_); } } while (0)
            { const size_t row = (size_t)(b * SEQ + kmin * 64 + skey) * 512 + h * 64 + 8 * sch; const u32x4 kv = *(const u32x4*)(Kb + row), vv = *(const u32x4*)(Vb + row); ATT_PUT(ATT_RING_OFF, 0, kv, vv); }
            bf16x8 qplain[4], qrot[4];
#pragma unroll
            for (int d0 = 0; d0 < 4; ++d0) { float v[8], o[8], pl[8]; unpack8(*(const u32x4*)(qp + 16 * d0 + 8 * hl), v);
                const int pos = d0 < 2 ? r : cq, i0 = ((16 * d0 + 8 * hl) & 31) >> 1;
#pragma unroll
                for (int j = 0; j < 4; ++j) { const f32x2 cs = rope[pos * 16 + i0 + j]; o[2 * j] = (v[2 * j] * cs.x - v[2 * j + 1] * cs.y) * SC; o[2 * j + 1] = (v[2 * j] * cs.y + v[2 * j + 1] * cs.x) * SC; }
#pragma unroll
                for (int j = 0; j < 8; ++j) pl[j] = v[j] * SC;
                qrot[d0] = __builtin_bit_cast(bf16x8, pack8(o)); qplain[d0] = __builtin_bit_cast(bf16x8, pack8(pl)); }
            int dco[16];
#pragma unroll
            for (int i = 0; i < 16; ++i) { const int kc = 32 * g + (i & 3) + 8 * (i >> 2) + 4 * hl; const bool ok = kc >= cstart && kc < cstart + 16; dco[i] = ok ? (kc - cq + 15) * 4 : 31 * 4; }
            f32x16 o0, o1;
#pragma unroll
            for (int i = 0; i < 16; ++i) { o0[i] = 0.f; o1[i] = 0.f; }
            float m = -1e30f, l = 0.f;
#define ATT_TILE(kp_, vb_, vsk_, ve_, qf) do { \
            _Pragma("unroll") for (int d0 = 0; d0 < 4; ++d0) s = __builtin_amdgcn_mfma_f32_32x32x16_bf16(*(const LAS bf16x8*)((kp_) + (((2 * d0 + hl) ^ (ql & 7)) * 16)), qf[d0], s, 0, 0, 0); \
            float mt = fmaxf(fmaxf(s[0], s[1]), s[2]); \
            _Pragma("unroll") for (int i = 3; i < 15; i += 2) mt = fmaxf(fmaxf(mt, s[i]), s[i + 1]); \
            mt = half_max(fmaxf(mt, s[15])); \
            if (__any(mt > m)) { const float mn = fmaxf(m, mt), alpha = __builtin_amdgcn_exp2f(m - mn); m = mn; l *= alpha; \
                _Pragma("unroll") for (int i = 0; i < 16; ++i) { o0[i] *= alpha; o1[i] *= alpha; } } \
            float ps = 0.f; \
            _Pragma("unroll") for (int i = 0; i < 16; ++i) { s[i] = __builtin_amdgcn_exp2f(s[i] - m); ps += s[i]; } \
            l += ps; \
            bf16x8 pb[2]; \
            _Pragma("unroll") for (int sk = 0; sk < 2; ++sk) { u32x4 w; w.x = pk2(s[8 * sk], s[8 * sk + 1]); w.y = pk2(s[8 * sk + 2], s[8 * sk + 3]); w.z = pk2(s[8 * sk + 4], s[8 * sk + 5]); w.w = pk2(s[8 * sk + 6], s[8 * sk + 7]); \
                pb[sk] = __builtin_bit_cast(bf16x8, w); } \
            _Pragma("unroll") for (int dt = 0; dt < 2; ++dt) _Pragma("unroll") for (int sk = 0; sk < 2; ++sk) { \
                const v4i16_t lo = __builtin_amdgcn_ds_read_tr16_b64_v4i16((LAS v4i16_t*)((vb_) + sk * (vsk_) + dt * 64)); \
                const v4i16_t hi = __builtin_amdgcn_ds_read_tr16_b64_v4i16((LAS v4i16_t*)((vb_) + sk * (vsk_) + (ve_) + dt * 64)); \
                const bf16x8 va = (bf16x8){lo[0], lo[1], lo[2], lo[3], hi[0], hi[1], hi[2], hi[3]}; \
                if (dt == 0) o0 = __builtin_amdgcn_mfma_f32_32x32x16_bf16(va, pb[sk], o0, 0, 0, 0); else o1 = __builtin_amdgcn_mfma_f32_32x32x16_bf16(va, pb[sk], o1, 0, 0, 0); } } while (0)
            __syncthreads();
#pragma unroll 1
            for (int st = 0; st < nsteps; ++st) {
                const int kr = kmin + st, slot = ATT_RING_OFF + (st & 1) * 16384;
                u32x4 nk, nv; const bool more = st + 1 < nsteps;
                if (more) { const size_t row = (size_t)(b * SEQ + (kr + 1) * 64 + skey) * 512 + h * 64 + 8 * sch; nk = *(const u32x4*)(Kb + row); nv = *(const u32x4*)(Vb + row); }
                if (kr >= rs && kr < rs + 8) {
                    const LAS unsigned char* brow = (const LAS unsigned char*)(rpbL + (kr - r + 7) * 32);
                    f32x16 s;
#pragma unroll
                    for (int i = 0; i < 16; ++i) s[i] = *(const LAS float*)(brow + dco[i]);
                    const LAS unsigned char* kp = lds + slot + g * 4096 + ql * 128; const LAS unsigned char* vb = lds + slot + 8192 + g * 4096 + (4 * hl + vq) * 128 + vcol;
                    ATT_TILE(kp, vb, 2048, 1024, qrot);
                }
                if (more) { const int ns = ATT_RING_OFF + ((st + 1) & 1) * 16384; ATT_PUT(ns, st + 1, nk, nv); }
                __syncthreads();
            }
#pragma unroll 1
            for (int x = 0; x < 2; ++x) {
                const int cb = g == 0 ? 8 : 0, krel0 = rs + 4 * x - kmin;
                f32x16 s;
#pragma unroll
                for (int i = 0; i < 16; ++i) { const int kc = 24 + cb + (i & 3) + 4 * hl, dr = rs + 4 * x + (i >> 2) - r + 7; const bool ok = kc >= cstart && kc < cstart + 16;
                    s[i] = ok ? rpbL[dr * 32 + (kc - cq + 15)] : -1e30f; }
                const LAS unsigned char* kp = lds + ATT_SK_OFF + ((krel0 + (ql >> 3)) * 16 + cb + (ql & 7)) * 128;
                const LAS unsigned char* vb = lds + ATT_SV_OFF + (krel0 * 16 + cb + 4 * hl + vq) * 128 + vcol;
                ATT_TILE(kp, vb, 4096, 2048, qrot);
            }
            __syncthreads();
#pragma unroll 1
            for (int ct = 0; ct < 8; ++ct) { f32x16 s;
#pragma unroll
                for (int i = 0; i < 16; ++i) s[i] = 0.f;
                const LAS unsigned char* kp = lds + ATT_CK_OFF + ct * 4096 + ql * 128; const LAS unsigned char* vb = lds + ATT_CV_OFF + ct * 4096 + (4 * hl + vq) * 128 + vcol;
                ATT_TILE(kp, vb, 2048, 1024, qplain); }
#undef ATT_TILE
#undef ATT_PUT
            l = half_sum(l);
            const float il = 1.0f / l;
#pragma unroll
            for (int dt = 0; dt < 2; ++dt)
#pragma unroll
                for (int g4 = 0; g4 < 4; ++g4) { u32x2 w;
                    if (dt == 0) { w.x = pk2(o0[4 * g4] * il, o0[4 * g4 + 1] * il); w.y = pk2(o0[4 * g4 + 2] * il, o0[4 * g4 + 3] * il); }
                    else { w.x = pk2(o1[4 * g4] * il, o1[4 * g4 + 1] * il); w.y = pk2(o1[4 * g4 + 2] * il, o1[4 * g4 + 3] * il); }
                    *(u32x2*)(op + 32 * dt + 8 * g4 + 4 * hl) = w; }
        }
    }
}

constexpr int LRU_WLDS = 8192;
constexpr int LRU_TILES = 72;
__device__ __forceinline__ void lru_conv_frags(const bf16_t* LX, const float* conv_w, const float* conv_b, size_t rowbase, int L, int s0, int n, int lane, bf16x8 (&afr)[8], bf16_t* XC) {
    const int token = lane & 31, hl = lane >> 5, s = s0 + token;
    u32x4 xr[2][2][4];
#define LRU_LDPAIR(pp, buf) do { _Pragma("unroll") for (int q = 0; q < 2; ++q) _Pragma("unroll") for (int j = 0; j < 4; ++j) { const int sj = s + j - 2; xr[buf][q][j] = (u32x4){0u, 0u, 0u, 0u}; \
        if (sj >= 0 && sj < L) xr[buf][q][j] = *(const u32x4*)(LX + (rowbase + sj) * 1024 + n * 128 + 16 * (2 * (pp) + q) + 8 * hl); } } while (0)
    LRU_LDPAIR(0, 0);
#pragma unroll
    for (int pp = 0; pp < 4; ++pp) {
        if (pp < 3) LRU_LDPAIR(pp + 1, (pp + 1) & 1);
        __builtin_amdgcn_sched_barrier(0);
#pragma unroll
        for (int q = 0; q < 2; ++q) { const int ch0 = n * 128 + 16 * (2 * pp + q) + 8 * hl;
            float acc[8];
            { const f32x4 b0 = *(const f32x4*)(conv_b + ch0), b1 = *(const f32x4*)(conv_b + ch0 + 4); acc[0] = b0.x; acc[1] = b0.y; acc[2] = b0.z; acc[3] = b0.w; acc[4] = b1.x; acc[5] = b1.y; acc[6] = b1.z; acc[7] = b1.w; }
#pragma unroll
            for (int j = 0; j < 4; ++j) { float xv[8]; unpack8(xr[pp & 1][q][j], xv);
                const f32x4 w0 = *(const f32x4*)(conv_w + j * 1024 + ch0), w1 = *(const f32x4*)(conv_w + j * 1024 + ch0 + 4);
                acc[0] += w0.x * xv[0]; acc[1] += w0.y * xv[1]; acc[2] += w0.z * xv[2]; acc[3] += w0.w * xv[3]; acc[4] += w1.x * xv[4]; acc[5] += w1.y * xv[5]; acc[6] += w1.z * xv[6]; acc[7] += w1.w * xv[7]; }
            const u32x4 pk = pack8(acc); afr[2 * pp + q] = __builtin_bit_cast(bf16x8, pk);
            if (XC) *(u32x4*)(XC + (rowbase + s) * 1024 + ch0) = pk; }
        __builtin_amdgcn_sched_barrier(0);
    }
#undef LRU_LDPAIR
}
template <int DIR>
__device__ __forceinline__ void lru_group_dir(const f32x16& accr, const f32x16& acci, const f32x16& xv, float bav, float bxv, float sp, float hin0, int hl, float (&hloc)[16], float& At, float& Ht) {
    float aloc[16], As[4], Hs[4];
#pragma unroll
    for (int g = 0; g < 4; ++g) { float h = 0.f, A = 1.f;
#pragma unroll
        for (int ee = 0; ee < 4; ++ee) { const int e4 = DIR == 0 ? ee : 3 - ee, i = 4 * g + e4;
            const float rg = __builtin_amdgcn_rcpf(1.0f + __builtin_amdgcn_exp2f(accr[i] + bav)), ig = __builtin_amdgcn_rcpf(1.0f + __builtin_amdgcn_exp2f(acci[i] + bxv));
            const float a = __builtin_amdgcn_exp2f(rg * sp), u = __builtin_amdgcn_sqrtf(__builtin_fmaf(-a, a, 1.0f)) * (ig * xv[i]);
            h = a * h + u; A *= a; hloc[i] = h; aloc[i] = A; }
        As[g] = A; Hs[g] = h; }
    float Alo[4], Ahi[4], Hlo[4], Hhi[4];
#pragma unroll
    for (int g = 0; g < 4; ++g) { const auto ra = __builtin_amdgcn_permlane32_swap(__float_as_uint(As[g]), __float_as_uint(As[g]), false, false); Alo[g] = __uint_as_float(ra[0]); Ahi[g] = __uint_as_float(ra[1]);
        const auto rh = __builtin_amdgcn_permlane32_swap(__float_as_uint(Hs[g]), __float_as_uint(Hs[g]), false, false); Hlo[g] = __uint_as_float(rh[0]); Hhi[g] = __uint_as_float(rh[1]); }
    float hin[4]; float st = hin0, Ap = 1.f, st0 = 0.f;
#pragma unroll
    for (int gg = 0; gg < 4; ++gg) { const int g = DIR == 0 ? gg : 3 - gg;
        const float A1 = DIR == 0 ? Alo[g] : Ahi[g], H1 = DIR == 0 ? Hlo[g] : Hhi[g], A2 = DIR == 0 ? Ahi[g] : Alo[g], H2 = DIR == 0 ? Hhi[g] : Hlo[g];
        const float in1 = st; st = A1 * st + H1; st0 = A1 * st0 + H1; const float in2 = st; st = A2 * st + H2; st0 = A2 * st0 + H2; Ap *= A1 * A2;
        hin[g] = (DIR == 0) == (hl == 0) ? in1 : in2; }
    At = Ap; Ht = st0;
#pragma unroll
    for (int i = 0; i < 16; ++i) hloc[i] += aloc[i] * hin[i >> 2];
}
constexpr int LRU_CONST_OFF = 131072;
template <int MODE>
__device__ __forceinline__ void p_lru(const bf16_t* LX, const bf16_t* LW, const float* conv_w, const float* conv_b, const float* ba, const float* bx, const float* SP, f32x2* AGG, bf16_t* XC, const bf16_t* LG, bf16_t* OL,
                                      LAS unsigned char* lds, int wave, int lane, int abl = 0) {
    const int G = gridDim.x, n = blockIdx.x & 7, ql = lane & 31, hl = lane >> 5, tid = wave * 64 + lane;
    LAS float* cst = (LAS float*)(lds + LRU_CONST_OFF);
    for (int idx = tid; idx < 2 * 256 * 16; idx += NTHREADS) { const int dir = idx >> 12, j = (idx >> 4) & 255, c = idx & 15;
        *(LAS u32x4*)(lds + (dir * 256 + j) * 256 + ((c ^ (j & 15)) * 16)) = *(const u32x4*)(LW + ((size_t)(dir * 8 + n) * 256 + j) * 128 + 8 * c); }
    for (int idx = tid; idx < 2 * 3 * 128; idx += NTHREADS) { const int dir = idx / 384, w = (idx / 128) % 3, c = idx & 127; const float* src = w == 0 ? ba : w == 1 ? bx : SP; cst[idx] = src[dir * 1024 + n * 128 + c] * (w == 2 ? -8.0f * 1.4426950408889634f : -1.4426950408889634f); }
    __syncthreads();
    const int tiles_per_b = MODE == 1 ? LRU_TILES : 64, nq = 16 * tiles_per_b, stride = (G >> 3) * NWAVES;
    for (int q = (blockIdx.x >> 3) * NWAVES + wave; q < nq; q += stride) {
        const int b = q / tiles_per_b, tile = MODE == 1 ? q % tiles_per_b : 8 + q % tiles_per_b;
        const size_t rowbase = tile < 8 ? (size_t)(TL + b * CTXL) : (size_t)b * SEQ; const int L = tile < 8 ? CTXL : SEQ, s0 = tile < 8 ? tile * 32 : (tile - 8) * 32;
        bf16x8 afr[8];
        if (MODE == 1) lru_conv_frags(LX, conv_w, conv_b, rowbase, L, s0, n, lane, afr, XC);
        else {
#pragma unroll
            for (int ks = 0; ks < 8; ++ks) afr[ks] = *(const bf16x8*)(XC + (abl == 4 ? (size_t)ql * 1024 : (rowbase + s0 + ql) * 1024 + n * 128) + 16 * ks + 8 * hl); }
#pragma unroll 1
        for (int cg = 0; cg < 4; ++cg) {
            const bf16x8 ax0 = cg == 0 ? afr[0] : cg == 1 ? afr[2] : cg == 2 ? afr[4] : afr[6], ax1 = cg == 0 ? afr[1] : cg == 1 ? afr[3] : cg == 2 ? afr[5] : afr[7];
            const int cl = cg * 32 + ql;
            float hinf = 0.f, hinb = 0.f;
            if (MODE == 2) { hinf = AGG[((size_t)b * LRU_TILES + tile) * 1024 + n * 128 + cl].x; hinb = AGG[((size_t)(16 + b) * LRU_TILES + tile) * 1024 + n * 128 + cl].x; }
            unsigned short gq[16];
            f32x16 xv;
#pragma unroll
            for (int i = 0; i < 16; ++i) xv[i] = 0.f;
            { bf16x8 idf[2];
#pragma unroll
              for (int kk = 0; kk < 2; ++kk)
#pragma unroll
                  for (int j = 0; j < 8; ++j) idf[kk][j] = (16 * kk + 8 * hl + j == ql) ? (short)0x3F80 : (short)0;
              xv = __builtin_amdgcn_mfma_f32_32x32x16_bf16(ax0, idf[0], xv, 0, 0, 0); xv = __builtin_amdgcn_mfma_f32_32x32x16_bf16(ax1, idf[1], xv, 0, 0, 0); }
            float hsum[16];
#pragma unroll
            for (int dir = 0; dir < 2; ++dir) {
                const LAS unsigned char* wr = lds + (dir * 256 + cl) * 256; const LAS unsigned char* wi = wr + 128 * 256;
                f32x16 accr, acci;
#pragma unroll
                for (int i = 0; i < 16; ++i) { accr[i] = 0.f; acci[i] = 0.f; }
                if (abl != 2) { bf16x8 bw[8];
#pragma unroll
                  for (int k = 0; k < 8; ++k) bw[k] = *(const LAS bf16x8*)(wr + (((2 * k + hl) ^ (cl & 15)) * 16));
#pragma unroll
                  for (int k = 0; k < 8; ++k) accr = __builtin_amdgcn_mfma_f32_32x32x16_bf16(afr[k], bw[k], accr, 0, 0, 0);
                  __builtin_amdgcn_sched_barrier(0);
#pragma unroll
                  for (int k = 0; k < 8; ++k) bw[k] = *(const LAS bf16x8*)(wi + (((2 * k + hl) ^ (cl & 15)) * 16));
#pragma unroll
                  for (int k = 0; k < 8; ++k) acci = __builtin_amdgcn_mfma_f32_32x32x16_bf16(afr[k], bw[k], acci, 0, 0, 0); }
                __builtin_amdgcn_sched_barrier(0);
                const float bav = cst[dir * 384 + cl], bxv = cst[dir * 384 + 128 + cl], sp = cst[dir * 384 + 256 + cl];
                const float hin0 = dir == 0 ? hinf : hinb;
                if (MODE == 2 && dir == 1 && abl != 3) {
#pragma unroll
                    for (int i = 0; i < 16; ++i) gq[i] = LG[(rowbase + s0 + (i & 3) + 8 * (i >> 2) + 4 * hl) * 1024 + n * 128 + cl]; }
                float hout[16], At, Ht;
                if (abl == 1) { _Pragma("unroll") for (int i = 0; i < 16; ++i) hout[i] = accr[i] + acci[i] * xv[i] + hin0 + bav + bxv + sp; At = 1.f; Ht = 0.f; }
                else if (dir == 0) lru_group_dir<0>(accr, acci, xv, bav, bxv, sp, hin0, hl, hout, At, Ht);
                else lru_group_dir<1>(accr, acci, xv, bav, bxv, sp, hin0, hl, hout, At, Ht);
                if (MODE == 1) { if (hl == 0) AGG[((size_t)(dir * 16 + b) * LRU_TILES + tile) * 1024 + n * 128 + cl] = (f32x2){At, Ht}; }
                else {
#pragma unroll
                    for (int i = 0; i < 16; ++i) hsum[i] = dir == 0 ? hout[i] : hsum[i] + hout[i]; }
            }
            if (MODE == 2) {
                if (abl == 3) { float t_ = 0.f; _Pragma("unroll") for (int i = 0; i < 16; ++i) t_ += hsum[i]; if (t_ == 123.456f) OL[0] = 0; }
                else {
#pragma unroll
                for (int i = 0; i < 16; ++i) OL[(rowbase + s0 + (i & 3) + 8 * (i >> 2) + 4 * hl) * 1024 + n * 128 + cl] = (bf16_t)f2bf(hsum[i] * bf2f(gq[i]));
                }
            }
        }
    }
}
__device__ __forceinline__ void p_lru_carry(f32x2* AGG, int tid) {
    const int gid = blockIdx.x * NTHREADS + tid;
    if (gid >= 2 * 16 * 1024) return;
    const int dir = gid >> 14, b = (gid >> 10) & 15, ch = gid & 1023;
    f32x2* base = AGG + (size_t)(dir * 16 + b) * LRU_TILES * 1024 + ch;
    float h = 0.f;
#pragma unroll 1
    for (int s0 = 0; s0 < LRU_TILES; s0 += 24) {
        f32x2 v[24];
#pragma unroll
        for (int s = 0; s < 24; ++s) { const int st = s0 + s, tile = dir == 0 ? st : (st < 8 ? 7 - st : 79 - st); v[s] = base[(size_t)tile * 1024]; }
#pragma unroll
        for (int s = 0; s < 24; ++s) { const int st = s0 + s, tile = dir == 0 ? st : (st < 8 ? 7 - st : 79 - st); base[(size_t)tile * 1024].x = h; h = v[s].x * h + v[s].y; }
    }
}

__device__ __forceinline__ unsigned char* lds_ptr(LAS unsigned char* ldsl, int i) {
    const LAS unsigned* t = (const LAS unsigned*)(ldsl + MISC_OFF + 1024) + 2 * i;
    const unsigned lo = __builtin_amdgcn_readfirstlane(t[0]), hi = __builtin_amdgcn_readfirstlane(t[1]);
    return (unsigned char*)(__attribute__((address_space(1))) unsigned char*)(((unsigned long long)hi << 32) | lo);
}
struct MArgs { const float* in[28]; float* out; unsigned char* ws; int ph_lo, ph_hi, li, extra; };
__global__ void __launch_bounds__(NTHREADS, 2) mega(MArgs a) {
    extern __shared__ __attribute__((aligned(16))) unsigned char lds[];
    const int wave = __builtin_amdgcn_readfirstlane(threadIdx.x >> 6);
#define LANE ((int)__builtin_amdgcn_mbcnt_hi(~0u, __builtin_amdgcn_mbcnt_lo(~0u, 0u)))
#define TID (wave * 64 + LANE)
    const int G = gridDim.x, gw = blockIdx.x * NWAVES + wave, ngw = G * NWAVES;
    LAS unsigned char* ldsl = (LAS unsigned char*)lds;
    volatile LAS unsigned* MISC = (volatile LAS unsigned*)(ldsl + MISC_OFF);
    for (int u = TID; u < (LDS_BYTES - MISC_OFF) / 4; u += NTHREADS) ((LAS unsigned*)(ldsl + MISC_OFF))[u] = 0u;
    __syncthreads();
    { LAS unsigned long long* pt = (LAS unsigned long long*)(ldsl + MISC_OFF + 1024);
      const int tid = TID;
      if (tid < 28) pt[tid] = (unsigned long long)a.in[tid];
      if (tid == 28) pt[28] = (unsigned long long)(a.extra ? (float*)(a.ws + WS_XB) : a.out);
      if (tid == 29) pt[29] = (unsigned long long)a.ws; }
    XcdBarrier bar = xcd_barrier_post((unsigned*)(a.ws + WS_CTL) + CW_BAR + a.li * XCD_BAR_WORDS, MISC + 8, wave == 0 && LANE == 0);
    const int lo = a.ph_lo, hi = a.ph_hi, extra = a.extra;
    __syncthreads();
#define PTR(i) ((const float*)lds_ptr(ldsl, (i)))
#define OUTP ((float*)lds_ptr(ldsl, 28))
#define WSP(off) (lds_ptr(ldsl, 29) + (off))
#define IN(k) (lo <= (k) && (k) < hi)
#define SEAM(k) do { if (IN(k) && IN((k) + 1)) xcd_barrier(bar, wave); } while (0)
    if (IN(0)) { unsigned char* ws = WSP(0); p0_prep(ws, ldsl, gw, ngw, LANE, wave); __syncthreads();
        p0_mod(PTR(1), PTR(3), PTR(4), PTR(5), PTR(20), PTR(22), (f32x4*)(ws + WS_MOD + 600 * 1024), PTR(16), (float*)(ws + WS_MOD + 760 * 1024), (float*)(ws + WS_MOD), (f32x2*)(ws + WS_MOD + 512 * 1024), (LAS float*)ldsl, TID); }
    SEAM(0);
    if (IN(1)) { unsigned char* ws = WSP(0); p1_router_tables(PTR(7), (const float*)(ws + WS_MOD), (const f32x4*)(ws + WS_MOD + 600 * 1024), PTR(21), PTR(23), (float*)(ws + WS_RWT), (float*)(ws + WS_RWT + 3 * MiB), gw, ngw, LANE);
        p1_adanorm(PTR(0), PTR(2), PTR(6), (const float*)(ws + WS_MOD), (bf16_t*)OUTP, gw, ngw, LANE); }
    SEAM(1);
    if (IN(2)) { unsigned char* ws = WSP(0); pg8::Gemm g{(const bf16_t*)OUTP, (const bf16_t*)(ws + WS_WIN), TALL, PROJ, 1024}; ProjOrder S; S.init(G, (int)blockIdx.x);
        EpiF<EpiProj> E{{(bf16_t*)(ws + WS_K), (bf16_t*)(ws + WS_V), (bf16_t*)(ws + WS_LX), (bf16_t*)(ws + WS_Q), (bf16_t*)(ws + WS_LG), (bf16_t*)(ws + WS_GA), (bf16_t*)(ws + WS_GB), (const f32x2*)(ws + WS_MOD + 512 * 1024)}};
        pg8::gemm_phase<EpiF<EpiProj>, ProjOrder, true, true>(ldsl, g, S, E, wave); }
    SEAM(2);
    if (IN(3)) { unsigned char* ws = WSP(0); bf16_t* LGb = (bf16_t*)(ws + WS_LG);
        p_lru<1>((const bf16_t*)(ws + WS_LX), (const bf16_t*)(ws + WS_LW), PTR(10), PTR(11), PTR(13), PTR(15), (const float*)(ws + WS_MOD + 760 * 1024), (f32x2*)OUTP, (bf16_t*)((unsigned char*)OUTP + 24 * MiB), LGb, LGb, ldsl, wave, LANE);
        __syncthreads(); }
    if (IN(3) || extra == 2) { unsigned char* ws = WSP(0); bf16_t* Qb = (bf16_t*)(ws + WS_Q);
        p3_attn(Qb, Qb, (const bf16_t*)(ws + WS_K), (const bf16_t*)(ws + WS_V), PTR(9), (const f32x2*)(ws + WS_MOD + 512 * 1024), ldsl, wave, LANE); }
    SEAM(3);
    if (IN(4)) p_lru_carry((f32x2*)OUTP, TID);
    if (IN(4)) { unsigned char* ws = WSP(0); bf16_t* GAb = (bf16_t*)(ws + WS_GA); pg8::Gemm g{(const bf16_t*)(ws + WS_Q), (const bf16_t*)(ws + WS_WA), TL, 1024, 512}; pg8::StaticOrder S; S.init(TL, 1024, G, (int)blockIdx.x); EpiF2<EpiUpAttn> E{{GAb, GAb}};
        pg8::gemm_phase<EpiF2<EpiUpAttn>, pg8::StaticOrder, true, true>(ldsl, g, S, E, wave); }
    SEAM(4);
    if (IN(5)) { unsigned char* ws = WSP(0); bf16_t* LGb = (bf16_t*)(ws + WS_LG);
        p_lru<2>((const bf16_t*)(ws + WS_LX), (const bf16_t*)(ws + WS_LW), PTR(10), PTR(11), PTR(13), PTR(15), (const float*)(ws + WS_MOD + 760 * 1024), (f32x2*)OUTP, (bf16_t*)((unsigned char*)OUTP + 24 * MiB), LGb, LGb, ldsl, wave, LANE, extra >= 10 ? extra - 10 : 0); }
    SEAM(5);
    if (IN(6)) { unsigned char* ws = WSP(0); bf16_t* GBb = (bf16_t*)(ws + WS_GB); pg8::Gemm g{(const bf16_t*)(ws + WS_LG), (const bf16_t*)(ws + WS_WL), TL, 1024, 1024}; pg8::StaticOrder S; S.init(TL, 1024, G, (int)blockIdx.x);
        EpiF2<EpiUpLru> E{{(const bf16_t*)(ws + WS_GA), GBb, GBb}};
        pg8::gemm_phase<EpiF2<EpiUpLru>, pg8::StaticOrder, true, true>(ldsl, g, S, E, wave); }
    SEAM(6);
    if (IN(7)) { unsigned char* ws = WSP(0); pg8::Gemm g{(const bf16_t*)(ws + WS_GB), (const bf16_t*)(ws + WS_WO), TL, 1024, 1024}; pg8::StaticOrder S; S.init(TL, 1024, G, (int)blockIdx.x);
        EpiF2<EpiOut> E{{PTR(0), (const float*)(ws + WS_MOD), (bf16_t*)(ws + WS_X1B)}};
        pg8::gemm_phase<EpiF2<EpiOut>, pg8::StaticOrder, true, true>(ldsl, g, S, E, wave); }
    SEAM(7);
    if (IN(8)) { unsigned char* ws = WSP(0);
        p8_route((const bf16_t*)(ws + WS_X1B), (const float*)(ws + WS_RWT), (const float*)(ws + WS_RWT + 3 * MiB), (unsigned*)(ws + WS_CTL), (int*)(ws + WS_TOK), ldsl, LANE, TID, wave); }
    SEAM(8);
    if (IN(9)) { unsigned char* ws = WSP(0); p9_scatter((const bf16_t*)(ws + WS_X1B), PTR(7), (const float*)(ws + WS_MOD), (unsigned*)(ws + WS_CTL), (int*)(ws + WS_TOK), (bf16_t*)(ws + WS_XB), (LAS unsigned*)ldsl, gw, ngw, LANE, TID); }
    SEAM(9);
    if (IN(10)) { unsigned char* ws = WSP(0); pg8::Gemm g{(const bf16_t*)(ws + WS_XB), (const bf16_t*)(ws + WS_W13), MOE_ROWS, 1024, 1024}; MoeOrder S; S.init((const unsigned*)(ws + WS_CTL), G, (int)blockIdx.x, (size_t)1024 * 1024 * 2);
        EpiF<EpiMoe1> E{{(bf16_t*)OUTP}};
        pg8::gemm_phase<EpiF<EpiMoe1>, MoeOrder, true, true>(ldsl, g, S, E, wave); }
    SEAM(10);
    if (IN(11)) { unsigned char* ws = WSP(0); pg8::Gemm g{(const bf16_t*)OUTP, (const bf16_t*)(ws + WS_W2), MOE_ROWS, 1024, 512}; MoeOrder S; S.init((const unsigned*)(ws + WS_CTL), G, (int)blockIdx.x, (size_t)1024 * 512 * 2);
        EpiF<EpiMoe2> E{{(bf16_t*)(ws + WS_YB)}};
        pg8::gemm_phase<EpiF<EpiMoe2>, MoeOrder, true, true>(ldsl, g, S, E, wave); }
    SEAM(11);
    if (IN(12)) { unsigned char* ws = WSP(0); p12_final((const bf16_t*)(ws + WS_X1B), OUTP, (const float*)(ws + WS_MOD), (const int*)(ws + WS_TOK), (const bf16_t*)(ws + WS_YB), PTR(27), gw, ngw, LANE); }
#undef PTR
#undef OUTP
#undef WSP
#undef LANE
#undef TID
#undef IN
#undef SEAM
}

extern "C" void kernel_launch(void* const* d_in, const int* in_sizes, int n_in, void* d_out, int out_size, void* d_ws, size_t ws_size, hipStream_t stream) {
    static int grid = 0;
    if (grid == 0) {
        if (n_in != 28 || out_size != TL * D || ws_size < WS_END) { fprintf(stderr, "kernel_launch: unexpected problem (n_in %d, out %d, ws %zu < %zu)\n", n_in, out_size, ws_size, (size_t)WS_END); grid = -1; return; }
        int dev = 0, cus = 0, per_cu = 0;
        if (hipGetDevice(&dev) != hipSuccess || hipDeviceGetAttribute(&cus, hipDeviceAttributeMultiprocessorCount, dev) != hipSuccess) { grid = -1; return; }
        if (hipFuncSetAttribute((const void*)mega, hipFuncAttributeMaxDynamicSharedMemorySize, LDS_BYTES) != hipSuccess) { fprintf(stderr, "kernel_launch: hipFuncSetAttribute failed\n"); grid = -1; return; }
        if (hipOccupancyMaxActiveBlocksPerMultiprocessor(&per_cu, (const void*)mega, NTHREADS, LDS_BYTES) != hipSuccess || per_cu < 1) { fprintf(stderr, "kernel_launch: occupancy query says %d blocks per CU\n", per_cu); grid = -1; return; }
        (void)hipGetLastError();
        grid = cus;
    }
    if (grid < 0) return;
    const float* const* in = (const float* const*)d_in;
    unsigned char* ws = (unsigned char*)d_ws; float* out = (float*)d_out;
    f32x2* rope = (f32x2*)(ws + WS_MOD + 512 * 1024);
    bf16_t* WinT = (bf16_t*)(ws + WS_WIN); bf16_t* WaT = (bf16_t*)(ws + WS_WA); bf16_t* WlT = (bf16_t*)(ws + WS_WL); bf16_t* WoT = (bf16_t*)(ws + WS_WO); bf16_t* LW = (bf16_t*)(ws + WS_LW);
    bf16_t* W13T = (bf16_t*)(ws + WS_W13); bf16_t* W2T = (bf16_t*)(ws + WS_W2);
    bf16_t* Kb = (bf16_t*)(ws + WS_K); bf16_t* Vb = (bf16_t*)(ws + WS_V); bf16_t* LXb = (bf16_t*)(ws + WS_LX); bf16_t* Qb = (bf16_t*)(ws + WS_Q); bf16_t* LGb = (bf16_t*)(ws + WS_LG);

    (void)hipMemsetAsync(ws + WS_CTL, 0, CTL_ZERO_BYTES, stream);
    MArgs a{};
    for (int i = 0; i < 28; ++i) a.in[i] = in[i];
    a.out = out; a.ws = ws;
    auto launch = [&](int lo, int hi, int li, int extra) {
        a.ph_lo = lo; a.ph_hi = hi; a.li = li; a.extra = extra; void* args[] = {&a};
        const hipError_t e = hipLaunchCooperativeKernel((const void*)mega, dim3(grid), dim3(NTHREADS), args, LDS_BYTES, stream);
        if (e != hipSuccess) fprintf(stderr, "kernel_launch: cooperative launch failed: %s (grid %d)\n", hipGetErrorString(e), grid);
    };
    launch(0, 13, 0, 0);
    EXTRA_LAUNCHES
}
```

```cpp
#include <hip/hip_runtime.h>
#include <cstdio>
#include <cstdint>

typedef float f32x2 __attribute__((ext_vector_type(2)));
typedef unsigned u32x2 __attribute__((ext_vector_type(2)));
#define EXTRA_LAUNCHES
namespace pg8 {
#define PG8_LAS __attribute__((address_space(3)))
typedef unsigned short bf16_t;
typedef short bf16x8 __attribute__((ext_vector_type(8)));
typedef float f32x4 __attribute__((ext_vector_type(4)));
typedef unsigned u32x4 __attribute__((ext_vector_type(4)));
constexpr int BM = 256, BK = 64, HALF = 128, HTB = HALF * BK * 2  , STAGE_BYTES = 8 * HTB, NXCD = 8, WGM = 8;

__host__ __device__ __forceinline__ int lds_byte(int r, int c) { const int st = (r >> 4) * 2 + (c >> 5), rr = r & 15, cc = c & 31, ob = rr * 64 + cc * 2; return st * 1024 + (ob ^ (((ob >> 9) & 1) << 5)); }
__host__ __device__ __forceinline__ void stage_rc(int b, int& R, int& C) { const int st = b / 1024, sb = b % 1024, swz = sb ^ (((sb >> 9) & 1) << 5); R = (st >> 1) * 16 + swz / 64; C = (st & 1) * 32 + (swz % 64) / 2; }
__host__ __device__ __forceinline__ int perm32(int rho) { const int n = rho >> 4, i = rho & 15; return 8 * (i >> 2) + 4 * n + (i & 3); }

struct Unit { int pm, pn; size_t bofs; };
struct Gemm { const bf16_t* A; const bf16_t* Bt; int M, N, K; };

struct StaticOrder {
    int nM, nN, nwg, G, c;
    __host__ __device__ __forceinline__ void init(int M, int N, int G_, int c_) { nM = M / BM; nN = N / BM; nwg = nM * nN; G = G_; c = c_; }
    __host__ __device__ __forceinline__ bool next(int i, Unit& u) const {
        const long L = (long)i * G + c; if (L >= nwg) return false;
        int wgid = (int)L; { const int q = nwg / NXCD, r = nwg % NXCD, xcd = wgid % NXCD, off = wgid / NXCD; wgid = (xcd < r ? xcd * (q + 1) : r * (q + 1) + (xcd - r) * q) + off; }
        const int nig = WGM * nN, gid = wgid / nig, fm = gid * WGM, gsz = (nM - fm) < WGM ? (nM - fm) : WGM;
        u.pm = fm + ((wgid % nig) % gsz); u.pn = (wgid % nig) / gsz; u.bofs = 0; return true;
    }
    __device__ __forceinline__ void a_ready(const Unit&) const {}
    __device__ __forceinline__ void done(const Unit&) const {}
};


template <class Epi, class Sched, bool ALIGN_EPI = false, bool SP2 = false>
__device__ __forceinline__ void gemm_phase(PG8_LAS unsigned char* lds, const Gemm g, const Sched& S, const Epi& E, int wid) {
    const int lane = (int)__builtin_amdgcn_mbcnt_hi(~0u, __builtin_amdgcn_mbcnt_lo(~0u, 0u)), tid = wid * 64 + lane, wr = wid >> 2, wc = wid & 3, fr = lane & 15, fq = lane >> 4;
    const int K = g.K, nt = K / BK;
    unsigned voffA[2], voffB[2];
#pragma unroll
    for (int i = 0; i < 2; ++i) { int R, C; stage_rc(tid * 16 + i * 8192, R, C); const int Rb = Epi::PERM ? ((R & ~31) + perm32(R & 31)) : R;
        voffA[i] = (unsigned)(R * K + C) * 2u; voffB[i] = (unsigned)(Rb * K + C) * 2u; }
    const size_t kstep = (size_t)(BK * 2);
    const size_t hstep = (size_t)HALF * K * 2;
    const size_t tstep = 2 * hstep;
    const unsigned ldsw = (unsigned)wid * 1024u;
    const int aoff = lds_byte(wr * 64 + fr, fq * 8), boff = lds_byte(wc * 32 + fr, fq * 8);
#define PG8_SA(b, h) (((b) * 2 + (h)) * HTB)
#define PG8_SB(b, h) ((4 + (b) * 2 + (h)) * HTB)
#define PG8_STAGE(bufoff, gbase, voff) do { _Pragma("unroll") for (int _i = 0; _i < 2; ++_i) \
        __builtin_amdgcn_global_load_lds((const unsigned*)((const char*)(gbase) + (voff)[_i]), (PG8_LAS unsigned*)(lds + (bufoff) + ldsw + _i * 8192), 16, 0, 0); } while (0)
#define PG8_LDA(dst, b, h) do { _Pragma("unroll") for (int m = 0; m < 4; ++m) _Pragma("unroll") for (int k = 0; k < 2; ++k) dst[m][k] = *(const PG8_LAS bf16x8*)(lds + PG8_SA(b, h) + aoff + m * 2048 + k * 1024); } while (0)
#define PG8_LDB(dst, b, h) do { _Pragma("unroll") for (int n = 0; n < 2; ++n) _Pragma("unroll") for (int k = 0; k < 2; ++k) dst[n][k] = *(const PG8_LAS bf16x8*)(lds + PG8_SB(b, h) + boff + n * 2048 + k * 1024); } while (0)
#define PG8_MMA(ai, bj, At, Bt) do { __builtin_amdgcn_s_setprio(1); _Pragma("unroll") for (int m = 0; m < 4; ++m) _Pragma("unroll") for (int n = 0; n < 2; ++n) _Pragma("unroll") for (int k = 0; k < 2; ++k) \
        acc[ai][bj][m][n] = __builtin_amdgcn_mfma_f32_16x16x32_bf16(Bt[n][k], At[m][k], acc[ai][bj][m][n], 0, 0, 0); __builtin_amdgcn_s_setprio(0); } while (0)
#define PG8_WAIT_V(n) asm volatile("s_waitcnt vmcnt(" #n ")" ::: "memory")
#define PG8_WAIT_L(n) asm volatile("s_waitcnt lgkmcnt(" #n ")" ::: "memory")
#define PG8_BAR __builtin_amdgcn_s_barrier()
#define PG8_SCHED __builtin_amdgcn_sched_barrier(0)
    Unit cur, nxt; int ui = 0;
    if (!S.next(0, cur)) return;
    f32x4 acc[2][2][4][2];
#pragma unroll
    for (int a = 0; a < 2; ++a)
#pragma unroll
        for (int b = 0; b < 2; ++b)
#pragma unroll
            for (int m = 0; m < 4; ++m)
#pragma unroll
                for (int n = 0; n < 2; ++n) acc[a][b][m][n] = (f32x4){0.f, 0.f, 0.f, 0.f};
    bf16x8 At[4][2], B0[2][2], B1[2][2];
    const char* cA = (const char*)g.A + (size_t)cur.pm * tstep; const char* cB = (const char*)g.Bt + (size_t)cur.pn * tstep + cur.bofs;
    S.a_ready(cur);
    if constexpr (SP2) {
        PG8_STAGE(PG8_SB(0, 0), cB, voffB); PG8_STAGE(PG8_SB(0, 1), cB + hstep, voffB); PG8_STAGE(PG8_SA(0, 0), cA, voffA); PG8_STAGE(PG8_SA(0, 1), cA + hstep, voffA);
        if (wr == 1) PG8_BAR;
        PG8_WAIT_V(2); PG8_BAR;
        PG8_STAGE(PG8_SB(1, 0), cB + kstep, voffB); PG8_STAGE(PG8_SA(1, 0), cA + kstep, voffA); PG8_STAGE(PG8_SB(1, 1), cB + hstep + kstep, voffB);
        PG8_WAIT_V(6); PG8_BAR;
    } else {
        PG8_STAGE(PG8_SB(0, 0), cB, voffB); PG8_STAGE(PG8_SA(0, 0), cA, voffA); PG8_STAGE(PG8_SB(0, 1), cB + hstep, voffB); PG8_STAGE(PG8_SA(0, 1), cA + hstep, voffA);
        if (wr == 1) PG8_BAR;
        PG8_WAIT_V(4); PG8_BAR;
        PG8_STAGE(PG8_SB(1, 0), cB + kstep, voffB); PG8_STAGE(PG8_SA(1, 0), cA + kstep, voffA); PG8_STAGE(PG8_SB(1, 1), cB + hstep + kstep, voffB);
        PG8_WAIT_V(6); PG8_BAR;
    }
    for (;;) {
        const bool has_next = S.next(ui + 1, nxt);
        const char* nA = has_next ? (const char*)g.A + (size_t)nxt.pm * tstep : cA; const char* nB = has_next ? (const char*)g.Bt + (size_t)nxt.pn * tstep + nxt.bofs : cB;
        for (int t = 0; t < nt; t += 2) {
            const bool last = (t == nt - 2);
            const char* a1 = cA + (size_t)(t + 1) * kstep;
            const char* a2 = last ? nA : cA + (size_t)(t + 2) * kstep; const char* b2 = last ? nB : cB + (size_t)(t + 2) * kstep;
            const char* a3 = a2 + kstep; const char* b3 = b2 + kstep;
            if (last && has_next) S.a_ready(nxt);
            if constexpr (SP2) {
            PG8_LDB(B0, 0, 0); PG8_LDB(B1, 0, 1); PG8_SCHED; PG8_LDA(At, 0, 0); PG8_STAGE(PG8_SA(1, 1), a1 + hstep, voffA);
            PG8_WAIT_V(8); PG8_WAIT_L(0); PG8_BAR; PG8_MMA(0, 0, At, B0); PG8_MMA(0, 1, At, B1); PG8_BAR; PG8_SCHED;
            PG8_LDA(At, 0, 1); PG8_STAGE(PG8_SB(0, 0), b2, voffB); PG8_STAGE(PG8_SB(0, 1), b2 + hstep, voffB); PG8_STAGE(PG8_SA(0, 0), a2, voffA);
            PG8_WAIT_V(8); PG8_WAIT_L(0); PG8_BAR; PG8_MMA(1, 0, At, B0); PG8_MMA(1, 1, At, B1); PG8_BAR; PG8_SCHED;
            PG8_LDB(B0, 1, 0); PG8_LDB(B1, 1, 1); PG8_SCHED; PG8_LDA(At, 1, 0); PG8_STAGE(PG8_SA(0, 1), a2 + hstep, voffA);
            PG8_WAIT_V(8); PG8_WAIT_L(0); PG8_BAR; PG8_MMA(0, 0, At, B0); PG8_MMA(0, 1, At, B1); PG8_BAR; PG8_SCHED;
            PG8_LDA(At, 1, 1); PG8_STAGE(PG8_SB(1, 0), b3, voffB); PG8_STAGE(PG8_SB(1, 1), b3 + hstep, voffB); PG8_STAGE(PG8_SA(1, 0), a3, voffA);
            PG8_WAIT_V(8); PG8_WAIT_L(0); PG8_BAR; PG8_MMA(1, 0, At, B0); PG8_MMA(1, 1, At, B1); PG8_BAR; PG8_SCHED;
            } else {
            PG8_LDB(B0, 0, 0); PG8_SCHED; PG8_LDA(At, 0, 0); PG8_STAGE(PG8_SA(1, 1), a1 + hstep, voffA);
            PG8_WAIT_L(8); PG8_BAR; PG8_WAIT_L(0); PG8_MMA(0, 0, At, B0); PG8_BAR; PG8_SCHED;
            PG8_LDB(B1, 0, 1); PG8_STAGE(PG8_SB(0, 0), b2, voffB);
            PG8_BAR; PG8_WAIT_L(0); PG8_MMA(0, 1, At, B1); PG8_BAR;
            PG8_LDA(At, 0, 1); PG8_STAGE(PG8_SA(0, 0), a2, voffA);
            PG8_BAR; PG8_WAIT_L(0); PG8_MMA(1, 0, At, B0); PG8_BAR; PG8_SCHED;
            PG8_STAGE(PG8_SB(0, 1), b2 + hstep, voffB);
            PG8_WAIT_V(6); PG8_BAR; PG8_MMA(1, 1, At, B1); PG8_BAR;
            PG8_LDB(B0, 1, 0); PG8_SCHED; PG8_LDA(At, 1, 0); PG8_STAGE(PG8_SA(0, 1), a2 + hstep, voffA);
            PG8_WAIT_L(8); PG8_BAR; PG8_WAIT_L(0); PG8_MMA(0, 0, At, B0); PG8_BAR; PG8_SCHED;
            PG8_LDB(B1, 1, 1); PG8_STAGE(PG8_SB(1, 0), b3, voffB);
            PG8_BAR; PG8_WAIT_L(0); PG8_MMA(0, 1, At, B1); PG8_BAR;
            PG8_LDA(At, 1, 1); PG8_STAGE(PG8_SA(1, 0), a3, voffA);
            PG8_BAR; PG8_WAIT_L(0); PG8_MMA(1, 0, At, B0); PG8_BAR; PG8_SCHED;
            PG8_STAGE(PG8_SB(1, 1), b3 + hstep, voffB);
            PG8_WAIT_V(6); PG8_BAR; PG8_MMA(1, 1, At, B1); PG8_BAR;
            }
        }
        if constexpr (ALIGN_EPI) { if (wr == 0) PG8_BAR; }
        if constexpr (!Epi::AFTER_DRAIN) { E(acc, cur, wr, wc, fr, fq); S.done(cur); }
        if (!has_next) break;
#pragma unroll
        for (int a = 0; a < 2; ++a)
#pragma unroll
            for (int b = 0; b < 2; ++b)
#pragma unroll
                for (int m = 0; m < 4; ++m)
#pragma unroll
                    for (int n = 0; n < 2; ++n) acc[a][b][m][n] = (f32x4){0.f, 0.f, 0.f, 0.f};
        cur = nxt; cA = nA; cB = nB; ++ui;
        if constexpr (ALIGN_EPI) { if (wr == 1) PG8_BAR; }
    }
    PG8_WAIT_V(0);
    if constexpr (!ALIGN_EPI) { if (wr == 0) PG8_BAR; }
    PG8_BAR;
    if constexpr (Epi::AFTER_DRAIN) { E.fused(acc, cur, wr, wc, fr, fq, lds, wid, lane); S.done(cur); }
#undef PG8_SA
#undef PG8_SB
#undef PG8_STAGE
#undef PG8_LDA
#undef PG8_LDB
#undef PG8_MMA
#undef PG8_WAIT_V
#undef PG8_WAIT_L
#undef PG8_BAR
#undef PG8_SCHED
}
}
using pg8::bf16_t; using pg8::f32x4; using pg8::u32x4;
#define LAS __attribute__((address_space(3)))

constexpr int D = 1024, NBATCH = 16, SEQ = 2048, CTXL = 256;
constexpr int TL = NBATCH * SEQ;
constexpr int TC = NBATCH * CTXL;
constexpr int TALL = TL + TC;
constexpr int PROJ = 5632;
constexpr int NEXP = 32, DEXP = 512;
constexpr int MOE_ROWS = 288 * 256;
constexpr float EPS = 1e-6f;
constexpr int NWAVES = 8, NTHREADS = 512;

constexpr size_t MiB = 1u << 20;
constexpr size_t WS_CTL = 0;
constexpr size_t CTL_ZERO_BYTES = 256 * 1024;
constexpr size_t WS_MOD = 1 * MiB;
constexpr size_t WS_TOK = 2 * MiB;
constexpr size_t WS_RWT = 3 * MiB;
constexpr size_t WS_WIN = 13 * MiB;
constexpr size_t WS_WA = 24 * MiB;
constexpr size_t WS_WL = 25 * MiB;
constexpr size_t WS_WO = 27 * MiB;
constexpr size_t WS_LW = 29 * MiB;
constexpr size_t WS_W13 = 30 * MiB;
constexpr size_t WS_W2 = 94 * MiB;
constexpr size_t WS_K = 126 * MiB;
constexpr size_t WS_V = 162 * MiB;
constexpr size_t WS_LX = 198 * MiB;
constexpr size_t WS_XB = WS_K;
constexpr size_t WS_Q = 270 * MiB;
constexpr size_t WS_LG = 302 * MiB;
constexpr size_t WS_H2 = WS_Q;
constexpr size_t WS_X1B = WS_LG;
constexpr size_t WS_GA = 366 * MiB;
constexpr size_t WS_GB = 430 * MiB;
constexpr size_t WS_YB = WS_GA;
constexpr size_t WS_END = 510 * MiB;
constexpr int CW_COUNT = 0, CW_CURSOR = 64, CW_NBLK = 128, CW_BLKE = 192;
constexpr int CW_BCNT = 16384;
constexpr int CW_BAR = 1024;

constexpr int RING_BYTES = 131072;
constexpr int MISC_OFF = 147456;
constexpr int LDS_BYTES = 163840;

__device__ __forceinline__ unsigned f2bf(float f) { unsigned u = __float_as_uint(f); return (u + 0x7fffu + ((u >> 16) & 1u)) >> 16; }
__device__ __forceinline__ float bf2f(unsigned h) { return __uint_as_float(h << 16); }
typedef __bf16 bf16x2_t __attribute__((ext_vector_type(2)));
__device__ __forceinline__ unsigned pk2(float lo, float hi) { const f32x2 v = {lo, hi}; const bf16x2_t b = __builtin_convertvector(v, bf16x2_t); return __builtin_bit_cast(unsigned, b); }
__device__ __forceinline__ float bflo(unsigned w) { return __uint_as_float(w << 16); }
__device__ __forceinline__ float bfhi(unsigned w) { return __uint_as_float(w & 0xffff0000u); }
__device__ __forceinline__ void unpack8(u32x4 w, float (&v)[8]) { v[0] = bflo(w.x); v[1] = bfhi(w.x); v[2] = bflo(w.y); v[3] = bfhi(w.y); v[4] = bflo(w.z); v[5] = bfhi(w.z); v[6] = bflo(w.w); v[7] = bfhi(w.w); }
__device__ __forceinline__ u32x4 pack8(const float (&v)[8]) { u32x4 w; w.x = pk2(v[0], v[1]); w.y = pk2(v[2], v[3]); w.z = pk2(v[4], v[5]); w.w = pk2(v[6], v[7]); return w; }
__device__ __forceinline__ float fast_exp(float x) { return __builtin_amdgcn_exp2f(x * 1.4426950408889634f); }
__device__ __forceinline__ float sigmoid_fast(float x) { return __builtin_amdgcn_rcpf(1.0f + fast_exp(-x)); }
__device__ __forceinline__ float silu_fast(float x) { return x * sigmoid_fast(x); }
__device__ __forceinline__ float gelu_tanh_fast(float x) { const float u2 = 1.5957691216057308f * (x + 0.044715f * x * x * x); return x * sigmoid_fast(u2); }
__device__ __forceinline__ float sigmoidf_(float x) { return 1.0f / (1.0f + expf(-x)); }
__device__ __forceinline__ float siluf_(float x) { return x / (1.0f + expf(-x)); }
__device__ __forceinline__ float wave_sum(float v) {
#pragma unroll
    for (int o = 1; o < 64; o <<= 1) v += __shfl_xor(v, o);
    return v;
}

template <int CTRL> __device__ __forceinline__ float dpp_f(float v) { return __int_as_float(__builtin_amdgcn_update_dpp(0, __float_as_int(v), CTRL, 0xF, 0xF, true)); }
__device__ __forceinline__ float row16_sum(float v) { v += dpp_f<0xB1>(v); v += dpp_f<0x4E>(v); v += dpp_f<0x141>(v); v += dpp_f<0x140>(v); return v; }
__device__ __forceinline__ float comb32(float a, float b) { const auto r = __builtin_amdgcn_permlane32_swap(__float_as_uint(a), __float_as_uint(b), false, false); return __uint_as_float(r[0]) + __uint_as_float(r[1]); }
__device__ __forceinline__ float comb16(float a, float b) { const auto r = __builtin_amdgcn_permlane16_swap(__float_as_uint(a), __float_as_uint(b), false, false); return __uint_as_float(r[0]) + __uint_as_float(r[1]); }
__device__ __forceinline__ float lane_f(float v, int l) { return __int_as_float(__builtin_amdgcn_readlane(__float_as_int(v), l)); }
__device__ __forceinline__ float wave_sum_fast(float v) { v = row16_sum(v); return (lane_f(v, 0) + lane_f(v, 16)) + (lane_f(v, 32) + lane_f(v, 48)); }
__device__ __forceinline__ float half_max(float v) { const auto r = __builtin_amdgcn_permlane32_swap(__float_as_uint(v), __float_as_uint(v), false, false); return fmaxf(__uint_as_float(r[0]), __uint_as_float(r[1])); }
__device__ __forceinline__ float half_sum(float v) { const auto r = __builtin_amdgcn_permlane32_swap(__float_as_uint(v), __float_as_uint(v), false, false); return __uint_as_float(r[0]) + __uint_as_float(r[1]); }

struct EpiProj {
    bf16_t *Kb, *Vb, *LXb, *Qb, *LGb, *GAb, *GBb; const f32x2* rope;
    __device__ __forceinline__ void operator()(int row, int col, const float (&v)[8]) const {
        float o[8];
        if (col < 512) {
            if (row < TL) { const int t = row & 2047, p = col & 63, pos = (p < 32) ? (t >> 6) : (t & 63), i0 = (p & 31) >> 1;
#pragma unroll
                for (int j = 0; j < 4; ++j) { const f32x2 cs = rope[pos * 16 + i0 + j]; o[2 * j] = v[2 * j] * cs.x - v[2 * j + 1] * cs.y; o[2 * j + 1] = v[2 * j] * cs.y + v[2 * j + 1] * cs.x; }
            } else {
#pragma unroll
                for (int j = 0; j < 8; ++j) o[j] = v[j]; }
            *(u32x4*)(Kb + (size_t)row * 512 + col) = pack8(o);
        } else if (col < 1024) { *(u32x4*)(Vb + (size_t)row * 512 + (col - 512)) = pack8(v);
        } else if (col < 2048) { *(u32x4*)(LXb + (size_t)row * 1024 + (col - 1024)) = pack8(v);
        } else if (col < 2560) { *(u32x4*)(Qb + (size_t)row * 512 + (col - 2048)) = pack8(v);
        } else if (col < 3584) {
#pragma unroll
            for (int j = 0; j < 8; ++j) o[j] = gelu_tanh_fast(v[j]);
            *(u32x4*)(LGb + (size_t)row * 1024 + (col - 2560)) = pack8(o);
        } else {
#pragma unroll
            for (int j = 0; j < 8; ++j) o[j] = sigmoid_fast(v[j]);
            bf16_t* dst = (col < 4608) ? GAb + (size_t)row * 1024 + (col - 3584) : GBb + (size_t)row * 1024 + (col - 4608);
            *(u32x4*)dst = pack8(o);
        }
    }
};
struct EpiUpAttn {
    const bf16_t* GA; bf16_t* OUT;
    struct P { u32x4 g; };
    __device__ __forceinline__ void load(int row, int col, P& p) const { p.g = *(const u32x4*)(GA + (size_t)row * 1024 + col); }
    __device__ __forceinline__ void apply(int row, int col, const float (&v)[8], const P& p) const {
        float g[8], o[8]; unpack8(p.g, g);
#pragma unroll
        for (int j = 0; j < 8; ++j) o[j] = g[j] * v[j];
        *(u32x4*)(OUT + (size_t)row * 1024 + col) = pack8(o);
    }
};
struct EpiUpLru {
    const bf16_t* Y; const bf16_t* GB; bf16_t* OUT;
    struct P { u32x4 g, y; };
    __device__ __forceinline__ void load(int row, int col, P& p) const { p.g = *(const u32x4*)(GB + (size_t)row * 1024 + col); p.y = *(const u32x4*)(Y + (size_t)row * 1024 + col); }
    __device__ __forceinline__ void apply(int row, int col, const float (&v)[8], const P& p) const {
        float g[8], y[8], o[8]; unpack8(p.g, g); unpack8(p.y, y);
#pragma unroll
        for (int j = 0; j < 8; ++j) o[j] = y[j] + g[j] * v[j];
        *(u32x4*)(OUT + (size_t)row * 1024 + col) = pack8(o);
    }
};
struct EpiOut {
    const float* x; const float* mod; bf16_t* x1;
    struct P { f32x4 x0, x1v, g0, g1; };
    __device__ __forceinline__ void load(int row, int col, P& p) const { const float* ga1 = mod + (row >> 11) * 6144 + 2048 + col; const float* xr = x + (size_t)row * D + col;
        p.x0 = *(const f32x4*)xr; p.x1v = *(const f32x4*)(xr + 4); p.g0 = *(const f32x4*)ga1; p.g1 = *(const f32x4*)(ga1 + 4); }
    __device__ __forceinline__ void apply(int row, int col, const float (&v)[8], const P& p) const {
        const float o[8] = {p.x0.x + p.g0.x * v[0], p.x0.y + p.g0.y * v[1], p.x0.z + p.g0.z * v[2], p.x0.w + p.g0.w * v[3], p.x1v.x + p.g1.x * v[4], p.x1v.y + p.g1.y * v[5], p.x1v.z + p.g1.z * v[6], p.x1v.w + p.g1.w * v[7]};
        *(u32x4*)(x1 + (size_t)row * D + col) = pack8(o);
    }
};
struct EpiMoe1 {
    bf16_t* HM;
    __device__ __forceinline__ void operator()(int row, int col, const float (&v)[8]) const {
        u32x2 w; w.x = pk2(silu_fast(v[0]) * v[1], silu_fast(v[2]) * v[3]); w.y = pk2(silu_fast(v[4]) * v[5], silu_fast(v[6]) * v[7]);
        *(u32x2*)(HM + (size_t)row * DEXP + (col >> 1)) = w;
    }
};
struct EpiMoe2 {
    bf16_t* YB;
    __device__ __forceinline__ void operator()(int row, int col, const float (&v)[8]) const { *(u32x4*)(YB + (size_t)row * D + col) = pack8(v); }
};
template <class F> struct EpiF {
    static constexpr bool PERM = true, AFTER_DRAIN = false; F f;
    __device__ __forceinline__ void operator()(const f32x4 (&acc)[2][2][4][2], const pg8::Unit& u, int wr, int wc, int fr, int fq) const {
#pragma unroll
        for (int ai = 0; ai < 2; ++ai)
#pragma unroll
            for (int m = 0; m < 4; ++m) { const int row = u.pm * 256 + ai * 128 + wr * 64 + m * 16 + fr;
#pragma unroll
                for (int bj = 0; bj < 2; ++bj) { const int col = u.pn * 256 + bj * 128 + wc * 32 + 8 * fq; const f32x4 a = acc[ai][bj][m][0], b = acc[ai][bj][m][1];
                    const float v[8] = {a[0], a[1], a[2], a[3], b[0], b[1], b[2], b[3]}; f(row, col, v); } }
    }
};
template <class F> struct EpiF2 {
    static constexpr bool PERM = true, AFTER_DRAIN = false; F f;
    __device__ __forceinline__ void operator()(const f32x4 (&acc)[2][2][4][2], const pg8::Unit& u, int wr, int wc, int fr, int fq) const {
#pragma unroll
        for (int ai = 0; ai < 2; ++ai)
#pragma unroll
            for (int mp = 0; mp < 2; ++mp) {
                typename F::P pre[2][2];
#pragma unroll
                for (int mm = 0; mm < 2; ++mm)
#pragma unroll
                    for (int bj = 0; bj < 2; ++bj) f.load(u.pm * 256 + ai * 128 + wr * 64 + (2 * mp + mm) * 16 + fr, u.pn * 256 + bj * 128 + wc * 32 + 8 * fq, pre[mm][bj]);
#pragma unroll
                for (int mm = 0; mm < 2; ++mm)
#pragma unroll
                    for (int bj = 0; bj < 2; ++bj) { const int m = 2 * mp + mm; const f32x4 a = acc[ai][bj][m][0], b = acc[ai][bj][m][1];
                        const float v[8] = {a[0], a[1], a[2], a[3], b[0], b[1], b[2], b[3]};
                        f.apply(u.pm * 256 + ai * 128 + wr * 64 + m * 16 + fr, u.pn * 256 + bj * 128 + wc * 32 + 8 * fq, v, pre[mm][bj]); }
                asm volatile("" ::: "memory");
            }
    }
};

struct ProjOrder {
    pg8::StaticOrder so; int G, c;
    __device__ __forceinline__ void init(int G_, int c_) { so.init(TL, PROJ, G_, c_); G = G_; c = c_; }
    __device__ __forceinline__ bool next(int i, pg8::Unit& u) const {
        const int L = i * G + c;
        if (L < so.nwg) return so.next(i, u);
        const int j = L - so.nwg; if (j >= 128) return false;
        u.pm = 128 + (j >> 3); u.pn = j & 7; u.bofs = 0; return true;
    }
    __device__ __forceinline__ void a_ready(const pg8::Unit&) const {}
    __device__ __forceinline__ void done(const pg8::Unit&) const {}
};
struct MoeOrder {
    const unsigned* ctl; int G, vcu, nunits; size_t estride;
    __device__ __forceinline__ void init(const unsigned* ctl_, int G_, int bx, size_t es) { ctl = ctl_; G = G_; vcu = (G_ % 8 == 0) ? (bx % 8) * (G_ / 8) + bx / 8 : bx; nunits = (int)ctl_[CW_NBLK] * 4; estride = es; }
    __device__ __forceinline__ bool next(int i, pg8::Unit& u) const {
        const int L = i * G + vcu; if (L >= nunits) return false;
        u.pm = L >> 2; u.pn = L & 3; u.bofs = (size_t)ctl[CW_BLKE + u.pm] * estride; return true;
    }
    __device__ __forceinline__ void a_ready(const pg8::Unit&) const {}
    __device__ __forceinline__ void done(const pg8::Unit&) const {}
};

#define XB_TMO      128
#define XB_XCNT(j)  (256  + 64 * (j))
#define XB_XSUB(j)  (1280 + 64 * (j))
#define XB_XGEN(j)  (2304 + 64 * (j))
#define XB_TOP      3328
#define XB_TOPGEN   3392
#define XCD_BAR_WORDS 3456
#define XB_SPIN_CAP (1u << 18)

__device__ __forceinline__ unsigned xb_ld(unsigned* p)              { return __hip_atomic_load(p, __ATOMIC_RELAXED, __HIP_MEMORY_SCOPE_AGENT); }
__device__ __forceinline__ unsigned xb_add(unsigned* p, unsigned v) { return __hip_atomic_fetch_add(p, v, __ATOMIC_RELAXED, __HIP_MEMORY_SCOPE_AGENT); }
__device__ __forceinline__ unsigned xb_xcc_id() { return (unsigned)__builtin_amdgcn_s_getreg((3 << 11) | 20) & 0xFu; }
#define XB_SPIN(cond, bar) do { unsigned _sp = 0; while (cond) { __builtin_amdgcn_s_sleep(1); \
    if ((++_sp & 255u) == 0u) { if (xb_ld(&(bar)[XB_TMO])) break; if (_sp > XB_SPIN_CAP) { atomicAdd(&(bar)[XB_TMO], 1u); break; } } } } while (0)

struct XcdBarrier {
    unsigned* bar; unsigned x;
    volatile LAS unsigned* st;
};

__device__ __forceinline__ XcdBarrier xcd_barrier_post(unsigned* bar, volatile LAS unsigned* st, bool leader) {
    XcdBarrier b; b.bar = bar; b.x = xb_xcc_id(); b.st = st;
    if (leader) (void)xb_add(&bar[XB_XCNT(b.x)], 1u);
    return b;
}
__device__ __forceinline__ void xcd_barrier_complete(unsigned* bar, unsigned x, unsigned& nloc, unsigned& nx) {
    const unsigned G = gridDim.x * gridDim.y * gridDim.z;
    unsigned sum, cnt, mine, sp = 0u;
    for (;;) {
        sum = 0u; cnt = 0u; mine = 0u;
#pragma unroll
        for (unsigned j = 0; j < 16; ++j) { const unsigned c = xb_ld(&bar[XB_XCNT(j)]); sum += c; cnt += (c > 0u) ? 1u : 0u; mine = (j == x) ? c : mine; }
        if (sum == G) break;
        __builtin_amdgcn_s_sleep(1);
        if ((++sp & 255u) == 0u) { if (xb_ld(&bar[XB_TMO])) break; if (sp > XB_SPIN_CAP) { atomicAdd(&bar[XB_TMO], 1u); break; } }
    }
    nloc = mine > 0u ? mine : 1u; nx = cnt > 0u ? cnt : 1u;
}

__device__ __forceinline__ void xcd_barrier(const XcdBarrier& b, int wave) {
    const bool leader_ = wave == 0 && __builtin_amdgcn_mbcnt_hi(~0u, __builtin_amdgcn_mbcnt_lo(~0u, 0u)) == 0u;
    asm volatile("s_waitcnt vmcnt(0)" ::: "memory");
    __syncthreads();
    if (leader_) {
        unsigned* bar = b.bar;
        __builtin_amdgcn_s_waitcnt(0);
        unsigned nloc = b.st[0], nx = b.st[1];
        if (nloc == 0u) { xcd_barrier_complete(bar, b.x, nloc, nx); b.st[0] = nloc; b.st[1] = nx; }
        const unsigned old = xb_add(&bar[XB_XSUB(b.x)], 1u);
        const unsigned gen = old / nloc;
        if (old + 1u == (gen + 1u) * nloc) {
            __builtin_amdgcn_fence(__ATOMIC_RELEASE, "agent");
            asm volatile("s_waitcnt vmcnt(0)" ::: "memory");
            const unsigned og = xb_add(&bar[XB_TOP], 1u);
            const unsigned tg = og / nx;
            if (og + 1u == (tg + 1u) * nx) xb_add(&bar[XB_TOPGEN], 1u);
            else XB_SPIN(xb_ld(&bar[XB_TOPGEN]) == tg, bar);
            __builtin_amdgcn_fence(__ATOMIC_ACQUIRE, "agent");
            xb_add(&bar[XB_XGEN(b.x)], 1u);
            asm volatile("s_waitcnt vmcnt(0)" ::: "memory");
        } else {
            XB_SPIN(xb_ld(&bar[XB_XGEN(b.x)]) == gen, bar);
            __builtin_amdgcn_fence(__ATOMIC_ACQUIRE, "agent");
            asm volatile("s_waitcnt vmcnt(0)" ::: "memory");
        }
    }
    __syncthreads();
}

__device__ __forceinline__ int win_perm(int n) {
    const bool qk = (n < 512) || (n >= 2048 && n < 2560);
    if (!qk) return n;
    const int d = n & 63, base = n - d, half = d >> 5, dd = d & 31, i = dd & 15, comp = dd >> 4;
    return base + half * 32 + 2 * i + comp;
}
template <int K, int N, int MODE, int ROWMUL>
__device__ __forceinline__ void prep_item(const float* W, bf16_t* WT, int rowoff, unsigned dstride, LAS float* scr, int item, int lane, float wscale = 1.0f) {
    constexpr int nblk = N / 32, per = (K / 64) * nblk;
    const int bi = item / per, r = item % per, kb = r / nblk, nb = r % nblk, k0 = 64 * kb, n0 = 32 * nb;
    const float* src = W + (size_t)bi * K * N;
    { float t_[32];
#pragma unroll
      for (int i = 0; i < 32; ++i) t_[i] = __builtin_nontemporal_load(src + (size_t)(k0 + 2 * i + (lane >> 5)) * N + n0 + (lane & 31));
#pragma unroll
      for (int i = 0; i < 32; ++i) scr[(2 * i + (lane >> 5)) * 33 + (lane & 31)] = t_[i]; }
    asm volatile("s_waitcnt lgkmcnt(0)" ::: "memory");
    const int c = lane & 7;
#pragma unroll
    for (int j = 0; j < 4; ++j) { const int n = (lane >> 3) + 8 * j; const LAS float* s = scr + (8 * c) * 33 + n;
        u32x4 o; o.x = pk2(s[0 * 33] * wscale, s[1 * 33] * wscale); o.y = pk2(s[2 * 33] * wscale, s[3 * 33] * wscale); o.z = pk2(s[4 * 33] * wscale, s[5 * 33] * wscale); o.w = pk2(s[6 * 33] * wscale, s[7 * 33] * wscale);
        int ng = n0 + n; if (MODE == 1) ng = win_perm(ng);
        *(u32x4*)(WT + (size_t)bi * dstride + (size_t)(ROWMUL * ng + rowoff) * K + k0 + 8 * c) = o; }
    asm volatile("s_waitcnt lgkmcnt(0)" ::: "memory");
}
__device__ __forceinline__ unsigned char* lds_ptr(LAS unsigned char* ldsl, int i);
__device__ __forceinline__ void p0_prep(unsigned char* ws, LAS unsigned char* ldsl, int gw, int ngw, int lane, int wave) {
    LAS float* scr = (LAS float*)(ldsl + wave * 8448);
#define in_(i) ((const float*)lds_ptr(ldsl, (i)))
    constexpr int I0 = 16 * 176, I1 = 8 * 32, I2 = 16 * 32, I3 = 16 * 32, I4 = 16 * 2 * 4, I5 = I4, I6 = 32 * 16 * 16, I7 = I6, I8 = 32 * 8 * 32;
    constexpr int TOT = I0 + I1 + I2 + I3 + I4 + I5 + I6 + I7 + I8;
    for (int it = gw; it < TOT; it += ngw) {
        int r = it;
        if (r < I0) { prep_item<1024, PROJ, 1, 1>(in_(8), (bf16_t*)(ws + WS_WIN), 0, 0u, scr, r, lane); continue; } r -= I0;
        if (r < I1) { prep_item<512, 1024, 0, 1>(in_(17), (bf16_t*)(ws + WS_WA), 0, 0u, scr, r, lane); continue; } r -= I1;
        if (r < I2) { prep_item<1024, 1024, 0, 1>(in_(18), (bf16_t*)(ws + WS_WL), 0, 0u, scr, r, lane); continue; } r -= I2;
        if (r < I3) { prep_item<1024, 1024, 0, 1>(in_(19), (bf16_t*)(ws + WS_WO), 0, 0u, scr, r, lane); continue; } r -= I3;
        if (r < I4) { prep_item<128, 128, 0, 1>(in_(12), (bf16_t*)(ws + WS_LW), 0, 256u * 128u, scr, r, lane, -1.4426950408889634f); continue; } r -= I4;
        if (r < I5) { prep_item<128, 128, 0, 1>(in_(14), (bf16_t*)(ws + WS_LW), 128, 256u * 128u, scr, r, lane, -1.4426950408889634f); continue; } r -= I5;
        if (r < I6) { prep_item<1024, 512, 0, 2>(in_(24), (bf16_t*)(ws + WS_W13), 0, 1024u * 1024u, scr, r, lane); continue; } r -= I6;
        if (r < I7) { prep_item<1024, 512, 0, 2>(in_(25), (bf16_t*)(ws + WS_W13), 1, 1024u * 1024u, scr, r, lane); continue; } r -= I7;
        prep_item<512, 1024, 0, 1>(in_(26), (bf16_t*)(ws + WS_W2), 0, 1024u * 512u, scr, r, lane);
    }
#undef in_
}
__device__ __forceinline__ void p0_mod(const float* c, const float* c_ctx, const float* w_mod, const float* b_mod, const float* wg, const float* we, f32x4* W4g, const float* lam, float* SPt, float* mod, f32x2* rope, LAS float* lds_f, int tid) {
    LAS float* sc = lds_f;
    LAS float* red = lds_f + 17 * 1024;
    for (int i = tid; i < 17 * 1024; i += NTHREADS) { const float v = (i < 16 * 1024) ? c[i] : c_ctx[i - 16 * 1024]; sc[i] = siluf_(v); }
    for (int idx = blockIdx.x * NTHREADS + tid; idx < 36 * 256; idx += gridDim.x * NTHREADS) { const int cc = idx >> 8, kq = idx & 255; f32x4 w;
        if (cc < 4) { const float* s = wg + (size_t)(4 * kq) * 4 + cc; w.x = s[0]; w.y = s[4]; w.z = s[8]; w.w = s[12]; }
        else { const float* s = we + (size_t)(4 * kq) * 32 + (cc - 4); w.x = s[0]; w.y = s[32]; w.z = s[64]; w.w = s[96]; }
        W4g[idx] = w; }
    if (blockIdx.x == 1) for (int i = tid; i < 2048; i += NTHREADS) { const float lm = lam[i]; SPt[i] = (-lm > 20.f) ? -lm : log1pf(expf(-lm)); }
    if (blockIdx.x == 0) for (int i = tid; i < 64 * 16; i += NTHREADS) { const int pos = i >> 4, f = i & 15; const double inv = exp(-(double)f / 16.0 * log(10000.0)); const double ang = (double)pos * inv;
        rope[i] = (f32x2){(float)cos(ang), (float)sin(ang)}; }
    __syncthreads();
    for (int cb = blockIdx.x; cb < 256; cb += gridDim.x) {
        const int ks = tid / 24, col = tid % 24;
        if (ks < 21) {
            float acc[17];
#pragma unroll
            for (int b = 0; b < 17; ++b) acc[b] = 0.f;
            for (int k = ks; k < 1024; k += 21) { const float w = w_mod[(size_t)k * 6144 + cb * 24 + col];
#pragma unroll
                for (int b = 0; b < 17; ++b) acc[b] += sc[b * 1024 + k] * w; }
#pragma unroll
            for (int b = 0; b < 17; ++b) red[(ks * 17 + b) * 24 + col] = acc[b];
        }
        __syncthreads();
        if (tid < 17 * 24) { const int b = tid / 24, cc = tid % 24; float s = b_mod[cb * 24 + cc];
            for (int q = 0; q < 21; ++q) s += red[(q * 17 + b) * 24 + cc];
            mod[b * 6144 + cb * 24 + cc] = s; }
        __syncthreads();
    }
}

__device__ __forceinline__ void p1_adanorm(const float* x, const float* ctx, const float* gain, const float* mod, bf16_t* H, int gw, int ngw, int lane) {
    f32x4 nA[4], nB[4];
#define AD_SRC(r_) ((r_) < TL ? x + (size_t)(r_) * D : ctx + (size_t)((r_) - TL) * D)
#define AD_LOAD(dst, r_) do { if ((r_) < TALL) { const float* s_ = AD_SRC(r_); _Pragma("unroll") for (int j = 0; j < 4; ++j) dst[j] = __builtin_nontemporal_load((const f32x4*)(s_ + lane * 4 + 256 * j)); } } while (0)
#define AD_ROW(src_, r_) do { const int row_ = (r_); const int mb = row_ < TL ? (row_ >> 11) : 16; const float* shift = mod + mb * 6144; const float* scale = shift + 1024; \
        f32x4 v[4]; float ss = 0.f; \
        _Pragma("unroll") for (int j = 0; j < 4; ++j) { v[j] = src_[j]; ss += v[j].x * v[j].x + v[j].y * v[j].y + v[j].z * v[j].z + v[j].w * v[j].w; } \
        AD_LOAD(src_, row_ + 2 * ngw); \
        const float rstd = rsqrtf(wave_sum_fast(ss) * (1.0f / D) + EPS); \
        _Pragma("unroll") for (int j = 0; j < 4; ++j) { const int k = lane * 4 + 256 * j; const f32x4 g = *(const f32x4*)(gain + k), sh = *(const f32x4*)(shift + k), sc = *(const f32x4*)(scale + k); \
            const f32x4 o = (v[j] * rstd * g) * (1.0f + sc) + sh; \
            u32x2 w; w.x = pk2(o.x, o.y); w.y = pk2(o.z, o.w); *(u32x2*)(H + (size_t)row_ * D + k) = w; } } while (0)
    AD_LOAD(nA, gw); AD_LOAD(nB, gw + ngw);
    for (int row = gw; row < TALL; row += 2 * ngw) { AD_ROW(nA, row); if (row + ngw < TALL) AD_ROW(nB, row + ngw); }
#undef AD_SRC
#undef AD_LOAD
#undef AD_ROW
}

__device__ __forceinline__ void p1_router_tables(const float* gain, const float* mod, const f32x4* W4g, const float* bg, const float* be, float* WT, float* biasb, int gw, int ngw, int lane) {
    for (int it = gw; it < 16 * 48; it += ngw) {
        const int b = it / 48, j = it % 48; const float* shift = mod + b * 6144 + 3072; const float* scale = shift + 1024;
        float part = 0.f;
#pragma unroll
        for (int i = 0; i < 4; ++i) { const int kq = lane + 64 * i; const f32x4 g = *(const f32x4*)(gain + 4 * kq), sc = *(const f32x4*)(scale + 4 * kq), sh = *(const f32x4*)(shift + 4 * kq);
            f32x4 w = (f32x4){0.f, 0.f, 0.f, 0.f}; if (j < 36) w = W4g[j * 256 + kq];
            *(f32x4*)(WT + (size_t)(b * 48 + j) * 1024 + 4 * kq) = g * (1.0f + sc) * w;
            part += sh.x * w.x + sh.y * w.y + sh.z * w.z + sh.w * w.w; }
        part = wave_sum_fast(part);
        if (lane == 0) biasb[b * 48 + j] = part + (j < 4 ? bg[j] : j < 36 ? be[j - 4] : 0.f);
    }
}
constexpr int RT_CHUNK_FLOATS = 48 * 132, RT_LG_OFF = 2 * RT_CHUNK_FLOATS * 4;
__device__ __forceinline__ void p8_route(const bf16_t* x1, const float* WT, const float* biasb, unsigned* ctl, int* tok, LAS unsigned char* lds, int lane, int tid, int wave) {
    LAS unsigned* hist = (LAS unsigned*)(lds + MISC_OFF + 256);
    if (tid < 32) hist[tid] = 0u;
    LAS float* Lg = (LAS float*)(lds + RT_LG_OFF + wave * 3072);
    const int i = lane & 15, kk = lane >> 4;
    for (int blk = blockIdx.x; blk < TL / 128; blk += gridDim.x) {
        const int R0 = 128 * blk + 16 * wave, b = (128 * blk) >> 11;
        const bf16_t* xr = x1 + (size_t)(R0 + i) * D + 4 * kk; const float* wtb = WT + (size_t)b * 48 * 1024;
        f32x4 a0 = (f32x4){0.f, 0.f, 0.f, 0.f}, a1 = a0, a2 = a0; float ss = 0.f;
        f32x4 stg[3];
#define RT_LOAD(c_) do { _Pragma("unroll") for (int q = 0; q < 3; ++q) { const int id = tid + NTHREADS * q, col = id >> 5, k4 = id & 31; stg[q] = *(const f32x4*)(wtb + (size_t)col * 1024 + 128 * (c_) + 4 * k4); } } while (0)
#define RT_STORE(buf_) do { _Pragma("unroll") for (int q = 0; q < 3; ++q) { const int id = tid + NTHREADS * q, col = id >> 5, k4 = id & 31; *(LAS f32x4*)((LAS float*)lds + (buf_) * RT_CHUNK_FLOATS + col * 132 + 4 * k4) = stg[q]; } } while (0)
        __syncthreads();
        RT_LOAD(0); RT_STORE(0);
        u32x2 cx[8];
#pragma unroll
        for (int u = 0; u < 8; ++u) cx[u] = *(const u32x2*)(xr + 16 * u);
        __syncthreads();
#pragma unroll 1
        for (int c = 0; c < 8; ++c) {
            if (c < 7) RT_LOAD(c + 1);
            u32x2 nx[8];
            if (c < 7) {
#pragma unroll
                for (int u = 0; u < 8; ++u) nx[u] = *(const u32x2*)(xr + 128 * (c + 1) + 16 * u); }
            const LAS float* wl = (const LAS float*)lds + (c & 1) * RT_CHUNK_FLOATS + i * 132 + 4 * kk;
#pragma unroll
            for (int u = 0; u < 8; ++u) { const f32x4 xa = (f32x4){bflo(cx[u].x), bfhi(cx[u].x), bflo(cx[u].y), bfhi(cx[u].y)}, b0 = *(const LAS f32x4*)(wl + 16 * u), b1 = *(const LAS f32x4*)(wl + 16 * 132 + 16 * u), b2 = *(const LAS f32x4*)(wl + 32 * 132 + 16 * u);
                ss += xa.x * xa.x + xa.y * xa.y + xa.z * xa.z + xa.w * xa.w;
                a0 = __builtin_amdgcn_mfma_f32_16x16x4f32(xa.x, b0.x, a0, 0, 0, 0); a1 = __builtin_amdgcn_mfma_f32_16x16x4f32(xa.x, b1.x, a1, 0, 0, 0); a2 = __builtin_amdgcn_mfma_f32_16x16x4f32(xa.x, b2.x, a2, 0, 0, 0);
                a0 = __builtin_amdgcn_mfma_f32_16x16x4f32(xa.y, b0.y, a0, 0, 0, 0); a1 = __builtin_amdgcn_mfma_f32_16x16x4f32(xa.y, b1.y, a1, 0, 0, 0); a2 = __builtin_amdgcn_mfma_f32_16x16x4f32(xa.y, b2.y, a2, 0, 0, 0);
                a0 = __builtin_amdgcn_mfma_f32_16x16x4f32(xa.z, b0.z, a0, 0, 0, 0); a1 = __builtin_amdgcn_mfma_f32_16x16x4f32(xa.z, b1.z, a1, 0, 0, 0); a2 = __builtin_amdgcn_mfma_f32_16x16x4f32(xa.z, b2.z, a2, 0, 0, 0);
                a0 = __builtin_amdgcn_mfma_f32_16x16x4f32(xa.w, b0.w, a0, 0, 0, 0); a1 = __builtin_amdgcn_mfma_f32_16x16x4f32(xa.w, b1.w, a1, 0, 0, 0); a2 = __builtin_amdgcn_mfma_f32_16x16x4f32(xa.w, b2.w, a2, 0, 0, 0); }
            if (c < 7) { RT_STORE((c + 1) & 1);
#pragma unroll
                for (int u = 0; u < 8; ++u) cx[u] = nx[u]; }
            __syncthreads();
        }
#undef RT_LOAD
#undef RT_STORE
        ss = half_sum(ss); { const auto r = __builtin_amdgcn_permlane16_swap(__float_as_uint(ss), __float_as_uint(ss), false, false); ss = __uint_as_float(r[0]) + __uint_as_float(r[1]); }
        const float rstd = rsqrtf(ss * (1.0f / D) + EPS);
#pragma unroll
        for (int rg = 0; rg < 4; ++rg) { Lg[(4 * kk + rg) * 48 + i] = a0[rg]; Lg[(4 * kk + rg) * 48 + 16 + i] = a1[rg]; Lg[(4 * kk + rg) * 48 + 32 + i] = a2[rg]; }
        if (lane < 16) {
            const int row = R0 + lane; const float* bb = biasb + b * 48; const LAS float* lr = Lg + lane * 48;
            float acc[36];
#pragma unroll
            for (int c4 = 0; c4 < 9; ++c4) { const f32x4 v = *(const LAS f32x4*)(lr + 4 * c4), bv = *(const f32x4*)(bb + 4 * c4);
                acc[4 * c4] = rstd * v.x + bv.x; acc[4 * c4 + 1] = rstd * v.y + bv.y; acc[4 * c4 + 2] = rstd * v.z + bv.z; acc[4 * c4 + 3] = rstd * v.w + bv.w; }
            int gi = 0; float gm = -1e30f;
#pragma unroll
            for (int g = 0; g < 4; ++g) if (acc[g] > gm) { gm = acc[g]; gi = g; }
            float gs = 0.f;
#pragma unroll
            for (int g = 0; g < 4; ++g) gs += expf(acc[g] - gm);
            const float p_top = 1.0f / gs;
            float le[8];
#pragma unroll
            for (int j = 0; j < 8; ++j) le[j] = gi == 0 ? acc[4 + j] : gi == 1 ? acc[12 + j] : gi == 2 ? acc[20 + j] : acc[28 + j];
            int e1 = 0; float v1 = -1e30f;
#pragma unroll
            for (int j = 0; j < 8; ++j) if (le[j] > v1) { v1 = le[j]; e1 = j; }
            int e2 = 0; float v2 = -1e30f;
#pragma unroll
            for (int j = 0; j < 8; ++j) if (j != e1 && le[j] > v2) { v2 = le[j]; e2 = j; }
            const float p2 = expf(v2 - v1), inv = 1.0f / (1.0f + p2);
            const int eid0 = gi * 8 + e1, eid1 = gi * 8 + e2;
            const int s0 = (int)__hip_atomic_fetch_add(&hist[eid0], 1u, __ATOMIC_RELAXED, __HIP_MEMORY_SCOPE_WORKGROUP), s1 = (int)__hip_atomic_fetch_add(&hist[eid1], 1u, __ATOMIC_RELAXED, __HIP_MEMORY_SCOPE_WORKGROUP);
            int* tr = tok + row * 8; tr[0] = eid0; tr[1] = eid1; ((float*)tr)[2] = p_top * inv; ((float*)tr)[3] = p_top * p2 * inv; tr[4] = s0; tr[5] = s1; ((float*)tr)[6] = rstd;
        }
    }
    __syncthreads();
    if (tid < 32) ctl[CW_BCNT + blockIdx.x * 32 + tid] = hist[tid];
}

__device__ __forceinline__ void p9_scatter(const bf16_t* x1, const float* gain, const float* mod, unsigned* ctl, int* tok, bf16_t* XB, LAS unsigned* sl, int gw, int ngw, int lane, int tid) {
    const int G = gridDim.x;
    { const int e = tid & 31, part = tid >> 5; unsigned sall = 0, sbef = 0;
      for (int bb = part; bb < G; bb += 16) { const unsigned v = ctl[CW_BCNT + bb * 32 + e]; sall += v; if (bb < (int)blockIdx.x) sbef += v; }
      sl[part * 32 + e] = sall; sl[512 + part * 32 + e] = sbef; }
    __syncthreads();
    if (tid < 64) {
        unsigned cnt = 0, bef = 0;
        if (lane < 32) for (int q = 0; q < 16; ++q) { cnt += sl[q * 32 + lane]; bef += sl[512 + q * 32 + lane]; }
        const unsigned padded = (cnt + 255u) & ~255u; unsigned incl = padded;
#pragma unroll
        for (int o = 1; o < 32; o <<= 1) { const unsigned t = __shfl_up(incl, o); if ((lane & 31) >= o) incl += t; }
        const unsigned excl = incl - padded;
        if (lane < 32) sl[1024 + lane] = excl + bef;
        if (blockIdx.x == 0) {
            const unsigned total = __shfl(incl, 31);
            if (lane == 0) ctl[CW_NBLK] = total >> 8;
            if (lane < 32) for (unsigned i = excl >> 8; i < (incl >> 8); ++i) ctl[CW_BLKE + i] = (unsigned)lane;
        }
    }
    __syncthreads();
    for (int blk = blockIdx.x; blk < TL / 128; blk += gridDim.x) {
        const int R0 = 128 * blk + 16 * (tid >> 6); const float* shift = mod + (R0 >> 11) * 6144 + 3072; const float* scale = shift + 1024;
        f32x4 G[4], S[4];
#pragma unroll
        for (int j = 0; j < 4; ++j) { const int k = lane * 4 + 256 * j; G[j] = *(const f32x4*)(gain + k) * (1.0f + *(const f32x4*)(scale + k)); S[j] = *(const f32x4*)(shift + k); }
#pragma unroll 4
        for (int rr = 0; rr < 16; ++rr) { const int row = R0 + rr; const int* tr = tok + row * 8;
            const int e0 = tr[0], e1 = tr[1]; const float rstd = ((const float*)tr)[6];
            const unsigned d0 = sl[1024 + e0] + (unsigned)tr[4], d1 = sl[1024 + e1] + (unsigned)tr[5];
            u32x2 w[4];
#pragma unroll
            for (int j = 0; j < 4; ++j) { const u32x2 xb = *(const u32x2*)(x1 + (size_t)row * D + lane * 4 + 256 * j); const f32x4 o = (f32x4){bflo(xb.x), bfhi(xb.x), bflo(xb.y), bfhi(xb.y)} * rstd * G[j] + S[j]; w[j].x = pk2(o.x, o.y); w[j].y = pk2(o.z, o.w); }
#pragma unroll
            for (int j = 0; j < 4; ++j) { *(u32x2*)(XB + (size_t)d0 * D + lane * 4 + 256 * j) = w[j]; *(u32x2*)(XB + (size_t)d1 * D + lane * 4 + 256 * j) = w[j]; }
            if (lane == 0) { tok[row * 8 + 4] = (int)d0; tok[row * 8 + 5] = (int)d1; } }
    }
}

__device__ __forceinline__ void p12_final(const bf16_t* x1, float* outp, const float* mod, const int* tok, const bf16_t* YB, const float* gfin, int gw, int ngw, int lane) {
    u32x2 nxv[4]; u32x2 nya[4], nyb[4]; float nw0 = 0.f, nw1 = 0.f; int t2d0 = 0, t2d1 = 0; float t2w0 = 0.f, t2w1 = 0.f;
    if (gw < TL) { const int d0 = tok[gw * 8 + 4], d1 = tok[gw * 8 + 5]; nw0 = ((const float*)tok)[gw * 8 + 2]; nw1 = ((const float*)tok)[gw * 8 + 3];
#pragma unroll
        for (int j = 0; j < 4; ++j) { const int k = lane * 4 + 256 * j; nxv[j] = *(const u32x2*)(x1 + (size_t)gw * D + k); nya[j] = *(const u32x2*)(YB + (size_t)d0 * D + k); nyb[j] = *(const u32x2*)(YB + (size_t)d1 * D + k); } }
    if (gw + ngw < TL) { const int r2 = gw + ngw; t2d0 = tok[r2 * 8 + 4]; t2d1 = tok[r2 * 8 + 5]; t2w0 = ((const float*)tok)[r2 * 8 + 2]; t2w1 = ((const float*)tok)[r2 * 8 + 3]; }
    for (int row = gw; row < TL; row += ngw) {
        const float* ga2 = mod + (row >> 11) * 6144 + 5120; float* dst = outp + (size_t)row * D;
        const float w0 = nw0, w1 = nw1;
        f32x4 xv[4]; u32x2 ya[4], yb[4];
#pragma unroll
        for (int j = 0; j < 4; ++j) { xv[j] = (f32x4){bflo(nxv[j].x), bfhi(nxv[j].x), bflo(nxv[j].y), bfhi(nxv[j].y)}; ya[j] = nya[j]; yb[j] = nyb[j]; }
        const int nrow = row + ngw;
        if (nrow < TL) { nw0 = t2w0; nw1 = t2w1;
#pragma unroll
            for (int j = 0; j < 4; ++j) { const int k = lane * 4 + 256 * j; nxv[j] = *(const u32x2*)(x1 + (size_t)nrow * D + k); nya[j] = *(const u32x2*)(YB + (size_t)t2d0 * D + k); nyb[j] = *(const u32x2*)(YB + (size_t)t2d1 * D + k); }
            const int r2 = nrow + ngw;
            if (r2 < TL) { t2d0 = tok[r2 * 8 + 4]; t2d1 = tok[r2 * 8 + 5]; t2w0 = ((const float*)tok)[r2 * 8 + 2]; t2w1 = ((const float*)tok)[r2 * 8 + 3]; } }
        f32x4 v[4]; float ss = 0.f;
#pragma unroll
        for (int j = 0; j < 4; ++j) { const int k = lane * 4 + 256 * j; const f32x4 g = *(const f32x4*)(ga2 + k); const u32x2 a = ya[j], bq = yb[j];
            f32x4 y; y.x = w0 * bflo(a.x) + w1 * bflo(bq.x); y.y = w0 * bfhi(a.x) + w1 * bfhi(bq.x); y.z = w0 * bflo(a.y) + w1 * bflo(bq.y); y.w = w0 * bfhi(a.y) + w1 * bfhi(bq.y);
            v[j] = xv[j] + g * y; ss += v[j].x * v[j].x + v[j].y * v[j].y + v[j].z * v[j].z + v[j].w * v[j].w; }
        const float rstd = rsqrtf(wave_sum_fast(ss) * (1.0f / D) + EPS);
#pragma unroll
        for (int j = 0; j < 4; ++j) { const int k = lane * 4 + 256 * j; const f32x4 g = *(const f32x4*)(gfin + k); *(f32x4*)(dst + k) = v[j] * rstd * g; }
    }
}

typedef float f32x16 __attribute__((ext_vector_type(16)));
typedef short v4i16_t __attribute__((ext_vector_type(4)));
using pg8::bf16x8;
constexpr int ATT_CK_OFF = 2048, ATT_CV_OFF = ATT_CK_OFF + 32768, ATT_RING_OFF = ATT_CV_OFF + 32768, ATT_SK_OFF = ATT_RING_OFF + 32768, ATT_SV_OFF = ATT_SK_OFF + 11 * 2048;
static_assert(ATT_SV_OFF + 11 * 2048 <= MISC_OFF, "attention LDS map");
__device__ __forceinline__ void p3_attn(const bf16_t* Qb, bf16_t* Ob, const bf16_t* Kb, const bf16_t* Vb, const float* rpb, const f32x2* rope, LAS unsigned char* lds, int wave, int lane) {
    constexpr float L2E = 1.4426950408889634f, SC = 0.125f * L2E;
    const int tid = wave * 64 + lane, ql = lane & 31, hl = lane >> 5, skey = tid >> 3, sch = tid & 7;
    LAS float* rpbL = (LAS float*)lds;
    const int vq = (lane & 15) >> 2, vcol = (16 * ((lane >> 4) & 1) + 4 * (lane & 3)) * 2;
    const int g = wave & 1, sside = skey >= 24 && skey < 40;
    for (int it = blockIdx.x; it < NBATCH * 8 * 2; it += gridDim.x) {
        const int rh = it & 1, h = (it >> 1) & 7, b = it >> 4;
        __syncthreads();
        if (tid < 15 * 32) { const int c = tid & 31, dr = tid >> 5; rpbL[tid] = c < 31 ? rpb[(h * 15 + dr) * 31 + c] * L2E : -1e30f; }
#pragma unroll
        for (int i = 0; i < 4; ++i) { const int key = skey + 64 * i; const size_t row = (size_t)(TL + b * CTXL + key) * 512 + h * 64 + 8 * sch;
            *(LAS u32x4*)(lds + ATT_CK_OFF + key * 128 + ((sch ^ (key & 7)) * 16)) = *(const u32x4*)(Kb + row);
            *(LAS u32x4*)(lds + ATT_CV_OFF + key * 128 + sch * 16) = *(const u32x4*)(Vb + row); }
#pragma unroll 1
        for (int pass = 0; pass < 4; ++pass) {
            const int R0 = 16 * rh + 4 * pass, r = R0 + (wave >> 1);
            const int cq = 32 * g + ql, rs = min(max(r - 4, 0), 24), cstart = min(max(cq - 8, 0), 48);
            const int kmin = min(max(R0 - 4, 0), 24), kmax = min(max(R0 - 1, 0), 24) + 7, nsteps = kmax - kmin + 1;
            const bf16_t* qp = Qb + (size_t)(b * SEQ + r * 64 + cq) * 512 + h * 64; bf16_t* op = Ob + (size_t)(b * SEQ + r * 64 + cq) * 512 + h * 64;
#define ATT_PUT(slot_, krel_, kv_, vv_) do { *(LAS u32x4*)(lds + (slot_) + skey * 128 + ((sch ^ (skey & 7)) * 16)) = (kv_); *(LAS u32x4*)(lds + (slot_) + 8192 + skey * 128 + sch * 16) = (vv_); \
                if (sside) { *(LAS u32x4*)(lds + ATT_SK_OFF + ((krel_) * 16 + skey - 24) * 128 + ((sch ^ (skey & 7)) * 16)) = (kv_); *(LAS u32x4*)(lds + ATT_SV_OFF + ((krel_) * 16 + skey - 24) * 128 + sch * 16) = (vv_); } } while (0)
            { const size_t row = (size_t)(b * SEQ + kmin * 64 + skey) * 512 + h * 64 + 8 * sch; const u32x4 kv = *(const u32x4*)(Kb + row), vv = *(const u32x4*)(Vb + row); ATT_PUT(ATT_RING_OFF, 0, kv, vv); }
            bf16x8 qplain[4], qrot[4];
#pragma unroll
            for (int d0 = 0; d0 < 4; ++d0) { float v[8], o[8], pl[8]; unpack8(*(const u32x4*)(qp + 16 * d0 + 8 * hl), v);
                const int pos = d0 < 2 ? r : cq, i0 = ((16 * d0 + 8 * hl) & 31) >> 1;
#pragma unroll
                for (int j = 0; j < 4; ++j) { const f32x2 cs = rope[pos * 16 + i0 + j]; o[2 * j] = (v[2 * j] * cs.x - v[2 * j + 1] * cs.y) * SC; o[2 * j + 1] = (v[2 * j] * cs.y + v[2 * j + 1] * cs.x) * SC; }
#pragma unroll
                for (int j = 0; j < 8; ++j) pl[j] = v[j] * SC;
                qrot[d0] = __builtin_bit_cast(bf16x8, pack8(o)); qplain[d0] = __builtin_bit_cast(bf16x8, pack8(pl)); }
            int dco[16];
#pragma unroll
            for (int i = 0; i < 16; ++i) { const int kc = 32 * g + (i & 3) + 8 * (i >> 2) + 4 * hl; const bool ok = kc >= cstart && kc < cstart + 16; dco[i] = ok ? (kc - cq + 15) * 4 : 31 * 4; }
            f32x16 o0, o1;
#pragma unroll
            for (int i = 0; i < 16; ++i) { o0[i] = 0.f; o1[i] = 0.f; }
            float m = -1e30f, l = 0.f;
#define ATT_TILE(kp_, vb_, vsk_, ve_, qf) do { \
            _Pragma("unroll") for (int d0 = 0; d0 < 4; ++d0) s = __builtin_amdgcn_mfma_f32_32x32x16_bf16(*(const LAS bf16x8*)((kp_) + (((2 * d0 + hl) ^ (ql & 7)) * 16)), qf[d0], s, 0, 0, 0); \
            float mt = fmaxf(fmaxf(s[0], s[1]), s[2]); \
            _Pragma("unroll") for (int i = 3; i < 15; i += 2) mt = fmaxf(fmaxf(mt, s[i]), s[i + 1]); \
            mt = half_max(fmaxf(mt, s[15])); \
            if (__any(mt > m)) { const float mn = fmaxf(m, mt), alpha = __builtin_amdgcn_exp2f(m - mn); m = mn; l *= alpha; \
                _Pragma("unroll") for (int i = 0; i < 16; ++i) { o0[i] *= alpha; o1[i] *= alpha; } } \
            float ps = 0.f; \
            _Pragma("unroll") for (int i = 0; i < 16; ++i) { s[i] = __builtin_amdgcn_exp2f(s[i] - m); ps += s[i]; } \
            l += ps; \
            bf16x8 pb[2]; \
            _Pragma("unroll") for (int sk = 0; sk < 2; ++sk) { u32x4 w; w.x = pk2(s[8 * sk], s[8 * sk + 1]); w.y = pk2(s[8 * sk + 2], s[8 * sk + 3]); w.z = pk2(s[8 * sk + 4], s[8 * sk + 5]); w.w = pk2(s[8 * sk + 6], s[8 * sk + 7]); \
                pb[sk] = __builtin_bit_cast(bf16x8, w); } \
            _Pragma("unroll") for (int dt = 0; dt < 2; ++dt) _Pragma("unroll") for (int sk = 0; sk < 2; ++sk) { \
                const v4i16_t lo = __builtin_amdgcn_ds_read_tr16_b64_v4i16((LAS v4i16_t*)((vb_) + sk * (vsk_) + dt * 64)); \
                const v4i16_t hi = __builtin_amdgcn_ds_read_tr16_b64_v4i16((LAS v4i16_t*)((vb_) + sk * (vsk_) + (ve_) + dt * 64)); \
                const bf16x8 va = (bf16x8){lo[0], lo[1], lo[2], lo[3], hi[0], hi[1], hi[2], hi[3]}; \
                if (dt == 0) o0 = __builtin_amdgcn_mfma_f32_32x32x16_bf16(va, pb[sk], o0, 0, 0, 0); else o1 = __builtin_amdgcn_mfma_f32_32x32x16_bf16(va, pb[sk], o1, 0, 0, 0); } } while (0)
            __syncthreads();
#pragma unroll 1
            for (int st = 0; st < nsteps; ++st) {
                const int kr = kmin + st, slot = ATT_RING_OFF + (st & 1) * 16384;
                u32x4 nk, nv; const bool more = st + 1 < nsteps;
                if (more) { const size_t row = (size_t)(b * SEQ + (kr + 1) * 64 + skey) * 512 + h * 64 + 8 * sch; nk = *(const u32x4*)(Kb + row); nv = *(const u32x4*)(Vb + row); }
                if (kr >= rs && kr < rs + 8) {
                    const LAS unsigned char* brow = (const LAS unsigned char*)(rpbL + (kr - r + 7) * 32);
                    f32x16 s;
#pragma unroll
                    for (int i = 0; i < 16; ++i) s[i] = *(const LAS float*)(brow + dco[i]);
                    const LAS unsigned char* kp = lds + slot + g * 4096 + ql * 128; const LAS unsigned char* vb = lds + slot + 8192 + g * 4096 + (4 * hl + vq) * 128 + vcol;
                    ATT_TILE(kp, vb, 2048, 1024, qrot);
                }
                if (more) { const int ns = ATT_RING_OFF + ((st + 1) & 1) * 16384; ATT_PUT(ns, st + 1, nk, nv); }
                __syncthreads();
            }
#pragma unroll 1
            for (int x = 0; x < 2; ++x) {
                const int cb = g == 0 ? 8 : 0, krel0 = rs + 4 * x - kmin;
                f32x16 s;
#pragma unroll
                for (int i = 0; i < 16; ++i) { const int kc = 24 + cb + (i & 3) + 4 * hl, dr = rs + 4 * x + (i >> 2) - r + 7; const bool ok = kc >= cstart && kc < cstart + 16;
                    s[i] = ok ? rpbL[dr * 32 + (kc - cq + 15)] : -1e30f; }
                const LAS unsigned char* kp = lds + ATT_SK_OFF + ((krel0 + (ql >> 3)) * 16 + cb + (ql & 7)) * 128;
                const LAS unsigned char* vb = lds + ATT_SV_OFF + (krel0 * 16 + cb + 4 * hl + vq) * 128 + vcol;
                ATT_TILE(kp, vb, 4096, 2048, qrot);
            }
            __syncthreads();
#pragma unroll 1
            for (int ct = 0; ct < 8; ++ct) { f32x16 s;
#pragma unroll
                for (int i = 0; i < 16; ++i) s[i] = 0.f;
                const LAS unsigned char* kp = lds + ATT_CK_OFF + ct * 4096 + ql * 128; const LAS unsigned char* vb = lds + ATT_CV_OFF + ct * 4096 + (4 * hl + vq) * 128 + vcol;
                ATT_TILE(kp, vb, 2048, 1024, qplain); }
#undef ATT_TILE
#undef ATT_PUT
            l = half_sum(l);
            const float il = 1.0f / l;
#pragma unroll
            for (int dt = 0; dt < 2; ++dt)
#pragma unroll
                for (int g4 = 0; g4 < 4; ++g4) { u32x2 w;
                    if (dt == 0) { w.x = pk2(o0[4 * g4] * il, o0[4 * g4 + 1] * il); w.y = pk2(o0[4 * g4 + 2] * il, o0[4 * g4 + 3] * il); }
                    else { w.x = pk2(o1[4 * g4] * il, o1[4 * g4 + 1] * il); w.y = pk2(o1[4 * g4 + 2] * il, o1[4 * g4 + 3] * il); }
                    *(u32x2*)(op + 32 * dt + 8 * g4 + 4 * hl) = w; }
        }
    }
}

constexpr int LRU_WLDS = 8192;
constexpr int LRU_TILES = 72;
__device__ __forceinline__ void lru_conv_frags(const bf16_t* LX, const float* conv_w, const float* conv_b, size_t rowbase, int L, int s0, int n, int lane, bf16x8 (&afr)[8], bf16_t* XC) {
    const int token = lane & 31, hl = lane >> 5, s = s0 + token;
    u32x4 xr[2][2][4];
#define LRU_LDPAIR(pp, buf) do { _Pragma("unroll") for (int q = 0; q < 2; ++q) _Pragma("unroll") for (int j = 0; j < 4; ++j) { const int sj = s + j - 2; xr[buf][q][j] = (u32x4){0u, 0u, 0u, 0u}; \
        if (sj >= 0 && sj < L) xr[buf][q][j] = *(const u32x4*)(LX + (rowbase + sj) * 1024 + n * 128 + 16 * (2 * (pp) + q) + 8 * hl); } } while (0)
    LRU_LDPAIR(0, 0);
#pragma unroll
    for (int pp = 0; pp < 4; ++pp) {
        if (pp < 3) LRU_LDPAIR(pp + 1, (pp + 1) & 1);
        __builtin_amdgcn_sched_barrier(0);
#pragma unroll
        for (int q = 0; q < 2; ++q) { const int ch0 = n * 128 + 16 * (2 * pp + q) + 8 * hl;
            float acc[8];
            { const f32x4 b0 = *(const f32x4*)(conv_b + ch0), b1 = *(const f32x4*)(conv_b + ch0 + 4); acc[0] = b0.x; acc[1] = b0.y; acc[2] = b0.z; acc[3] = b0.w; acc[4] = b1.x; acc[5] = b1.y; acc[6] = b1.z; acc[7] = b1.w; }
#pragma unroll
            for (int j = 0; j < 4; ++j) { float xv[8]; unpack8(xr[pp & 1][q][j], xv);
                const f32x4 w0 = *(const f32x4*)(conv_w + j * 1024 + ch0), w1 = *(const f32x4*)(conv_w + j * 1024 + ch0 + 4);
                acc[0] += w0.x * xv[0]; acc[1] += w0.y * xv[1]; acc[2] += w0.z * xv[2]; acc[3] += w0.w * xv[3]; acc[4] += w1.x * xv[4]; acc[5] += w1.y * xv[5]; acc[6] += w1.z * xv[6]; acc[7] += w1.w * xv[7]; }
            const u32x4 pk = pack8(acc); afr[2 * pp + q] = __builtin_bit_cast(bf16x8, pk);
            if (XC) *(u32x4*)(XC + (rowbase + s) * 1024 + ch0) = pk; }
        __builtin_amdgcn_sched_barrier(0);
    }
#undef LRU_LDPAIR
}
template <int DIR>
__device__ __forceinline__ void lru_group_dir(const f32x16& accr, const f32x16& acci, const f32x16& xv, float bav, float bxv, float sp, float hin0, int hl, float (&hloc)[16], float& At, float& Ht) {
    float aloc[16], As[4], Hs[4];
#pragma unroll
    for (int g = 0; g < 4; ++g) { float h = 0.f, A = 1.f;
#pragma unroll
        for (int ee = 0; ee < 4; ++ee) { const int e4 = DIR == 0 ? ee : 3 - ee, i = 4 * g + e4;
            const float rg = __builtin_amdgcn_rcpf(1.0f + __builtin_amdgcn_exp2f(accr[i] + bav)), ig = __builtin_amdgcn_rcpf(1.0f + __builtin_amdgcn_exp2f(acci[i] + bxv));
            const float a = __builtin_amdgcn_exp2f(rg * sp), u = __builtin_amdgcn_sqrtf(__builtin_fmaf(-a, a, 1.0f)) * (ig * xv[i]);
            h = a * h + u; A *= a; hloc[i] = h; aloc[i] = A; }
        As[g] = A; Hs[g] = h; }
    float Alo[4], Ahi[4], Hlo[4], Hhi[4];
#pragma unroll
    for (int g = 0; g < 4; ++g) { const auto ra = __builtin_amdgcn_permlane32_swap(__float_as_uint(As[g]), __float_as_uint(As[g]), false, false); Alo[g] = __uint_as_float(ra[0]); Ahi[g] = __uint_as_float(ra[1]);
        const auto rh = __builtin_amdgcn_permlane32_swap(__float_as_uint(Hs[g]), __float_as_uint(Hs[g]), false, false); Hlo[g] = __uint_as_float(rh[0]); Hhi[g] = __uint_as_float(rh[1]); }
    float hin[4]; float st = hin0, Ap = 1.f, st0 = 0.f;
#pragma unroll
    for (int gg = 0; gg < 4; ++gg) { const int g = DIR == 0 ? gg : 3 - gg;
        const float A1 = DIR == 0 ? Alo[g] : Ahi[g], H1 = DIR == 0 ? Hlo[g] : Hhi[g], A2 = DIR == 0 ? Ahi[g] : Alo[g], H2 = DIR == 0 ? Hhi[g] : Hlo[g];
        const float in1 = st; st = A1 * st + H1; st0 = A1 * st0 + H1; const float in2 = st; st = A2 * st + H2; st0 = A2 * st0 + H2; Ap *= A1 * A2;
        hin[g] = (DIR == 0) == (hl == 0) ? in1 : in2; }
    At = Ap; Ht = st0;
#pragma unroll
    for (int i = 0; i < 16; ++i) hloc[i] += aloc[i] * hin[i >> 2];
}
constexpr int LRU_CONST_OFF = 131072;
template <int MODE>
__device__ __forceinline__ void p_lru(const bf16_t* LX, const bf16_t* LW, const float* conv_w, const float* conv_b, const float* ba, const float* bx, const float* SP, f32x2* AGG, bf16_t* XC, const bf16_t* LG, bf16_t* OL,
                                      LAS unsigned char* lds, int wave, int lane, int abl = 0) {
    const int G = gridDim.x, n = blockIdx.x & 7, ql = lane & 31, hl = lane >> 5, tid = wave * 64 + lane;
    LAS float* cst = (LAS float*)(lds + LRU_CONST_OFF);
    for (int idx = tid; idx < 2 * 256 * 16; idx += NTHREADS) { const int dir = idx >> 12, j = (idx >> 4) & 255, c = idx & 15;
        *(LAS u32x4*)(lds + (dir * 256 + j) * 256 + ((c ^ (j & 15)) * 16)) = *(const u32x4*)(LW + ((size_t)(dir * 8 + n) * 256 + j) * 128 + 8 * c); }
    for (int idx = tid; idx < 2 * 3 * 128; idx += NTHREADS) { const int dir = idx / 384, w = (idx / 128) % 3, c = idx & 127; const float* src = w == 0 ? ba : w == 1 ? bx : SP; cst[idx] = src[dir * 1024 + n * 128 + c] * (w == 2 ? -8.0f * 1.4426950408889634f : -1.4426950408889634f); }
    __syncthreads();
    const int tiles_per_b = MODE == 1 ? LRU_TILES : 64, nq = 16 * tiles_per_b, stride = (G >> 3) * NWAVES;
    for (int q = (blockIdx.x >> 3) * NWAVES + wave; q < nq; q += stride) {
        const int b = q / tiles_per_b, tile = MODE == 1 ? q % tiles_per_b : 8 + q % tiles_per_b;
        const size_t rowbase = tile < 8 ? (size_t)(TL + b * CTXL) : (size_t)b * SEQ; const int L = tile < 8 ? CTXL : SEQ, s0 = tile < 8 ? tile * 32 : (tile - 8) * 32;
        bf16x8 afr[8];
        if (MODE == 1) lru_conv_frags(LX, conv_w, conv_b, rowbase, L, s0, n, lane, afr, XC);
        else {
#pragma unroll
            for (int ks = 0; ks < 8; ++ks) afr[ks] = *(const bf16x8*)(XC + (abl == 4 ? (size_t)ql * 1024 : (rowbase + s0 + ql) * 1024 + n * 128) + 16 * ks + 8 * hl); }
#pragma unroll 1
        for (int cg = 0; cg < 4; ++cg) {
            const bf16x8 ax0 = cg == 0 ? afr[0] : cg == 1 ? afr[2] : cg == 2 ? afr[4] : afr[6], ax1 = cg == 0 ? afr[1] : cg == 1 ? afr[3] : cg == 2 ? afr[5] : afr[7];
            const int cl = cg * 32 + ql;
            float hinf = 0.f, hinb = 0.f;
            if (MODE == 2) { hinf = AGG[((size_t)b * LRU_TILES + tile) * 1024 + n * 128 + cl].x; hinb = AGG[((size_t)(16 + b) * LRU_TILES + tile) * 1024 + n * 128 + cl].x; }
            unsigned short gq[16];
            f32x16 xv;
#pragma unroll
            for (int i = 0; i < 16; ++i) xv[i] = 0.f;
            { bf16x8 idf[2];
#pragma unroll
              for (int kk = 0; kk < 2; ++kk)
#pragma unroll
                  for (int j = 0; j < 8; ++j) idf[kk][j] = (16 * kk + 8 * hl + j == ql) ? (short)0x3F80 : (short)0;
              xv = __builtin_amdgcn_mfma_f32_32x32x16_bf16(ax0, idf[0], xv, 0, 0, 0); xv = __builtin_amdgcn_mfma_f32_32x32x16_bf16(ax1, idf[1], xv, 0, 0, 0); }
            float hsum[16];
#pragma unroll
            for (int dir = 0; dir < 2; ++dir) {
                const LAS unsigned char* wr = lds + (dir * 256 + cl) * 256; const LAS unsigned char* wi = wr + 128 * 256;
                f32x16 accr, acci;
#pragma unroll
                for (int i = 0; i < 16; ++i) { accr[i] = 0.f; acci[i] = 0.f; }
                if (abl != 2) { bf16x8 bw[8];
#pragma unroll
                  for (int k = 0; k < 8; ++k) bw[k] = *(const LAS bf16x8*)(wr + (((2 * k + hl) ^ (cl & 15)) * 16));
#pragma unroll
                  for (int k = 0; k < 8; ++k) accr = __builtin_amdgcn_mfma_f32_32x32x16_bf16(afr[k], bw[k], accr, 0, 0, 0);
                  __builtin_amdgcn_sched_barrier(0);
#pragma unroll
                  for (int k = 0; k < 8; ++k) bw[k] = *(const LAS bf16x8*)(wi + (((2 * k + hl) ^ (cl & 15)) * 16));
#pragma unroll
                  for (int k = 0; k < 8; ++k) acci = __builtin_amdgcn_mfma_f32_32x32x16_bf16(afr[k], bw[k], acci, 0, 0, 0); }
                __builtin_amdgcn_sched_barrier(0);
                const float bav = cst[dir * 384 + cl], bxv = cst[dir * 384 + 128 + cl], sp = cst[dir * 384 + 256 + cl];
                const float hin0 = dir == 0 ? hinf : hinb;
                if (MODE == 2 && dir == 1 && abl != 3) {
#pragma unroll
                    for (int i = 0; i < 16; ++i) gq[i] = LG[(rowbase + s0 + (i & 3) + 8 * (i >> 2) + 4 * hl) * 1024 + n * 128 + cl]; }
                float hout[16], At, Ht;
                if (abl == 1) { _Pragma("unroll") for (int i = 0; i < 16; ++i) hout[i] = accr[i] + acci[i] * xv[i] + hin0 + bav + bxv + sp; At = 1.f; Ht = 0.f; }
                else if (dir == 0) lru_group_dir<0>(accr, acci, xv, bav, bxv, sp, hin0, hl, hout, At, Ht);
                else lru_group_dir<1>(accr, acci, xv, bav, bxv, sp, hin0, hl, hout, At, Ht);
                if (MODE == 1) { if (hl == 0) AGG[((size_t)(dir * 16 + b) * LRU_TILES + tile) * 1024 + n * 128 + cl] = (f32x2){At, Ht}; }
                else {
#pragma unroll
                    for (int i = 0; i < 16; ++i) hsum[i] = dir == 0 ? hout[i] : hsum[i] + hout[i]; }
            }
            if (MODE == 2) {
                if (abl == 3) { float t_ = 0.f; _Pragma("unroll") for (int i = 0; i < 16; ++i) t_ += hsum[i]; if (t_ == 123.456f) OL[0] = 0; }
                else {
#pragma unroll
                for (int i = 0; i < 16; ++i) OL[(rowbase + s0 + (i & 3) + 8 * (i >> 2) + 4 * hl) * 1024 + n * 128 + cl] = (bf16_t)f2bf(hsum[i] * bf2f(gq[i]));
                }
            }
        }
    }
}
__device__ __forceinline__ void p_lru_carry(f32x2* AGG, int tid) {
    const int gid = blockIdx.x * NTHREADS + tid;
    if (gid >= 2 * 16 * 1024) return;
    const int dir = gid >> 14, b = (gid >> 10) & 15, ch = gid & 1023;
    f32x2* base = AGG + (size_t)(dir * 16 + b) * LRU_TILES * 1024 + ch;
    float h = 0.f;
#pragma unroll 1
    for (int s0 = 0; s0 < LRU_TILES; s0 += 24) {
        f32x2 v[24];
#pragma unroll
        for (int s = 0; s < 24; ++s) { const int st = s0 + s, tile = dir == 0 ? st : (st < 8 ? 7 - st : 79 - st); v[s] = base[(size_t)tile * 1024]; }
#pragma unroll
        for (int s = 0; s < 24; ++s) { const int st = s0 + s, tile = dir == 0 ? st : (st < 8 ? 7 - st : 79 - st); base[(size_t)tile * 1024].x = h; h = v[s].x * h + v[s].y; }
    }
}

__device__ __forceinline__ unsigned char* lds_ptr(LAS unsigned char* ldsl, int i) {
    const LAS unsigned* t = (const LAS unsigned*)(ldsl + MISC_OFF + 1024) + 2 * i;
    const unsigned lo = __builtin_amdgcn_readfirstlane(t[0]), hi = __builtin_amdgcn_readfirstlane(t[1]);
    return (unsigned char*)(__attribute__((address_space(1))) unsigned char*)(((unsigned long long)hi << 32) | lo);
}
struct MArgs { const float* in[28]; float* out; unsigned char* ws; int ph_lo, ph_hi, li, extra; };
__global__ void __launch_bounds__(NTHREADS, 2) mega(MArgs a) {
    extern __shared__ __attribute__((aligned(16))) unsigned char lds[];
    const int wave = __builtin_amdgcn_readfirstlane(threadIdx.x >> 6);
#define LANE ((int)__builtin_amdgcn_mbcnt_hi(~0u, __builtin_amdgcn_mbcnt_lo(~0u, 0u)))
#define TID (wave * 64 + LANE)
    const int G = gridDim.x, gw = blockIdx.x * NWAVES + wave, ngw = G * NWAVES;
    LAS unsigned char* ldsl = (LAS unsigned char*)lds;
    volatile LAS unsigned* MISC = (volatile LAS unsigned*)(ldsl + MISC_OFF);
    for (int u = TID; u < (LDS_BYTES - MISC_OFF) / 4; u += NTHREADS) ((LAS unsigned*)(ldsl + MISC_OFF))[u] = 0u;
    __syncthreads();
    { LAS unsigned long long* pt = (LAS unsigned long long*)(ldsl + MISC_OFF + 1024);
      const int tid = TID;
      if (tid < 28) pt[tid] = (unsigned long long)a.in[tid];
      if (tid == 28) pt[28] = (unsigned long long)(a.extra ? (float*)(a.ws + WS_XB) : a.out);
      if (tid == 29) pt[29] = (unsigned long long)a.ws; }
    XcdBarrier bar = xcd_barrier_post((unsigned*)(a.ws + WS_CTL) + CW_BAR + a.li * XCD_BAR_WORDS, MISC + 8, wave == 0 && LANE == 0);
    const int lo = a.ph_lo, hi = a.ph_hi, extra = a.extra;
    __syncthreads();
#define PTR(i) ((const float*)lds_ptr(ldsl, (i)))
#define OUTP ((float*)lds_ptr(ldsl, 28))
#define WSP(off) (lds_ptr(ldsl, 29) + (off))
#define IN(k) (lo <= (k) && (k) < hi)
#define SEAM(k) do { if (IN(k) && IN((k) + 1)) xcd_barrier(bar, wave); } while (0)
    if (IN(0)) { unsigned char* ws = WSP(0); p0_prep(ws, ldsl, gw, ngw, LANE, wave); __syncthreads();
        p0_mod(PTR(1), PTR(3), PTR(4), PTR(5), PTR(20), PTR(22), (f32x4*)(ws + WS_MOD + 600 * 1024), PTR(16), (float*)(ws + WS_MOD + 760 * 1024), (float*)(ws + WS_MOD), (f32x2*)(ws + WS_MOD + 512 * 1024), (LAS float*)ldsl, TID); }
    SEAM(0);
    if (IN(1)) { unsigned char* ws = WSP(0); p1_router_tables(PTR(7), (const float*)(ws + WS_MOD), (const f32x4*)(ws + WS_MOD + 600 * 1024), PTR(21), PTR(23), (float*)(ws + WS_RWT), (float*)(ws + WS_RWT + 3 * MiB), gw, ngw, LANE);
        p1_adanorm(PTR(0), PTR(2), PTR(6), (const float*)(ws + WS_MOD), (bf16_t*)OUTP, gw, ngw, LANE); }
    SEAM(1);
    if (IN(2)) { unsigned char* ws = WSP(0); pg8::Gemm g{(const bf16_t*)OUTP, (const bf16_t*)(ws + WS_WIN), TALL, PROJ, 1024}; ProjOrder S; S.init(G, (int)blockIdx.x);
        EpiF<EpiProj> E{{(bf16_t*)(ws + WS_K), (bf16_t*)(ws + WS_V), (bf16_t*)(ws + WS_LX), (bf16_t*)(ws + WS_Q), (bf16_t*)(ws + WS_LG), (bf16_t*)(ws + WS_GA), (bf16_t*)(ws + WS_GB), (const f32x2*)(ws + WS_MOD + 512 * 1024)}};
        pg8::gemm_phase<EpiF<EpiProj>, ProjOrder, true, true>(ldsl, g, S, E, wave); }
    SEAM(2);
    if (IN(3)) { unsigned char* ws = WSP(0); bf16_t* LGb = (bf16_t*)(ws + WS_LG);
        p_lru<1>((const bf16_t*)(ws + WS_LX), (const bf16_t*)(ws + WS_LW), PTR(10), PTR(11), PTR(13), PTR(15), (const float*)(ws + WS_MOD + 760 * 1024), (f32x2*)OUTP, (bf16_t*)((unsigned char*)OUTP + 24 * MiB), LGb, LGb, ldsl, wave, LANE);
        __syncthreads(); }
    if (IN(3) || extra == 2) { unsigned char* ws = WSP(0); bf16_t* Qb = (bf16_t*)(ws + WS_Q);
        p3_attn(Qb, Qb, (const bf16_t*)(ws + WS_K), (const bf16_t*)(ws + WS_V), PTR(9), (const f32x2*)(ws + WS_MOD + 512 * 1024), ldsl, wave, LANE); }
    SEAM(3);
    if (IN(4)) p_lru_carry((f32x2*)OUTP, TID);
    if (IN(4)) { unsigned char* ws = WSP(0); bf16_t* GAb = (bf16_t*)(ws + WS_GA); pg8::Gemm g{(const bf16_t*)(ws + WS_Q), (const bf16_t*)(ws + WS_WA), TL, 1024, 512}; pg8::StaticOrder S; S.init(TL, 1024, G, (int)blockIdx.x); EpiF2<EpiUpAttn> E{{GAb, GAb}};
        pg8::gemm_phase<EpiF2<EpiUpAttn>, pg8::StaticOrder, true, true>(ldsl, g, S, E, wave); }
    SEAM(4);
    if (IN(5)) { unsigned char* ws = WSP(0); bf16_t* LGb = (bf16_t*)(ws + WS_LG);
        p_lru<2>((const bf16_t*)(ws + WS_LX), (const bf16_t*)(ws + WS_LW), PTR(10), PTR(11), PTR(13), PTR(15), (const float*)(ws + WS_MOD + 760 * 1024), (f32x2*)OUTP, (bf16_t*)((unsigned char*)OUTP + 24 * MiB), LGb, LGb, ldsl, wave, LANE, extra >= 10 ? extra - 10 : 0); }
    SEAM(5);
    if (IN(6)) { unsigned char* ws = WSP(0); bf16_t* GBb = (bf16_t*)(ws + WS_GB); pg8::Gemm g{(const bf16_t*)(ws + WS_LG), (const bf16_t*)(ws + WS_WL), TL, 1024, 1024}; pg8::StaticOrder S; S.init(TL, 1024, G, (int)blockIdx.x);
        EpiF2<EpiUpLru> E{{(const bf16_t*)(ws + WS_GA), GBb, GBb}};
        pg8::gemm_phase<EpiF2<EpiUpLru>, pg8::StaticOrder, true, true>(ldsl, g, S, E, wave); }
    SEAM(6);
    if (IN(7)) { unsigned char* ws = WSP(0); pg8::Gemm g{(const bf16_t*)(ws + WS_GB), (const bf16_t*)(ws + WS_WO), TL, 1024, 1024}; pg8::StaticOrder S; S.init(TL, 1024, G, (int)blockIdx.x);
        EpiF2<EpiOut> E{{PTR(0), (const float*)(ws + WS_MOD), (bf16_t*)(ws + WS_X1B)}};
        pg8::gemm_phase<EpiF2<EpiOut>, pg8::StaticOrder, true, true>(ldsl, g, S, E, wave); }
    SEAM(7);
    if (IN(8)) { unsigned char* ws = WSP(0);
        p8_route((const bf16_t*)(ws + WS_X1B), (const float*)(ws + WS_RWT), (const float*)(ws + WS_RWT + 3 * MiB), (unsigned*)(ws + WS_CTL), (int*)(ws + WS_TOK), ldsl, LANE, TID, wave); }
    SEAM(8);
    if (IN(9)) { unsigned char* ws = WSP(0); p9_scatter((const bf16_t*)(ws + WS_X1B), PTR(7), (const float*)(ws + WS_MOD), (unsigned*)(ws + WS_CTL), (int*)(ws + WS_TOK), (bf16_t*)(ws + WS_XB), (LAS unsigned*)ldsl, gw, ngw, LANE, TID); }
    SEAM(9);
    if (IN(10)) { unsigned char* ws = WSP(0); pg8::Gemm g{(const bf16_t*)(ws + WS_XB), (const bf16_t*)(ws + WS_W13), MOE_ROWS, 1024, 1024}; MoeOrder S; S.init((const unsigned*)(ws + WS_CTL), G, (int)blockIdx.x, (size_t)1024 * 1024 * 2);
        EpiF<EpiMoe1> E{{(bf16_t*)OUTP}};
        pg8::gemm_phase<EpiF<EpiMoe1>, MoeOrder, true, true>(ldsl, g, S, E, wave); }
    SEAM(10);
    if (IN(11)) { unsigned char* ws = WSP(0); pg8::Gemm g{(const bf16_t*)OUTP, (const bf16_t*)(ws + WS_W2), MOE_ROWS, 1024, 512}; MoeOrder S; S.init((const unsigned*)(ws + WS_CTL), G, (int)blockIdx.x, (size_t)1024 * 512 * 2);
        EpiF<EpiMoe2> E{{(bf16_t*)(ws + WS_YB)}};
        pg8::gemm_phase<EpiF<EpiMoe2>, MoeOrder, true, true>(ldsl, g, S, E, wave); }
    SEAM(11);
    if (IN(12)) { unsigned char* ws = WSP(0); p12_final((const bf16_t*)(ws + WS_X1B), OUTP, (const float*)(ws + WS_MOD), (const int*)(ws + WS_TOK), (const bf16_t*)(ws + WS_YB), PTR(27), gw, ngw, LANE); }
#undef PTR
#undef OUTP
#undef WSP
#undef LANE
#undef TID
#undef IN
#undef SEAM
}

extern "C" void kernel_launch(void* const* d_in, const int* in_sizes, int n_in, void* d_out, int out_size, void* d_ws, size_t ws_size, hipStream_t stream) {
    static int grid = 0;
    if (grid == 0) {
        if (n_in != 28 || out_size != TL * D || ws_size < WS_END) { fprintf(stderr, "kernel_launch: unexpected problem (n_in %d, out %d, ws %zu < %zu)\n", n_in, out_size, ws_size, (size_t)WS_END); grid = -1; return; }
        int dev = 0, cus = 0, per_cu = 0;
        if (hipGetDevice(&dev) != hipSuccess || hipDeviceGetAttribute(&cus, hipDeviceAttributeMultiprocessorCount, dev) != hipSuccess) { grid = -1; return; }
        if (hipFuncSetAttribute((const void*)mega, hipFuncAttributeMaxDynamicSharedMemorySize, LDS_BYTES) != hipSuccess) { fprintf(stderr, "kernel_launch: hipFuncSetAttribute failed\n"); grid = -1; return; }
        if (hipOccupancyMaxActiveBlocksPerMultiprocessor(&per_cu, (const void*)mega, NTHREADS, LDS_BYTES) != hipSuccess || per_cu < 1) { fprintf(stderr, "kernel_launch: occupancy query says %d blocks per CU\n", per_cu); grid = -1; return; }
        (void)hipGetLastError();
        grid = cus;
    }
    if (grid < 0) return;
    const float* const* in = (const float* const*)d_in;
    unsigned char* ws = (unsigned char*)d_ws; float* out = (float*)d_out;
    (void)hipMemsetAsync(ws + WS_CTL, 0, CTL_ZERO_BYTES, stream);
    MArgs a{};
    for (int i = 0; i < 28; ++i) a.in[i] = in[i];
    a.out = out; a.ws = ws;
    auto launch = [&](int lo, int hi, int li, int extra) {
        a.ph_lo = lo; a.ph_hi = hi; a.li = li; a.extra = extra; void* args[] = {&a};
        const hipError_t e = hipLaunchCooperativeKernel((const void*)mega, dim3(grid), dim3(NTHREADS), args, LDS_BYTES, stream);
        if (e != hipSuccess) fprintf(stderr, "kernel_launch: cooperative launch failed: %s (grid %d)\n", hipGetErrorString(e), grid);
    };
    launch(0, 13, 0, 0);
    EXTRA_LAUNCHES
}
```

```cpp
#include <hip/hip_runtime.h>
#include <cstdio>
#include <cstdint>

typedef float f32x2 __attribute__((ext_vector_type(2)));
typedef unsigned u32x2 __attribute__((ext_vector_type(2)));
#define EXTRA_LAUNCHES
namespace pg8 {
#define PG8_LAS __attribute__((address_space(3)))
typedef unsigned short bf16_t;
typedef short bf16x8 __attribute__((ext_vector_type(8)));
typedef float f32x4 __attribute__((ext_vector_type(4)));
typedef unsigned u32x4 __attribute__((ext_vector_type(4)));
constexpr int BM = 256, BK = 64, HALF = 128, HTB = HALF * BK * 2  , STAGE_BYTES = 8 * HTB, NXCD = 8, WGM = 8;

__host__ __device__ __forceinline__ int lds_byte(int r, int c) { const int st = (r >> 4) * 2 + (c >> 5), rr = r & 15, cc = c & 31, ob = rr * 64 + cc * 2; return st * 1024 + (ob ^ (((ob >> 9) & 1) << 5)); }
__host__ __device__ __forceinline__ void stage_rc(int b, int& R, int& C) { const int st = b / 1024, sb = b % 1024, swz = sb ^ (((sb >> 9) & 1) << 5); R = (st >> 1) * 16 + swz / 64; C = (st & 1) * 32 + (swz % 64) / 2; }
__host__ __device__ __forceinline__ int perm32(int rho) { const int n = rho >> 4, i = rho & 15; return 8 * (i >> 2) + 4 * n + (i & 3); }

struct Unit { int pm, pn; size_t bofs; };
struct Gemm { const bf16_t* A; const bf16_t* Bt; int M, N, K; };

struct StaticOrder {
    int nM, nN, nwg, G, c;
    __host__ __device__ __forceinline__ void init(int M, int N, int G_, int c_) { nM = M / BM; nN = N / BM; nwg = nM * nN; G = G_; c = c_; }
    __host__ __device__ __forceinline__ bool next(int i, Unit& u) const {
        const long L = (long)i * G + c; if (L >= nwg) return false;
        int wgid = (int)L; { const int q = nwg / NXCD, r = nwg % NXCD, xcd = wgid % NXCD, off = wgid / NXCD; wgid = (xcd < r ? xcd * (q + 1) : r * (q + 1) + (xcd - r) * q) + off; }
        const int nig = WGM * nN, gid = wgid / nig, fm = gid * WGM, gsz = (nM - fm) < WGM ? (nM - fm) : WGM;
        u.pm = fm + ((wgid % nig) % gsz); u.pn = (wgid % nig) / gsz; u.bofs = 0; return true;
    }
    __device__ __forceinline__ void a_ready(const Unit&) const {}
    __device__ __forceinline__ void done(const Unit&) const {}
};


template <class Epi, class Sched, bool ALIGN_EPI = false, bool SP2 = false>
__device__ __forceinline__ void gemm_phase(PG8_LAS unsigned char* lds, const Gemm g, const Sched& S, const Epi& E, int wid) {
    const int lane = (int)__builtin_amdgcn_mbcnt_hi(~0u, __builtin_amdgcn_mbcnt_lo(~0u, 0u)), tid = wid * 64 + lane, wr = wid >> 2, wc = wid & 3, fr = lane & 15, fq = lane >> 4;
    const int K = g.K, nt = K / BK;
    unsigned voffA[2], voffB[2];
#pragma unroll
    for (int i = 0; i < 2; ++i) { int R, C; stage_rc(tid * 16 + i * 8192, R, C); const int Rb = Epi::PERM ? ((R & ~31) + perm32(R & 31)) : R;
        voffA[i] = (unsigned)(R * K + C) * 2u; voffB[i] = (unsigned)(Rb * K + C) * 2u; }
    const size_t kstep = (size_t)(BK * 2);
    const size_t hstep = (size_t)HALF * K * 2;
    const size_t tstep = 2 * hstep;
    const unsigned ldsw = (unsigned)wid * 1024u;
    const int aoff = lds_byte(wr * 64 + fr, fq * 8), boff = lds_byte(wc * 32 + fr, fq * 8);
#define PG8_SA(b, h) (((b) * 2 + (h)) * HTB)
#define PG8_SB(b, h) ((4 + (b) * 2 + (h)) * HTB)
#define PG8_STAGE(bufoff, gbase, voff) do { _Pragma("unroll") for (int _i = 0; _i < 2; ++_i) \
        __builtin_amdgcn_global_load_lds((const unsigned*)((const char*)(gbase) + (voff)[_i]), (PG8_LAS unsigned*)(lds + (bufoff) + ldsw + _i * 8192), 16, 0, 0); } while (0)
#define PG8_LDA(dst, b, h) do { _Pragma("unroll") for (int m = 0; m < 4; ++m) _Pragma("unroll") for (int k = 0; k < 2; ++k) dst[m][k] = *(const PG8_LAS bf16x8*)(lds + PG8_SA(b, h) + aoff + m * 2048 + k * 1024); } while (0)
#define PG8_LDB(dst, b, h) do { _Pragma("unroll") for (int n = 0; n < 2; ++n) _Pragma("unroll") for (int k = 0; k < 2; ++k) dst[n][k] = *(const PG8_LAS bf16x8*)(lds + PG8_SB(b, h) + boff + n * 2048 + k * 1024); } while (0)
#define PG8_MMA(ai, bj, At, Bt) do { __builtin_amdgcn_s_setprio(1); _Pragma("unroll") for (int m = 0; m < 4; ++m) _Pragma("unroll") for (int n = 0; n < 2; ++n) _Pragma("unroll") for (int k = 0; k < 2; ++k) \
        acc[ai][bj][m][n] = __builtin_amdgcn_mfma_f32_16x16x32_bf16(Bt[n][k], At[m][k], acc[ai][bj][m][n], 0, 0, 0); __builtin_amdgcn_s_setprio(0); } while (0)
#define PG8_WAIT_V(n) asm volatile("s_waitcnt vmcnt(" #n ")" ::: "memory")
#define PG8_WAIT_L(n) asm volatile("s_waitcnt lgkmcnt(" #n ")" ::: "memory")
#define PG8_BAR __builtin_amdgcn_s_barrier()
#define PG8_SCHED __builtin_amdgcn_sched_barrier(0)
    Unit cur, nxt; int ui = 0;
    if (!S.next(0, cur)) return;
    f32x4 acc[2][2][4][2];
#pragma unroll
    for (int a = 0; a < 2; ++a)
#pragma unroll
        for (int b = 0; b < 2; ++b)
#pragma unroll
            for (int m = 0; m < 4; ++m)
#pragma unroll
                for (int n = 0; n < 2; ++n) acc[a][b][m][n] = (f32x4){0.f, 0.f, 0.f, 0.f};
    bf16x8 At[4][2], B0[2][2], B1[2][2];
    const char* cA = (const char*)g.A + (size_t)cur.pm * tstep; const char* cB = (const char*)g.Bt + (size_t)cur.pn * tstep + cur.bofs;
    S.a_ready(cur);
    if constexpr (SP2) {
        PG8_STAGE(PG8_SB(0, 0), cB, voffB); PG8_STAGE(PG8_SB(0, 1), cB + hstep, voffB); PG8_STAGE(PG8_SA(0, 0), cA, voffA); PG8_STAGE(PG8_SA(0, 1), cA + hstep, voffA);
        if (wr == 1) PG8_BAR;
        PG8_WAIT_V(2); PG8_BAR;
        PG8_STAGE(PG8_SB(1, 0), cB + kstep, voffB); PG8_STAGE(PG8_SA(1, 0), cA + kstep, voffA); PG8_STAGE(PG8_SB(1, 1), cB + hstep + kstep, voffB);
        PG8_WAIT_V(6); PG8_BAR;
    } else {
        PG8_STAGE(PG8_SB(0, 0), cB, voffB); PG8_STAGE(PG8_SA(0, 0), cA, voffA); PG8_STAGE(PG8_SB(0, 1), cB + hstep, voffB); PG8_STAGE(PG8_SA(0, 1), cA + hstep, voffA);
        if (wr == 1) PG8_BAR;
        PG8_WAIT_V(4); PG8_BAR;
        PG8_STAGE(PG8_SB(1, 0), cB + kstep, voffB); PG8_STAGE(PG8_SA(1, 0), cA + kstep, voffA); PG8_STAGE(PG8_SB(1, 1), cB + hstep + kstep, voffB);
        PG8_WAIT_V(6); PG8_BAR;
    }
    for (;;) {
        const bool has_next = S.next(ui + 1, nxt);
        const char* nA = has_next ? (const char*)g.A + (size_t)nxt.pm * tstep : cA; const char* nB = has_next ? (const char*)g.Bt + (size_t)nxt.pn * tstep + nxt.bofs : cB;
        for (int t = 0; t < nt; t += 2) {
            const bool last = (t == nt - 2);
            const char* a1 = cA + (size_t)(t + 1) * kstep;
            const char* a2 = last ? nA : cA + (size_t)(t + 2) * kstep; const char* b2 = last ? nB : cB + (size_t)(t + 2) * kstep;
            const char* a3 = a2 + kstep; const char* b3 = b2 + kstep;
            if (last && has_next) S.a_ready(nxt);
            if constexpr (SP2) {
            PG8_LDB(B0, 0, 0); PG8_LDB(B1, 0, 1); PG8_SCHED; PG8_LDA(At, 0, 0); PG8_STAGE(PG8_SA(1, 1), a1 + hstep, voffA);
            PG8_WAIT_V(8); PG8_WAIT_L(0); PG8_BAR; PG8_MMA(0, 0, At, B0); PG8_MMA(0, 1, At, B1); PG8_BAR; PG8_SCHED;
            PG8_LDA(At, 0, 1); PG8_STAGE(PG8_SB(0, 0), b2, voffB); PG8_STAGE(PG8_SB(0, 1), b2 + hstep, voffB); PG8_STAGE(PG8_SA(0, 0), a2, voffA);
            PG8_WAIT_V(8); PG8_WAIT_L(0); PG8_BAR; PG8_MMA(1, 0, At, B0); PG8_MMA(1, 1, At, B1); PG8_BAR; PG8_SCHED;
            PG8_LDB(B0, 1, 0); PG8_LDB(B1, 1, 1); PG8_SCHED; PG8_LDA(At, 1, 0); PG8_STAGE(PG8_SA(0, 1), a2 + hstep, voffA);
            PG8_WAIT_V(8); PG8_WAIT_L(0); PG8_BAR; PG8_MMA(0, 0, At, B0); PG8_MMA(0, 1, At, B1); PG8_BAR; PG8_SCHED;
            PG8_LDA(At, 1, 1); PG8_STAGE(PG8_SB(1, 0), b3, voffB); PG8_STAGE(PG8_SB(1, 1), b3 + hstep, voffB); PG8_STAGE(PG8_SA(1, 0), a3, voffA);
            PG8_WAIT_V(8); PG8_WAIT_L(0); PG8_BAR; PG8_MMA(1, 0, At, B0); PG8_MMA(1, 1, At, B1); PG8_BAR; PG8_SCHED;
            } else {
            PG8_LDB(B0, 0, 0); PG8_SCHED; PG8_LDA(At, 0, 0); PG8_STAGE(PG8_SA(1, 1), a1 + hstep, voffA);
            PG8_WAIT_L(8); PG8_BAR; PG8_WAIT_L(0); PG8_MMA(0, 0, At, B0); PG8_BAR; PG8_SCHED;
            PG8_LDB(B1, 0, 1); PG8_STAGE(PG8_SB(0, 0), b2, voffB);
            PG8_BAR; PG8_WAIT_L(0); PG8_MMA(0, 1, At, B1); PG8_BAR;
            PG8_LDA(At, 0, 1); PG8_STAGE(PG8_SA(0, 0), a2, voffA);
            PG8_BAR; PG8_WAIT_L(0); PG8_MMA(1, 0, At, B0); PG8_BAR; PG8_SCHED;
            PG8_STAGE(PG8_SB(0, 1), b2 + hstep, voffB);
            PG8_WAIT_V(6); PG8_BAR; PG8_MMA(1, 1, At, B1); PG8_BAR;
            PG8_LDB(B0, 1, 0); PG8_SCHED; PG8_LDA(At, 1, 0); PG8_STAGE(PG8_SA(0, 1), a2 + hstep, voffA);
            PG8_WAIT_L(8); PG8_BAR; PG8_WAIT_L(0); PG8_MMA(0, 0, At, B0); PG8_BAR; PG8_SCHED;
            PG8_LDB(B1, 1, 1); PG8_STAGE(PG8_SB(1, 0), b3, voffB);
            PG8_BAR; PG8_WAIT_L(0); PG8_MMA(0, 1, At, B1); PG8_BAR;
            PG8_LDA(At, 1, 1); PG8_STAGE(PG8_SA(1, 0), a3, voffA);
            PG8_BAR; PG8_WAIT_L(0); PG8_MMA(1, 0, At, B0); PG8_BAR; PG8_SCHED;
            PG8_STAGE(PG8_SB(1, 1), b3 + hstep, voffB);
            PG8_WAIT_V(6); PG8_BAR; PG8_MMA(1, 1, At, B1); PG8_BAR;
            }
        }
        if constexpr (ALIGN_EPI) { if (wr == 0) PG8_BAR; }
        if constexpr (!Epi::AFTER_DRAIN) { E(acc, cur, wr, wc, fr, fq); S.done(cur); }
        if (!has_next) break;
#pragma unroll
        for (int a = 0; a < 2; ++a)
#pragma unroll
            for (int b = 0; b < 2; ++b)
#pragma unroll
                for (int m = 0; m < 4; ++m)
#pragma unroll
                    for (int n = 0; n < 2; ++n) acc[a][b][m][n] = (f32x4){0.f, 0.f, 0.f, 0.f};
        cur = nxt; cA = nA; cB = nB; ++ui;
        if constexpr (ALIGN_EPI) { if (wr == 1) PG8_BAR; }
    }
    PG8_WAIT_V(0);
    if constexpr (!ALIGN_EPI) { if (wr == 0) PG8_BAR; }
    PG8_BAR;
    if constexpr (Epi::AFTER_DRAIN) { E.fused(acc, cur, wr, wc, fr, fq, lds, wid, lane); S.done(cur); }
#undef PG8_SA
#undef PG8_SB
#undef PG8_STAGE
#undef PG8_LDA
#undef PG8_LDB
#undef PG8_MMA
#undef PG8_WAIT_V
#undef PG8_WAIT_L
#undef PG8_BAR
#undef PG8_SCHED
}
}
using pg8::bf16_t; using pg8::f32x4; using pg8::u32x4;
#define LAS __attribute__((address_space(3)))

constexpr int D = 1024, NBATCH = 16, SEQ = 2048, CTXL = 256;
constexpr int TL = NBATCH * SEQ;
constexpr int TC = NBATCH * CTXL;
constexpr int TALL = TL + TC;
constexpr int PROJ = 5632;
constexpr int NEXP = 32, DEXP = 512;
constexpr int MOE_ROWS = 288 * 256;
constexpr float EPS = 1e-6f;
constexpr int NWAVES = 8, NTHREADS = 512;

constexpr size_t MiB = 1u << 20;
constexpr size_t WS_CTL = 0;
constexpr size_t CTL_ZERO_BYTES = 256 * 1024;
constexpr size_t WS_MOD = 1 * MiB;
constexpr size_t WS_TOK = 2 * MiB;
constexpr size_t WS_RWT = 3 * MiB;
constexpr size_t WS_WIN = 13 * MiB;
constexpr size_t WS_WA = 24 * MiB;
constexpr size_t WS_WL = 25 * MiB;
constexpr size_t WS_WO = 27 * MiB;
constexpr size_t WS_LW = 29 * MiB;
constexpr size_t WS_W13 = 30 * MiB;
constexpr size_t WS_W2 = 94 * MiB;
constexpr size_t WS_K = 126 * MiB;
constexpr size_t WS_V = 162 * MiB;
constexpr size_t WS_LX = 198 * MiB;
constexpr size_t WS_XB = WS_K;
constexpr size_t WS_Q = 270 * MiB;
constexpr size_t WS_LG = 302 * MiB;
constexpr size_t WS_H2 = WS_Q;
constexpr size_t WS_X1B = WS_LG;
constexpr size_t WS_GA = 366 * MiB;
constexpr size_t WS_GB = 398 * MiB;
constexpr size_t WS_Y = 430 * MiB;
constexpr size_t WS_YB = WS_GA;
constexpr size_t WS_END = 510 * MiB;
constexpr int CW_COUNT = 0, CW_CURSOR = 64, CW_NBLK = 128, CW_BLKE = 192;
constexpr int CW_BCNT = 16384;
constexpr int CW_BAR = 1024;

constexpr int RING_BYTES = 131072;
constexpr int MISC_OFF = 147456;
constexpr int LDS_BYTES = 163840;

__device__ __forceinline__ unsigned f2bf(float f) { unsigned u = __float_as_uint(f); return (u + 0x7fffu + ((u >> 16) & 1u)) >> 16; }
__device__ __forceinline__ float bf2f(unsigned h) { return __uint_as_float(h << 16); }
typedef __bf16 bf16x2_t __attribute__((ext_vector_type(2)));
__device__ __forceinline__ unsigned pk2(float lo, float hi) { const f32x2 v = {lo, hi}; const bf16x2_t b = __builtin_convertvector(v, bf16x2_t); return __builtin_bit_cast(unsigned, b); }
__device__ __forceinline__ float bflo(unsigned w) { return __uint_as_float(w << 16); }
__device__ __forceinline__ float bfhi(unsigned w) { return __uint_as_float(w & 0xffff0000u); }
__device__ __forceinline__ void unpack8(u32x4 w, float (&v)[8]) { v[0] = bflo(w.x); v[1] = bfhi(w.x); v[2] = bflo(w.y); v[3] = bfhi(w.y); v[4] = bflo(w.z); v[5] = bfhi(w.z); v[6] = bflo(w.w); v[7] = bfhi(w.w); }
__device__ __forceinline__ u32x4 pack8(const float (&v)[8]) { u32x4 w; w.x = pk2(v[0], v[1]); w.y = pk2(v[2], v[3]); w.z = pk2(v[4], v[5]); w.w = pk2(v[6], v[7]); return w; }
__device__ __forceinline__ unsigned q8(float v) { return (unsigned)(v * 255.0f + 0.5f); }
__device__ __forceinline__ u32x2 packq8(const float (&v)[8]) { u32x2 w; w.x = q8(v[0]) | (q8(v[1]) << 8) | (q8(v[2]) << 16) | (q8(v[3]) << 24); w.y = q8(v[4]) | (q8(v[5]) << 8) | (q8(v[6]) << 16) | (q8(v[7]) << 24); return w; }
__device__ __forceinline__ void unpackq8(u32x2 w, float (&v)[8]) { const float s = 1.0f / 255.0f;
    v[0] = (float)(w.x & 255u) * s; v[1] = (float)((w.x >> 8) & 255u) * s; v[2] = (float)((w.x >> 16) & 255u) * s; v[3] = (float)(w.x >> 24) * s;
    v[4] = (float)(w.y & 255u) * s; v[5] = (float)((w.y >> 8) & 255u) * s; v[6] = (float)((w.y >> 16) & 255u) * s; v[7] = (float)(w.y >> 24) * s; }
__device__ __forceinline__ float fast_exp(float x) { return __builtin_amdgcn_exp2f(x * 1.4426950408889634f); }
__device__ __forceinline__ float sigmoid_fast(float x) { return __builtin_amdgcn_rcpf(1.0f + fast_exp(-x)); }
__device__ __forceinline__ float silu_fast(float x) { return x * sigmoid_fast(x); }
__device__ __forceinline__ float gelu_tanh_fast(float x) { const float u2 = 1.5957691216057308f * (x + 0.044715f * x * x * x); return x * sigmoid_fast(u2); }
__device__ __forceinline__ float sigmoidf_(float x) { return 1.0f / (1.0f + expf(-x)); }
__device__ __forceinline__ float siluf_(float x) { return x / (1.0f + expf(-x)); }
__device__ __forceinline__ float wave_sum(float v) {
#pragma unroll
    for (int o = 1; o < 64; o <<= 1) v += __shfl_xor(v, o);
    return v;
}

template <int CTRL> __device__ __forceinline__ float dpp_f(float v) { return __int_as_float(__builtin_amdgcn_update_dpp(0, __float_as_int(v), CTRL, 0xF, 0xF, true)); }
__device__ __forceinline__ float row16_sum(float v) { v += dpp_f<0xB1>(v); v += dpp_f<0x4E>(v); v += dpp_f<0x141>(v); v += dpp_f<0x140>(v); return v; }
__device__ __forceinline__ float comb32(float a, float b) { const auto r = __builtin_amdgcn_permlane32_swap(__float_as_uint(a), __float_as_uint(b), false, false); return __uint_as_float(r[0]) + __uint_as_float(r[1]); }
__device__ __forceinline__ float comb16(float a, float b) { const auto r = __builtin_amdgcn_permlane16_swap(__float_as_uint(a), __float_as_uint(b), false, false); return __uint_as_float(r[0]) + __uint_as_float(r[1]); }
__device__ __forceinline__ float lane_f(float v, int l) { return __int_as_float(__builtin_amdgcn_readlane(__float_as_int(v), l)); }
__device__ __forceinline__ float wave_sum_fast(float v) { v = row16_sum(v); return (lane_f(v, 0) + lane_f(v, 16)) + (lane_f(v, 32) + lane_f(v, 48)); }
__device__ __forceinline__ float half_max(float v) { const auto r = __builtin_amdgcn_permlane32_swap(__float_as_uint(v), __float_as_uint(v), false, false); return fmaxf(__uint_as_float(r[0]), __uint_as_float(r[1])); }
__device__ __forceinline__ float half_sum(float v) { const auto r = __builtin_amdgcn_permlane32_swap(__float_as_uint(v), __float_as_uint(v), false, false); return __uint_as_float(r[0]) + __uint_as_float(r[1]); }

struct EpiProj {
    bf16_t *Kb, *Vb, *LXb, *Qb, *LGb; unsigned char *GAq, *GBq; const f32x2* rope;
    __device__ __forceinline__ void operator()(int row, int col, const float (&v)[8]) const {
        float o[8];
        if (col < 512) {
            if (row < TL) { const int t = row & 2047, p = col & 63, pos = (p < 32) ? (t >> 6) : (t & 63), i0 = (p & 31) >> 1;
#pragma unroll
                for (int j = 0; j < 4; ++j) { const f32x2 cs = rope[pos * 16 + i0 + j]; o[2 * j] = v[2 * j] * cs.x - v[2 * j + 1] * cs.y; o[2 * j + 1] = v[2 * j] * cs.y + v[2 * j + 1] * cs.x; }
            } else {
#pragma unroll
                for (int j = 0; j < 8; ++j) o[j] = v[j]; }
            *(u32x4*)(Kb + (size_t)row * 512 + col) = pack8(o);
        } else if (col < 1024) { *(u32x4*)(Vb + (size_t)row * 512 + (col - 512)) = pack8(v);
        } else if (col < 2048) { *(u32x4*)(LXb + (size_t)row * 1024 + (col - 1024)) = pack8(v);
        } else if (col < 2560) { *(u32x4*)(Qb + (size_t)row * 512 + (col - 2048)) = pack8(v);
        } else if (col < 3584) {
#pragma unroll
            for (int j = 0; j < 8; ++j) o[j] = gelu_tanh_fast(v[j]);
            *(u32x4*)(LGb + (size_t)row * 1024 + (col - 2560)) = pack8(o);
        } else {
#pragma unroll
            for (int j = 0; j < 8; ++j) o[j] = sigmoid_fast(v[j]);
            unsigned char* dst = (col < 4608) ? GAq + (size_t)row * 1024 + (col - 3584) : GBq + (size_t)row * 1024 + (col - 4608);
            *(u32x2*)dst = packq8(o);
        }
    }
};
struct EpiUpAttn {
    const unsigned char* GA; bf16_t* OUT;
    struct P { u32x2 g; };
    __device__ __forceinline__ void load(int row, int col, P& p) const { p.g = *(const u32x2*)(GA + (size_t)row * 1024 + col); }
    __device__ __forceinline__ void apply(int row, int col, const float (&v)[8], const P& p) const {
        float g[8], o[8]; unpackq8(p.g, g);
#pragma unroll
        for (int j = 0; j < 8; ++j) o[j] = g[j] * v[j];
        *(u32x4*)(OUT + (size_t)row * 1024 + col) = pack8(o);
    }
};
struct EpiUpLru {
    const bf16_t* Y; const unsigned char* GB; bf16_t* OUT;
    struct P { u32x2 g; u32x4 y; };
    __device__ __forceinline__ void load(int row, int col, P& p) const { p.g = *(const u32x2*)(GB + (size_t)row * 1024 + col); p.y = *(const u32x4*)(Y + (size_t)row * 1024 + col); }
    __device__ __forceinline__ void apply(int row, int col, const float (&v)[8], const P& p) const {
        float g[8], y[8], o[8]; unpackq8(p.g, g); unpack8(p.y, y);
#pragma unroll
        for (int j = 0; j < 8; ++j) o[j] = y[j] + g[j] * v[j];
        *(u32x4*)(OUT + (size_t)row * 1024 + col) = pack8(o);
    }
};
struct EpiOut {
    const float* x; const float* mod; bf16_t* x1;
    struct P { f32x4 x0, x1v, g0, g1; };
    __device__ __forceinline__ void load(int row, int col, P& p) const { const float* ga1 = mod + (row >> 11) * 6144 + 2048 + col; const float* xr = x + (size_t)row * D + col;
        p.x0 = *(const f32x4*)xr; p.x1v = *(const f32x4*)(xr + 4); p.g0 = *(const f32x4*)ga1; p.g1 = *(const f32x4*)(ga1 + 4); }
    __device__ __forceinline__ void apply(int row, int col, const float (&v)[8], const P& p) const {
        const float o[8] = {p.x0.x + p.g0.x * v[0], p.x0.y + p.g0.y * v[1], p.x0.z + p.g0.z * v[2], p.x0.w + p.g0.w * v[3], p.x1v.x + p.g1.x * v[4], p.x1v.y + p.g1.y * v[5], p.x1v.z + p.g1.z * v[6], p.x1v.w + p.g1.w * v[7]};
        *(u32x4*)(x1 + (size_t)row * D + col) = pack8(o);
    }
};
struct EpiMoe1 {
    bf16_t* HM;
    __device__ __forceinline__ void operator()(int row, int col, const float (&v)[8]) const {
        u32x2 w; w.x = pk2(silu_fast(v[0]) * v[1], silu_fast(v[2]) * v[3]); w.y = pk2(silu_fast(v[4]) * v[5], silu_fast(v[6]) * v[7]);
        *(u32x2*)(HM + (size_t)row * DEXP + (col >> 1)) = w;
    }
};
struct EpiMoe2 {
    bf16_t* YB;
    __device__ __forceinline__ void operator()(int row, int col, const float (&v)[8]) const { *(u32x4*)(YB + (size_t)row * D + col) = pack8(v); }
};
template <class F> struct EpiF {
    static constexpr bool PERM = true, AFTER_DRAIN = false; F f;
    __device__ __forceinline__ void operator()(const f32x4 (&acc)[2][2][4][2], const pg8::Unit& u, int wr, int wc, int fr, int fq) const {
#pragma unroll
        for (int ai = 0; ai < 2; ++ai)
#pragma unroll
            for (int m = 0; m < 4; ++m) { const int row = u.pm * 256 + ai * 128 + wr * 64 + m * 16 + fr;
#pragma unroll
                for (int bj = 0; bj < 2; ++bj) { const int col = u.pn * 256 + bj * 128 + wc * 32 + 8 * fq; const f32x4 a = acc[ai][bj][m][0], b = acc[ai][bj][m][1];
                    const float v[8] = {a[0], a[1], a[2], a[3], b[0], b[1], b[2], b[3]}; f(row, col, v); } }
    }
};
template <class F> struct EpiF2 {
    static constexpr bool PERM = true, AFTER_DRAIN = false; F f;
    __device__ __forceinline__ void operator()(const f32x4 (&acc)[2][2][4][2], const pg8::Unit& u, int wr, int wc, int fr, int fq) const {
#pragma unroll
        for (int ai = 0; ai < 2; ++ai)
#pragma unroll
            for (int mp = 0; mp < 2; ++mp) {
                typename F::P pre[2][2];
#pragma unroll
                for (int mm = 0; mm < 2; ++mm)
#pragma unroll
                    for (int bj = 0; bj < 2; ++bj) f.load(u.pm * 256 + ai * 128 + wr * 64 + (2 * mp + mm) * 16 + fr, u.pn * 256 + bj * 128 + wc * 32 + 8 * fq, pre[mm][bj]);
#pragma unroll
                for (int mm = 0; mm < 2; ++mm)
#pragma unroll
                    for (int bj = 0; bj < 2; ++bj) { const int m = 2 * mp + mm; const f32x4 a = acc[ai][bj][m][0], b = acc[ai][bj][m][1];
                        const float v[8] = {a[0], a[1], a[2], a[3], b[0], b[1], b[2], b[3]};
                        f.apply(u.pm * 256 + ai * 128 + wr * 64 + m * 16 + fr, u.pn * 256 + bj * 128 + wc * 32 + 8 * fq, v, pre[mm][bj]); }
                asm volatile("" ::: "memory");
            }
    }
};

struct ProjOrder {
    pg8::StaticOrder so; int G, c;
    __device__ __forceinline__ void init(int G_, int c_) { so.init(TL, PROJ, G_, c_); G = G_; c = c_; }
    __device__ __forceinline__ bool next(int i, pg8::Unit& u) const {
        const int L = i * G + c;
        if (L < so.nwg) return so.next(i, u);
        const int j = L - so.nwg; if (j >= 128) return false;
        u.pm = 128 + (j >> 3); u.pn = j & 7; u.bofs = 0; return true;
    }
    __device__ __forceinline__ void a_ready(const pg8::Unit&) const {}
    __device__ __forceinline__ void done(const pg8::Unit&) const {}
};
struct MoeOrder {
    const unsigned* ctl; int G, vcu, nunits; size_t estride;
    __device__ __forceinline__ void init(const unsigned* ctl_, int G_, int bx, size_t es) { ctl = ctl_; G = G_; vcu = (G_ % 8 == 0) ? (bx % 8) * (G_ / 8) + bx / 8 : bx; nunits = (int)ctl_[CW_NBLK] * 4; estride = es; }
    __device__ __forceinline__ bool next(int i, pg8::Unit& u) const {
        const int L = i * G + vcu; if (L >= nunits) return false;
        u.pm = L >> 2; u.pn = L & 3; u.bofs = (size_t)ctl[CW_BLKE + u.pm] * estride; return true;
    }
    __device__ __forceinline__ void a_ready(const pg8::Unit&) const {}
    __device__ __forceinline__ void done(const pg8::Unit&) const {}
};

#define XB_TMO      128
#define XB_XCNT(j)  (256  + 64 * (j))
#define XB_XSUB(j)  (1280 + 64 * (j))
#define XB_XGEN(j)  (2304 + 64 * (j))
#define XB_TOP      3328
#define XB_TOPGEN   3392
#define XCD_BAR_WORDS 3456
#define XB_SPIN_CAP (1u << 18)

__device__ __forceinline__ unsigned xb_ld(unsigned* p)              { return __hip_atomic_load(p, __ATOMIC_RELAXED, __HIP_MEMORY_SCOPE_AGENT); }
__device__ __forceinline__ unsigned xb_add(unsigned* p, unsigned v) { return __hip_atomic_fetch_add(p, v, __ATOMIC_RELAXED, __HIP_MEMORY_SCOPE_AGENT); }
__device__ __forceinline__ unsigned xb_xcc_id() { return (unsigned)__builtin_amdgcn_s_getreg((3 << 11) | 20) & 0xFu; }
#define XB_SPIN(cond, bar) do { unsigned _sp = 0; while (cond) { __builtin_amdgcn_s_sleep(1); \
    if ((++_sp & 255u) == 0u) { if (xb_ld(&(bar)[XB_TMO])) break; if (_sp > XB_SPIN_CAP) { atomicAdd(&(bar)[XB_TMO], 1u); break; } } } } while (0)

struct XcdBarrier {
    unsigned* bar; unsigned x;
    volatile LAS unsigned* st;
};

__device__ __forceinline__ XcdBarrier xcd_barrier_post(unsigned* bar, volatile LAS unsigned* st, bool leader) {
    XcdBarrier b; b.bar = bar; b.x = xb_xcc_id(); b.st = st;
    if (leader) (void)xb_add(&bar[XB_XCNT(b.x)], 1u);
    return b;
}
__device__ __forceinline__ void xcd_barrier_complete(unsigned* bar, unsigned x, unsigned& nloc, unsigned& nx) {
    const unsigned G = gridDim.x * gridDim.y * gridDim.z;
    unsigned sum, cnt, mine, sp = 0u;
    for (;;) {
        sum = 0u; cnt = 0u; mine = 0u;
#pragma unroll
        for (unsigned j = 0; j < 16; ++j) { const unsigned c = xb_ld(&bar[XB_XCNT(j)]); sum += c; cnt += (c > 0u) ? 1u : 0u; mine = (j == x) ? c : mine; }
        if (sum == G) break;
        __builtin_amdgcn_s_sleep(1);
        if ((++sp & 255u) == 0u) { if (xb_ld(&bar[XB_TMO])) break; if (sp > XB_SPIN_CAP) { atomicAdd(&bar[XB_TMO], 1u); break; } }
    }
    nloc = mine > 0u ? mine : 1u; nx = cnt > 0u ? cnt : 1u;
}

__device__ __forceinline__ void xcd_barrier(const XcdBarrier& b, int wave) {
    const bool leader_ = wave == 0 && __builtin_amdgcn_mbcnt_hi(~0u, __builtin_amdgcn_mbcnt_lo(~0u, 0u)) == 0u;
    asm volatile("s_waitcnt vmcnt(0)" ::: "memory");
    __syncthreads();
    if (leader_) {
        unsigned* bar = b.bar;
        __builtin_amdgcn_s_waitcnt(0);
        unsigned nloc = b.st[0], nx = b.st[1];
        if (nloc == 0u) { xcd_barrier_complete(bar, b.x, nloc, nx); b.st[0] = nloc; b.st[1] = nx; }
        const unsigned old = xb_add(&bar[XB_XSUB(b.x)], 1u);
        const unsigned gen = old / nloc;
        if (old + 1u == (gen + 1u) * nloc) {
            __builtin_amdgcn_fence(__ATOMIC_RELEASE, "agent");
            asm volatile("s_waitcnt vmcnt(0)" ::: "memory");
            const unsigned og = xb_add(&bar[XB_TOP], 1u);
            const unsigned tg = og / nx;
            if (og + 1u == (tg + 1u) * nx) xb_add(&bar[XB_TOPGEN], 1u);
            else XB_SPIN(xb_ld(&bar[XB_TOPGEN]) == tg, bar);
            __builtin_amdgcn_fence(__ATOMIC_ACQUIRE, "agent");
            xb_add(&bar[XB_XGEN(b.x)], 1u);
            asm volatile("s_waitcnt vmcnt(0)" ::: "memory");
        } else {
            XB_SPIN(xb_ld(&bar[XB_XGEN(b.x)]) == gen, bar);
            __builtin_amdgcn_fence(__ATOMIC_ACQUIRE, "agent");
            asm volatile("s_waitcnt vmcnt(0)" ::: "memory");
        }
    }
    __syncthreads();
}

__device__ __forceinline__ int win_perm(int n) {
    const bool qk = (n < 512) || (n >= 2048 && n < 2560);
    if (!qk) return n;
    const int d = n & 63, base = n - d, half = d >> 5, dd = d & 31, i = dd & 15, comp = dd >> 4;
    return base + half * 32 + 2 * i + comp;
}
template <int K, int N, int MODE, int ROWMUL>
__device__ __forceinline__ void prep_item(const float* W, bf16_t* WT, int rowoff, unsigned dstride, LAS float* scr, int item, int lane, float wscale = 1.0f) {
    constexpr int nblk = N / 32, per = (K / 64) * nblk;
    const int bi = item / per, r = item % per, kb = r / nblk, nb = r % nblk, k0 = 64 * kb, n0 = 32 * nb;
    const float* src = W + (size_t)bi * K * N;
    { float t_[32];
#pragma unroll
      for (int i = 0; i < 32; ++i) t_[i] = __builtin_nontemporal_load(src + (size_t)(k0 + 2 * i + (lane >> 5)) * N + n0 + (lane & 31));
#pragma unroll
      for (int i = 0; i < 32; ++i) scr[(2 * i + (lane >> 5)) * 33 + (lane & 31)] = t_[i]; }
    asm volatile("s_waitcnt lgkmcnt(0)" ::: "memory");
    const int c = lane & 7;
#pragma unroll
    for (int j = 0; j < 4; ++j) { const int n = (lane >> 3) + 8 * j; const LAS float* s = scr + (8 * c) * 33 + n;
        u32x4 o; o.x = pk2(s[0 * 33] * wscale, s[1 * 33] * wscale); o.y = pk2(s[2 * 33] * wscale, s[3 * 33] * wscale); o.z = pk2(s[4 * 33] * wscale, s[5 * 33] * wscale); o.w = pk2(s[6 * 33] * wscale, s[7 * 33] * wscale);
        int ng = n0 + n; if (MODE == 1) ng = win_perm(ng);
        *(u32x4*)(WT + (size_t)bi * dstride + (size_t)(ROWMUL * ng + rowoff) * K + k0 + 8 * c) = o; }
    asm volatile("s_waitcnt lgkmcnt(0)" ::: "memory");
}
__device__ __forceinline__ unsigned char* lds_ptr(LAS unsigned char* ldsl, int i);
__device__ __forceinline__ void p0_prep(unsigned char* ws, LAS unsigned char* ldsl, int gw, int ngw, int lane, int wave) {
    LAS float* scr = (LAS float*)(ldsl + wave * 8448);
#define in_(i) ((const float*)lds_ptr(ldsl, (i)))
    constexpr int I0 = 16 * 176, I1 = 8 * 32, I2 = 16 * 32, I3 = 16 * 32, I4 = 16 * 2 * 4, I5 = I4, I6 = 32 * 16 * 16, I7 = I6, I8 = 32 * 8 * 32;
    constexpr int TOT = I0 + I1 + I2 + I3 + I4 + I5 + I6 + I7 + I8;
    for (int it = gw; it < TOT; it += ngw) {
        int r = it;
        if (r < I0) { prep_item<1024, PROJ, 1, 1>(in_(8), (bf16_t*)(ws + WS_WIN), 0, 0u, scr, r, lane); continue; } r -= I0;
        if (r < I1) { prep_item<512, 1024, 0, 1>(in_(17), (bf16_t*)(ws + WS_WA), 0, 0u, scr, r, lane); continue; } r -= I1;
        if (r < I2) { prep_item<1024, 1024, 0, 1>(in_(18), (bf16_t*)(ws + WS_WL), 0, 0u, scr, r, lane); continue; } r -= I2;
        if (r < I3) { prep_item<1024, 1024, 0, 1>(in_(19), (bf16_t*)(ws + WS_WO), 0, 0u, scr, r, lane); continue; } r -= I3;
        if (r < I4) { prep_item<128, 128, 0, 1>(in_(12), (bf16_t*)(ws + WS_LW), 0, 256u * 128u, scr, r, lane, -1.4426950408889634f); continue; } r -= I4;
        if (r < I5) { prep_item<128, 128, 0, 1>(in_(14), (bf16_t*)(ws + WS_LW), 128, 256u * 128u, scr, r, lane, -1.4426950408889634f); continue; } r -= I5;
        if (r < I6) { prep_item<1024, 512, 0, 2>(in_(24), (bf16_t*)(ws + WS_W13), 0, 1024u * 1024u, scr, r, lane); continue; } r -= I6;
        if (r < I7) { prep_item<1024, 512, 0, 2>(in_(25), (bf16_t*)(ws + WS_W13), 1, 1024u * 1024u, scr, r, lane); continue; } r -= I7;
        prep_item<512, 1024, 0, 1>(in_(26), (bf16_t*)(ws + WS_W2), 0, 1024u * 512u, scr, r, lane);
    }
#undef in_
}
__device__ __forceinline__ void p0_mod(const float* c, const float* c_ctx, const float* w_mod, const float* b_mod, const float* wg, const float* we, f32x4* W4g, const float* lam, float* SPt, float* mod, f32x2* rope, LAS float* lds_f, int tid) {
    LAS float* sc = lds_f;
    LAS float* red = lds_f + 17 * 1024;
    for (int i = tid; i < 17 * 1024; i += NTHREADS) { const float v = (i < 16 * 1024) ? c[i] : c_ctx[i - 16 * 1024]; sc[i] = siluf_(v); }
    for (int idx = blockIdx.x * NTHREADS + tid; idx < 36 * 256; idx += gridDim.x * NTHREADS) { const int cc = idx >> 8, kq = idx & 255; f32x4 w;
        if (cc < 4) { const float* s = wg + (size_t)(4 * kq) * 4 + cc; w.x = s[0]; w.y = s[4]; w.z = s[8]; w.w = s[12]; }
        else { const float* s = we + (size_t)(4 * kq) * 32 + (cc - 4); w.x = s[0]; w.y = s[32]; w.z = s[64]; w.w = s[96]; }
        W4g[idx] = w; }
    if (blockIdx.x == 1) for (int i = tid; i < 2048; i += NTHREADS) { const float lm = lam[i]; SPt[i] = (-lm > 20.f) ? -lm : log1pf(expf(-lm)); }
    if (blockIdx.x == 0) for (int i = tid; i < 64 * 16; i += NTHREADS) { const int pos = i >> 4, f = i & 15; const double inv = exp(-(double)f / 16.0 * log(10000.0)); const double ang = (double)pos * inv;
        rope[i] = (f32x2){(float)cos(ang), (float)sin(ang)}; }
    __syncthreads();
    for (int cb = blockIdx.x; cb < 256; cb += gridDim.x) {
        const int ks = tid / 24, col = tid % 24;
        if (ks < 21) {
            float acc[17];
#pragma unroll
            for (int b = 0; b < 17; ++b) acc[b] = 0.f;
            for (int k = ks; k < 1024; k += 21) { const float w = w_mod[(size_t)k * 6144 + cb * 24 + col];
#pragma unroll
                for (int b = 0; b < 17; ++b) acc[b] += sc[b * 1024 + k] * w; }
#pragma unroll
            for (int b = 0; b < 17; ++b) red[(ks * 17 + b) * 24 + col] = acc[b];
        }
        __syncthreads();
        if (tid < 17 * 24) { const int b = tid / 24, cc = tid % 24; float s = b_mod[cb * 24 + cc];
            for (int q = 0; q < 21; ++q) s += red[(q * 17 + b) * 24 + cc];
            mod[b * 6144 + cb * 24 + cc] = s; }
        __syncthreads();
    }
}

__device__ __forceinline__ void p1_adanorm(const float* x, const float* ctx, const float* gain, const float* mod, bf16_t* H, int gw, int ngw, int lane) {
    f32x4 nA[4], nB[4];
#define AD_SRC(r_) ((r_) < TL ? x + (size_t)(r_) * D : ctx + (size_t)((r_) - TL) * D)
#define AD_LOAD(dst, r_) do { if ((r_) < TALL) { const float* s_ = AD_SRC(r_); _Pragma("unroll") for (int j = 0; j < 4; ++j) dst[j] = __builtin_nontemporal_load((const f32x4*)(s_ + lane * 4 + 256 * j)); } } while (0)
#define AD_ROW(src_, r_) do { const int row_ = (r_); const int mb = row_ < TL ? (row_ >> 11) : 16; const float* shift = mod + mb * 6144; const float* scale = shift + 1024; \
        f32x4 v[4]; float ss = 0.f; \
        _Pragma("unroll") for (int j = 0; j < 4; ++j) { v[j] = src_[j]; ss += v[j].x * v[j].x + v[j].y * v[j].y + v[j].z * v[j].z + v[j].w * v[j].w; } \
        AD_LOAD(src_, row_ + 2 * ngw); \
        const float rstd = rsqrtf(wave_sum_fast(ss) * (1.0f / D) + EPS); \
        _Pragma("unroll") for (int j = 0; j < 4; ++j) { const int k = lane * 4 + 256 * j; const f32x4 g = *(const f32x4*)(gain + k), sh = *(const f32x4*)(shift + k), sc = *(const f32x4*)(scale + k); \
            const f32x4 o = (v[j] * rstd * g) * (1.0f + sc) + sh; \
            u32x2 w; w.x = pk2(o.x, o.y); w.y = pk2(o.z, o.w); *(u32x2*)(H + (size_t)row_ * D + k) = w; } } while (0)
    AD_LOAD(nA, gw); AD_LOAD(nB, gw + ngw);
    for (int row = gw; row < TALL; row += 2 * ngw) { AD_ROW(nA, row); if (row + ngw < TALL) AD_ROW(nB, row + ngw); }
#undef AD_SRC
#undef AD_LOAD
#undef AD_ROW
}

__device__ __forceinline__ void p1_router_tables(const float* gain, const float* mod, const f32x4* W4g, const float* bg, const float* be, float* WT, float* biasb, int gw, int ngw, int lane) {
    for (int it = gw; it < 16 * 48; it += ngw) {
        const int b = it / 48, j = it % 48; const float* shift = mod + b * 6144 + 3072; const float* scale = shift + 1024;
        float part = 0.f;
#pragma unroll
        for (int i = 0; i < 4; ++i) { const int kq = lane + 64 * i; const f32x4 g = *(const f32x4*)(gain + 4 * kq), sc = *(const f32x4*)(scale + 4 * kq), sh = *(const f32x4*)(shift + 4 * kq);
            f32x4 w = (f32x4){0.f, 0.f, 0.f, 0.f}; if (j < 36) w = W4g[j * 256 + kq];
            *(f32x4*)(WT + (size_t)(b * 48 + j) * 1024 + 4 * kq) = g * (1.0f + sc) * w;
            part += sh.x * w.x + sh.y * w.y + sh.z * w.z + sh.w * w.w; }
        part = wave_sum_fast(part);
        if (lane == 0) biasb[b * 48 + j] = part + (j < 4 ? bg[j] : j < 36 ? be[j - 4] : 0.f);
    }
}
constexpr int RT_CHUNK_FLOATS = 48 * 132, RT_LG_OFF = 2 * RT_CHUNK_FLOATS * 4;
__device__ __forceinline__ void p8_route(const bf16_t* x1, const float* WT, const float* biasb, unsigned* ctl, int* tok, LAS unsigned char* lds, int lane, int tid, int wave) {
    LAS unsigned* hist = (LAS unsigned*)(lds + MISC_OFF + 256);
    if (tid < 32) hist[tid] = 0u;
    LAS float* Lg = (LAS float*)(lds + RT_LG_OFF + wave * 3072);
    const int i = lane & 15, kk = lane >> 4;
    for (int blk = blockIdx.x; blk < TL / 128; blk += gridDim.x) {
        const int R0 = 128 * blk + 16 * wave, b = (128 * blk) >> 11;
        const bf16_t* xr = x1 + (size_t)(R0 + i) * D + 4 * kk; const float* wtb = WT + (size_t)b * 48 * 1024;
        f32x4 a0 = (f32x4){0.f, 0.f, 0.f, 0.f}, a1 = a0, a2 = a0; float ss = 0.f;
        f32x4 stg[3];
#define RT_LOAD(c_) do { _Pragma("unroll") for (int q = 0; q < 3; ++q) { const int id = tid + NTHREADS * q, col = id >> 5, k4 = id & 31; stg[q] = *(const f32x4*)(wtb + (size_t)col * 1024 + 128 * (c_) + 4 * k4); } } while (0)
#define RT_STORE(buf_) do { _Pragma("unroll") for (int q = 0; q < 3; ++q) { const int id = tid + NTHREADS * q, col = id >> 5, k4 = id & 31; *(LAS f32x4*)((LAS float*)lds + (buf_) * RT_CHUNK_FLOATS + col * 132 + 4 * k4) = stg[q]; } } while (0)
        __syncthreads();
        RT_LOAD(0); RT_STORE(0);
        u32x2 cx[8];
#pragma unroll
        for (int u = 0; u < 8; ++u) cx[u] = *(const u32x2*)(xr + 16 * u);
        __syncthreads();
#pragma unroll 1
        for (int c = 0; c < 8; ++c) {
            if (c < 7) RT_LOAD(c + 1);
            u32x2 nx[8];
            if (c < 7) {
#pragma unroll
                for (int u = 0; u < 8; ++u) nx[u] = *(const u32x2*)(xr + 128 * (c + 1) + 16 * u); }
            const LAS float* wl = (const LAS float*)lds + (c & 1) * RT_CHUNK_FLOATS + i * 132 + 4 * kk;
#pragma unroll
            for (int u = 0; u < 8; ++u) { const f32x4 xa = (f32x4){bflo(cx[u].x), bfhi(cx[u].x), bflo(cx[u].y), bfhi(cx[u].y)}, b0 = *(const LAS f32x4*)(wl + 16 * u), b1 = *(const LAS f32x4*)(wl + 16 * 132 + 16 * u), b2 = *(const LAS f32x4*)(wl + 32 * 132 + 16 * u);
                ss += xa.x * xa.x + xa.y * xa.y + xa.z * xa.z + xa.w * xa.w;
                a0 = __builtin_amdgcn_mfma_f32_16x16x4f32(xa.x, b0.x, a0, 0, 0, 0); a1 = __builtin_amdgcn_mfma_f32_16x16x4f32(xa.x, b1.x, a1, 0, 0, 0); a2 = __builtin_amdgcn_mfma_f32_16x16x4f32(xa.x, b2.x, a2, 0, 0, 0);
                a0 = __builtin_amdgcn_mfma_f32_16x16x4f32(xa.y, b0.y, a0, 0, 0, 0); a1 = __builtin_amdgcn_mfma_f32_16x16x4f32(xa.y, b1.y, a1, 0, 0, 0); a2 = __builtin_amdgcn_mfma_f32_16x16x4f32(xa.y, b2.y, a2, 0, 0, 0);
                a0 = __builtin_amdgcn_mfma_f32_16x16x4f32(xa.z, b0.z, a0, 0, 0, 0); a1 = __builtin_amdgcn_mfma_f32_16x16x4f32(xa.z, b1.z, a1, 0, 0, 0); a2 = __builtin_amdgcn_mfma_f32_16x16x4f32(xa.z, b2.z, a2, 0, 0, 0);
                a0 = __builtin_amdgcn_mfma_f32_16x16x4f32(xa.w, b0.w, a0, 0, 0, 0); a1 = __builtin_amdgcn_mfma_f32_16x16x4f32(xa.w, b1.w, a1, 0, 0, 0); a2 = __builtin_amdgcn_mfma_f32_16x16x4f32(xa.w, b2.w, a2, 0, 0, 0); }
            if (c < 7) { RT_STORE((c + 1) & 1);
#pragma unroll
                for (int u = 0; u < 8; ++u) cx[u] = nx[u]; }
            __syncthreads();
        }
#undef RT_LOAD
#undef RT_STORE
        ss = half_sum(ss); { const auto r = __builtin_amdgcn_permlane16_swap(__float_as_uint(ss), __float_as_uint(ss), false, false); ss = __uint_as_float(r[0]) + __uint_as_float(r[1]); }
        const float rstd = rsqrtf(ss * (1.0f / D) + EPS);
#pragma unroll
        for (int rg = 0; rg < 4; ++rg) { Lg[(4 * kk + rg) * 48 + i] = a0[rg]; Lg[(4 * kk + rg) * 48 + 16 + i] = a1[rg]; Lg[(4 * kk + rg) * 48 + 32 + i] = a2[rg]; }
        if (lane < 16) {
            const int row = R0 + lane; const float* bb = biasb + b * 48; const LAS float* lr = Lg + lane * 48;
            float acc[36];
#pragma unroll
            for (int c4 = 0; c4 < 9; ++c4) { const f32x4 v = *(const LAS f32x4*)(lr + 4 * c4), bv = *(const f32x4*)(bb + 4 * c4);
                acc[4 * c4] = rstd * v.x + bv.x; acc[4 * c4 + 1] = rstd * v.y + bv.y; acc[4 * c4 + 2] = rstd * v.z + bv.z; acc[4 * c4 + 3] = rstd * v.w + bv.w; }
            int gi = 0; float gm = -1e30f;
#pragma unroll
            for (int g = 0; g < 4; ++g) if (acc[g] > gm) { gm = acc[g]; gi = g; }
            float gs = 0.f;
#pragma unroll
            for (int g = 0; g < 4; ++g) gs += expf(acc[g] - gm);
            const float p_top = 1.0f / gs;
            float le[8];
#pragma unroll
            for (int j = 0; j < 8; ++j) le[j] = gi == 0 ? acc[4 + j] : gi == 1 ? acc[12 + j] : gi == 2 ? acc[20 + j] : acc[28 + j];
            int e1 = 0; float v1 = -1e30f;
#pragma unroll
            for (int j = 0; j < 8; ++j) if (le[j] > v1) { v1 = le[j]; e1 = j; }
            int e2 = 0; float v2 = -1e30f;
#pragma unroll
            for (int j = 0; j < 8; ++j) if (j != e1 && le[j] > v2) { v2 = le[j]; e2 = j; }
            const float p2 = expf(v2 - v1), inv = 1.0f / (1.0f + p2);
            const int eid0 = gi * 8 + e1, eid1 = gi * 8 + e2;
            const int s0 = (int)__hip_atomic_fetch_add(&hist[eid0], 1u, __ATOMIC_RELAXED, __HIP_MEMORY_SCOPE_WORKGROUP), s1 = (int)__hip_atomic_fetch_add(&hist[eid1], 1u, __ATOMIC_RELAXED, __HIP_MEMORY_SCOPE_WORKGROUP);
            int* tr = tok + row * 8; tr[0] = eid0; tr[1] = eid1; ((float*)tr)[2] = p_top * inv; ((float*)tr)[3] = p_top * p2 * inv; tr[4] = s0; tr[5] = s1; ((float*)tr)[6] = rstd;
        }
    }
    __syncthreads();
    if (tid < 32) ctl[CW_BCNT + blockIdx.x * 32 + tid] = hist[tid];
}

__device__ __forceinline__ void p9_scatter(const bf16_t* x1, const float* gain, const float* mod, unsigned* ctl, int* tok, bf16_t* XB, LAS unsigned* sl, int gw, int ngw, int lane, int tid) {
    const int G = gridDim.x;
    { const int e = tid & 31, part = tid >> 5; unsigned sall = 0, sbef = 0;
      for (int bb = part; bb < G; bb += 16) { const unsigned v = ctl[CW_BCNT + bb * 32 + e]; sall += v; if (bb < (int)blockIdx.x) sbef += v; }
      sl[part * 32 + e] = sall; sl[512 + part * 32 + e] = sbef; }
    __syncthreads();
    if (tid < 64) {
        unsigned cnt = 0, bef = 0;
        if (lane < 32) for (int q = 0; q < 16; ++q) { cnt += sl[q * 32 + lane]; bef += sl[512 + q * 32 + lane]; }
        const unsigned padded = (cnt + 255u) & ~255u; unsigned incl = padded;
#pragma unroll
        for (int o = 1; o < 32; o <<= 1) { const unsigned t = __shfl_up(incl, o); if ((lane & 31) >= o) incl += t; }
        const unsigned excl = incl - padded;
        if (lane < 32) sl[1024 + lane] = excl + bef;
        if (blockIdx.x == 0) {
            const unsigned total = __shfl(incl, 31);
            if (lane == 0) ctl[CW_NBLK] = total >> 8;
            if (lane < 32) for (unsigned i = excl >> 8; i < (incl >> 8); ++i) ctl[CW_BLKE + i] = (unsigned)lane;
        }
    }
    __syncthreads();
    for (int blk = blockIdx.x; blk < TL / 128; blk += gridDim.x) {
        const int R0 = 128 * blk + 16 * (tid >> 6); const float* shift = mod + (R0 >> 11) * 6144 + 3072; const float* scale = shift + 1024;
        f32x4 G[4], S[4];
#pragma unroll
        for (int j = 0; j < 4; ++j) { const int k = lane * 4 + 256 * j; G[j] = *(const f32x4*)(gain + k) * (1.0f + *(const f32x4*)(scale + k)); S[j] = *(const f32x4*)(shift + k); }
#pragma unroll 4
        for (int rr = 0; rr < 16; ++rr) { const int row = R0 + rr; const int* tr = tok + row * 8;
            const int e0 = tr[0], e1 = tr[1]; const float rstd = ((const float*)tr)[6];
            const unsigned d0 = sl[1024 + e0] + (unsigned)tr[4], d1 = sl[1024 + e1] + (unsigned)tr[5];
            u32x2 w[4];
#pragma unroll
            for (int j = 0; j < 4; ++j) { const u32x2 xb = *(const u32x2*)(x1 + (size_t)row * D + lane * 4 + 256 * j); const f32x4 o = (f32x4){bflo(xb.x), bfhi(xb.x), bflo(xb.y), bfhi(xb.y)} * rstd * G[j] + S[j]; w[j].x = pk2(o.x, o.y); w[j].y = pk2(o.z, o.w); }
#pragma unroll
            for (int j = 0; j < 4; ++j) { *(u32x2*)(XB + (size_t)d0 * D + lane * 4 + 256 * j) = w[j]; *(u32x2*)(XB + (size_t)d1 * D + lane * 4 + 256 * j) = w[j]; }
            if (lane == 0) { tok[row * 8 + 4] = (int)d0; tok[row * 8 + 5] = (int)d1; } }
    }
}

__device__ __forceinline__ void p12_final(const bf16_t* x1, float* outp, const float* mod, const int* tok, const bf16_t* YB, const float* gfin, int gw, int ngw, int lane) {
    u32x2 nxv[4]; u32x2 nya[4], nyb[4]; float nw0 = 0.f, nw1 = 0.f; int t2d0 = 0, t2d1 = 0; float t2w0 = 0.f, t2w1 = 0.f;
    if (gw < TL) { const int d0 = tok[gw * 8 + 4], d1 = tok[gw * 8 + 5]; nw0 = ((const float*)tok)[gw * 8 + 2]; nw1 = ((const float*)tok)[gw * 8 + 3];
#pragma unroll
        for (int j = 0; j < 4; ++j) { const int k = lane * 4 + 256 * j; nxv[j] = *(const u32x2*)(x1 + (size_t)gw * D + k); nya[j] = *(const u32x2*)(YB + (size_t)d0 * D + k); nyb[j] = *(const u32x2*)(YB + (size_t)d1 * D + k); } }
    if (gw + ngw < TL) { const int r2 = gw + ngw; t2d0 = tok[r2 * 8 + 4]; t2d1 = tok[r2 * 8 + 5]; t2w0 = ((const float*)tok)[r2 * 8 + 2]; t2w1 = ((const float*)tok)[r2 * 8 + 3]; }
    for (int row = gw; row < TL; row += ngw) {
        const float* ga2 = mod + (row >> 11) * 6144 + 5120; float* dst = outp + (size_t)row * D;
        const float w0 = nw0, w1 = nw1;
        f32x4 xv[4]; u32x2 ya[4], yb[4];
#pragma unroll
        for (int j = 0; j < 4; ++j) { xv[j] = (f32x4){bflo(nxv[j].x), bfhi(nxv[j].x), bflo(nxv[j].y), bfhi(nxv[j].y)}; ya[j] = nya[j]; yb[j] = nyb[j]; }
        const int nrow = row + ngw;
        if (nrow < TL) { nw0 = t2w0; nw1 = t2w1;
#pragma unroll
            for (int j = 0; j < 4; ++j) { const int k = lane * 4 + 256 * j; nxv[j] = *(const u32x2*)(x1 + (size_t)nrow * D + k); nya[j] = *(const u32x2*)(YB + (size_t)t2d0 * D + k); nyb[j] = *(const u32x2*)(YB + (size_t)t2d1 * D + k); }
            const int r2 = nrow + ngw;
            if (r2 < TL) { t2d0 = tok[r2 * 8 + 4]; t2d1 = tok[r2 * 8 + 5]; t2w0 = ((const float*)tok)[r2 * 8 + 2]; t2w1 = ((const float*)tok)[r2 * 8 + 3]; } }
        f32x4 v[4]; float ss = 0.f;
#pragma unroll
        for (int j = 0; j < 4; ++j) { const int k = lane * 4 + 256 * j; const f32x4 g = *(const f32x4*)(ga2 + k); const u32x2 a = ya[j], bq = yb[j];
            f32x4 y; y.x = w0 * bflo(a.x) + w1 * bflo(bq.x); y.y = w0 * bfhi(a.x) + w1 * bfhi(bq.x); y.z = w0 * bflo(a.y) + w1 * bflo(bq.y); y.w = w0 * bfhi(a.y) + w1 * bfhi(bq.y);
            v[j] = xv[j] + g * y; ss += v[j].x * v[j].x + v[j].y * v[j].y + v[j].z * v[j].z + v[j].w * v[j].w; }
        const float rstd = rsqrtf(wave_sum_fast(ss) * (1.0f / D) + EPS);
#pragma unroll
        for (int j = 0; j < 4; ++j) { const int k = lane * 4 + 256 * j; const f32x4 g = *(const f32x4*)(gfin + k); *(f32x4*)(dst + k) = v[j] * rstd * g; }
    }
}

typedef float f32x16 __attribute__((ext_vector_type(16)));
typedef short v4i16_t __attribute__((ext_vector_type(4)));
using pg8::bf16x8;
constexpr int ATT_CK_OFF = 2048, ATT_CV_OFF = ATT_CK_OFF + 32768, ATT_RING_OFF = ATT_CV_OFF + 32768, ATT_SK_OFF = ATT_RING_OFF + 32768, ATT_SV_OFF = ATT_SK_OFF + 11 * 2048;
static_assert(ATT_SV_OFF + 11 * 2048 <= MISC_OFF, "attention LDS map");
__device__ __forceinline__ void p3_attn(const bf16_t* Qb, bf16_t* Ob, const bf16_t* Kb, const bf16_t* Vb, const float* rpb, const f32x2* rope, LAS unsigned char* lds, int wave, int lane) {
    constexpr float L2E = 1.4426950408889634f, SC = 0.125f * L2E;
    const int tid = wave * 64 + lane, ql = lane & 31, hl = lane >> 5, skey = tid >> 3, sch = tid & 7;
    LAS float* rpbL = (LAS float*)lds;
    const int vq = (lane & 15) >> 2, vcol = (16 * ((lane >> 4) & 1) + 4 * (lane & 3)) * 2;
    const int g = wave & 1, sside = skey >= 24 && skey < 40;
    for (int it = blockIdx.x; it < NBATCH * 8 * 2; it += gridDim.x) {
        const int rh = it & 1, h = (it >> 1) & 7, b = it >> 4;
        __syncthreads();
        if (tid < 15 * 32) { const int c = tid & 31, dr = tid >> 5; rpbL[tid] = c < 31 ? rpb[(h * 15 + dr) * 31 + c] * L2E : -1e30f; }
#pragma unroll
        for (int i = 0; i < 4; ++i) { const int key = skey + 64 * i; const size_t row = (size_t)(TL + b * CTXL + key) * 512 + h * 64 + 8 * sch;
            *(LAS u32x4*)(lds + ATT_CK_OFF + key * 128 + ((sch ^ (key & 7)) * 16)) = *(const u32x4*)(Kb + row);
            *(LAS u32x4*)(lds + ATT_CV_OFF + key * 128 + sch * 16) = *(const u32x4*)(Vb + row); }
#pragma unroll 1
        for (int pass = 0; pass < 4; ++pass) {
            const int R0 = 16 * rh + 4 * pass, r = R0 + (wave >> 1);
            const int cq = 32 * g + ql, rs = min(max(r - 4, 0), 24), cstart = min(max(cq - 8, 0), 48);
            const int kmin = min(max(R0 - 4, 0), 24), kmax = min(max(R0 - 1, 0), 24) + 7, nsteps = kmax - kmin + 1;
            const bf16_t* qp = Qb + (size_t)(b * SEQ + r * 64 + cq) * 512 + h * 64; bf16_t* op = Ob + (size_t)(b * SEQ + r * 64 + cq) * 512 + h * 64;
#define ATT_PUT(slot_, krel_, kv_, vv_) do { *(LAS u32x4*)(lds + (slot_) + skey * 128 + ((sch ^ (skey & 7)) * 16)) = (kv_); *(LAS u32x4*)(lds + (slot_) + 8192 + skey * 128 + sch * 16) = (vv_); \
                if (sside) { *(LAS u32x4*)(lds + ATT_SK_OFF + ((krel_) * 16 + skey - 24) * 128 + ((sch ^ (skey & 7)) * 16)) = (kv_); *(LAS u32x4*)(lds + ATT_SV_OFF + ((krel_) * 16 + skey - 24) * 128 + sch * 16) = (vv_); } } while (0)
            { const size_t row = (size_t)(b * SEQ + kmin * 64 + skey) * 512 + h * 64 + 8 * sch; const u32x4 kv = *(const u32x4*)(Kb + row), vv = *(const u32x4*)(Vb + row); ATT_PUT(ATT_RING_OFF, 0, kv, vv); }
            bf16x8 qplain[4], qrot[4];
#pragma unroll
            for (int d0 = 0; d0 < 4; ++d0) { float v[8], o[8], pl[8]; unpack8(*(const u32x4*)(qp + 16 * d0 + 8 * hl), v);
                const int pos = d0 < 2 ? r : cq, i0 = ((16 * d0 + 8 * hl) & 31) >> 1;
#pragma unroll
                for (int j = 0; j < 4; ++j) { const f32x2 cs = rope[pos * 16 + i0 + j]; o[2 * j] = (v[2 * j] * cs.x - v[2 * j + 1] * cs.y) * SC; o[2 * j + 1] = (v[2 * j] * cs.y + v[2 * j + 1] * cs.x) * SC; }
#pragma unroll
                for (int j = 0; j < 8; ++j) pl[j] = v[j] * SC;
                qrot[d0] = __builtin_bit_cast(bf16x8, pack8(o)); qplain[d0] = __builtin_bit_cast(bf16x8, pack8(pl)); }
            int dco[16];
#pragma unroll
            for (int i = 0; i < 16; ++i) { const int kc = 32 * g + (i & 3) + 8 * (i >> 2) + 4 * hl; const bool ok = kc >= cstart && kc < cstart + 16; dco[i] = ok ? (kc - cq + 15) * 4 : 31 * 4; }
            f32x16 o0, o1;
#pragma unroll
            for (int i = 0; i < 16; ++i) { o0[i] = 0.f; o1[i] = 0.f; }
            float m = -1e30f, l = 0.f;
#define ATT_TILE(kp_, vb_, vsk_, ve_, qf) do { \
            _Pragma("unroll") for (int d0 = 0; d0 < 4; ++d0) s = __builtin_amdgcn_mfma_f32_32x32x16_bf16(*(const LAS bf16x8*)((kp_) + (((2 * d0 + hl) ^ (ql & 7)) * 16)), qf[d0], s, 0, 0, 0); \
            float mt = fmaxf(fmaxf(s[0], s[1]), s[2]); \
            _Pragma("unroll") for (int i = 3; i < 15; i += 2) mt = fmaxf(fmaxf(mt, s[i]), s[i + 1]); \
            mt = half_max(fmaxf(mt, s[15])); \
            if (__any(mt > m)) { const float mn = fmaxf(m, mt), alpha = __builtin_amdgcn_exp2f(m - mn); m = mn; l *= alpha; \
                _Pragma("unroll") for (int i = 0; i < 16; ++i) { o0[i] *= alpha; o1[i] *= alpha; } } \
            float ps = 0.f; \
            _Pragma("unroll") for (int i = 0; i < 16; ++i) { s[i] = __builtin_amdgcn_exp2f(s[i] - m); ps += s[i]; } \
            l += ps; \
            bf16x8 pb[2]; \
            _Pragma("unroll") for (int sk = 0; sk < 2; ++sk) { u32x4 w; w.x = pk2(s[8 * sk], s[8 * sk + 1]); w.y = pk2(s[8 * sk + 2], s[8 * sk + 3]); w.z = pk2(s[8 * sk + 4], s[8 * sk + 5]); w.w = pk2(s[8 * sk + 6], s[8 * sk + 7]); \
                pb[sk] = __builtin_bit_cast(bf16x8, w); } \
            _Pragma("unroll") for (int dt = 0; dt < 2; ++dt) _Pragma("unroll") for (int sk = 0; sk < 2; ++sk) { \
                const v4i16_t lo = __builtin_amdgcn_ds_read_tr16_b64_v4i16((LAS v4i16_t*)((vb_) + sk * (vsk_) + dt * 64)); \
                const v4i16_t hi = __builtin_amdgcn_ds_read_tr16_b64_v4i16((LAS v4i16_t*)((vb_) + sk * (vsk_) + (ve_) + dt * 64)); \
                const bf16x8 va = (bf16x8){lo[0], lo[1], lo[2], lo[3], hi[0], hi[1], hi[2], hi[3]}; \
                if (dt == 0) o0 = __builtin_amdgcn_mfma_f32_32x32x16_bf16(va, pb[sk], o0, 0, 0, 0); else o1 = __builtin_amdgcn_mfma_f32_32x32x16_bf16(va, pb[sk], o1, 0, 0, 0); } } while (0)
            __syncthreads();
#pragma unroll 1
            for (int st = 0; st < nsteps; ++st) {
                const int kr = kmin + st, slot = ATT_RING_OFF + (st & 1) * 16384;
                u32x4 nk, nv; const bool more = st + 1 < nsteps;
                if (more) { const size_t row = (size_t)(b * SEQ + (kr + 1) * 64 + skey) * 512 + h * 64 + 8 * sch; nk = *(const u32x4*)(Kb + row); nv = *(const u32x4*)(Vb + row); }
                if (kr >= rs && kr < rs + 8) {
                    const LAS unsigned char* brow = (const LAS unsigned char*)(rpbL + (kr - r + 7) * 32);
                    f32x16 s;
#pragma unroll
                    for (int i = 0; i < 16; ++i) s[i] = *(const LAS float*)(brow + dco[i]);
                    const LAS unsigned char* kp = lds + slot + g * 4096 + ql * 128; const LAS unsigned char* vb = lds + slot + 8192 + g * 4096 + (4 * hl + vq) * 128 + vcol;
                    ATT_TILE(kp, vb, 2048, 1024, qrot);
                }
                if (more) { const int ns = ATT_RING_OFF + ((st + 1) & 1) * 16384; ATT_PUT(ns, st + 1, nk, nv); }
                __syncthreads();
            }
#pragma unroll 1
            for (int x = 0; x < 2; ++x) {
                const int cb = g == 0 ? 8 : 0, krel0 = rs + 4 * x - kmin;
                f32x16 s;
#pragma unroll
                for (int i = 0; i < 16; ++i) { const int kc = 24 + cb + (i & 3) + 4 * hl, dr = rs + 4 * x + (i >> 2) - r + 7; const bool ok = kc >= cstart && kc < cstart + 16;
                    s[i] = ok ? rpbL[dr * 32 + (kc - cq + 15)] : -1e30f; }
                const LAS unsigned char* kp = lds + ATT_SK_OFF + ((krel0 + (ql >> 3)) * 16 + cb + (ql & 7)) * 128;
                const LAS unsigned char* vb = lds + ATT_SV_OFF + (krel0 * 16 + cb + 4 * hl + vq) * 128 + vcol;
                ATT_TILE(kp, vb, 4096, 2048, qrot);
            }
            __syncthreads();
#pragma unroll 1
            for (int ct = 0; ct < 8; ++ct) { f32x16 s;
#pragma unroll
                for (int i = 0; i < 16; ++i) s[i] = 0.f;
                const LAS unsigned char* kp = lds + ATT_CK_OFF + ct * 4096 + ql * 128; const LAS unsigned char* vb = lds + ATT_CV_OFF + ct * 4096 + (4 * hl + vq) * 128 + vcol;
                ATT_TILE(kp, vb, 2048, 1024, qplain); }
#undef ATT_TILE
#undef ATT_PUT
            l = half_sum(l);
            const float il = 1.0f / l;
#pragma unroll
            for (int dt = 0; dt < 2; ++dt)
#pragma unroll
                for (int g4 = 0; g4 < 4; ++g4) { u32x2 w;
                    if (dt == 0) { w.x = pk2(o0[4 * g4] * il, o0[4 * g4 + 1] * il); w.y = pk2(o0[4 * g4 + 2] * il, o0[4 * g4 + 3] * il); }
                    else { w.x = pk2(o1[4 * g4] * il, o1[4 * g4 + 1] * il); w.y = pk2(o1[4 * g4 + 2] * il, o1[4 * g4 + 3] * il); }
                    *(u32x2*)(op + 32 * dt + 8 * g4 + 4 * hl) = w; }
        }
    }
}

constexpr int LRU_WLDS = 8192;
constexpr int LRU_TILES = 72;
__device__ __forceinline__ void lru_conv_frags(const bf16_t* LX, const float* conv_w, const float* conv_b, size_t rowbase, int L, int s0, int n, int lane, bf16x8 (&afr)[8], bf16_t* XC) {
    const int token = lane & 31, hl = lane >> 5, s = s0 + token;
    u32x4 xr[2][2][4];
#define LRU_LDPAIR(pp, buf) do { _Pragma("unroll") for (int q = 0; q < 2; ++q) _Pragma("unroll") for (int j = 0; j < 4; ++j) { const int sj = s + j - 2; xr[buf][q][j] = (u32x4){0u, 0u, 0u, 0u}; \
        if (sj >= 0 && sj < L) xr[buf][q][j] = *(const u32x4*)(LX + (rowbase + sj) * 1024 + n * 128 + 16 * (2 * (pp) + q) + 8 * hl); } } while (0)
    LRU_LDPAIR(0, 0);
#pragma unroll
    for (int pp = 0; pp < 4; ++pp) {
        if (pp < 3) LRU_LDPAIR(pp + 1, (pp + 1) & 1);
        __builtin_amdgcn_sched_barrier(0);
#pragma unroll
        for (int q = 0; q < 2; ++q) { const int ch0 = n * 128 + 16 * (2 * pp + q) + 8 * hl;
            float acc[8];
            { const f32x4 b0 = *(const f32x4*)(conv_b + ch0), b1 = *(const f32x4*)(conv_b + ch0 + 4); acc[0] = b0.x; acc[1] = b0.y; acc[2] = b0.z; acc[3] = b0.w; acc[4] = b1.x; acc[5] = b1.y; acc[6] = b1.z; acc[7] = b1.w; }
#pragma unroll
            for (int j = 0; j < 4; ++j) { float xv[8]; unpack8(xr[pp & 1][q][j], xv);
                const f32x4 w0 = *(const f32x4*)(conv_w + j * 1024 + ch0), w1 = *(const f32x4*)(conv_w + j * 1024 + ch0 + 4);
                acc[0] += w0.x * xv[0]; acc[1] += w0.y * xv[1]; acc[2] += w0.z * xv[2]; acc[3] += w0.w * xv[3]; acc[4] += w1.x * xv[4]; acc[5] += w1.y * xv[5]; acc[6] += w1.z * xv[6]; acc[7] += w1.w * xv[7]; }
            const u32x4 pk = pack8(acc); afr[2 * pp + q] = __builtin_bit_cast(bf16x8, pk);
            if (XC) *(u32x4*)(XC + (rowbase + s) * 1024 + ch0) = pk; }
        __builtin_amdgcn_sched_barrier(0);
    }
#undef LRU_LDPAIR
}
template <int DIR>
__device__ __forceinline__ void lru_group_dir(const f32x16& accr, const f32x16& acci, const f32x16& xv, float bav, float bxv, float sp, float hin0, int hl, float (&hloc)[16], float& At, float& Ht) {
    float aloc[16], As[4], Hs[4];
#pragma unroll
    for (int g = 0; g < 4; ++g) { float h = 0.f, A = 1.f;
#pragma unroll
        for (int ee = 0; ee < 4; ++ee) { const int e4 = DIR == 0 ? ee : 3 - ee, i = 4 * g + e4;
            const float rg = __builtin_amdgcn_rcpf(1.0f + __builtin_amdgcn_exp2f(accr[i] + bav)), ig = __builtin_amdgcn_rcpf(1.0f + __builtin_amdgcn_exp2f(acci[i] + bxv));
            const float a = __builtin_amdgcn_exp2f(rg * sp), u = __builtin_amdgcn_sqrtf(__builtin_fmaf(-a, a, 1.0f)) * (ig * xv[i]);
            h = a * h + u; A *= a; hloc[i] = h; aloc[i] = A; }
        As[g] = A; Hs[g] = h; }
    float Alo[4], Ahi[4], Hlo[4], Hhi[4];
#pragma unroll
    for (int g = 0; g < 4; ++g) { const auto ra = __builtin_amdgcn_permlane32_swap(__float_as_uint(As[g]), __float_as_uint(As[g]), false, false); Alo[g] = __uint_as_float(ra[0]); Ahi[g] = __uint_as_float(ra[1]);
        const auto rh = __builtin_amdgcn_permlane32_swap(__float_as_uint(Hs[g]), __float_as_uint(Hs[g]), false, false); Hlo[g] = __uint_as_float(rh[0]); Hhi[g] = __uint_as_float(rh[1]); }
    float hin[4]; float st = hin0, Ap = 1.f, st0 = 0.f;
#pragma unroll
    for (int gg = 0; gg < 4; ++gg) { const int g = DIR == 0 ? gg : 3 - gg;
        const float A1 = DIR == 0 ? Alo[g] : Ahi[g], H1 = DIR == 0 ? Hlo[g] : Hhi[g], A2 = DIR == 0 ? Ahi[g] : Alo[g], H2 = DIR == 0 ? Hhi[g] : Hlo[g];
        const float in1 = st; st = A1 * st + H1; st0 = A1 * st0 + H1; const float in2 = st; st = A2 * st + H2; st0 = A2 * st0 + H2; Ap *= A1 * A2;
        hin[g] = (DIR == 0) == (hl == 0) ? in1 : in2; }
    At = Ap; Ht = st0;
#pragma unroll
    for (int i = 0; i < 16; ++i) hloc[i] += aloc[i] * hin[i >> 2];
}
constexpr int LRU_CONST_OFF = 131072;
template <int MODE>
__device__ __forceinline__ void p_lru(const bf16_t* LX, const bf16_t* LW, const float* conv_w, const float* conv_b, const float* ba, const float* bx, const float* SP, f32x2* AGG, bf16_t* XC, const bf16_t* LG, bf16_t* OL,
                                      LAS unsigned char* lds, int wave, int lane, int abl = 0) {
    const int G = gridDim.x, n = blockIdx.x & 7, ql = lane & 31, hl = lane >> 5, tid = wave * 64 + lane;
    LAS float* cst = (LAS float*)(lds + LRU_CONST_OFF);
    for (int idx = tid; idx < 2 * 256 * 16; idx += NTHREADS) { const int dir = idx >> 12, j = (idx >> 4) & 255, c = idx & 15;
        *(LAS u32x4*)(lds + (dir * 256 + j) * 256 + ((c ^ (j & 15)) * 16)) = *(const u32x4*)(LW + ((size_t)(dir * 8 + n) * 256 + j) * 128 + 8 * c); }
    for (int idx = tid; idx < 2 * 3 * 128; idx += NTHREADS) { const int dir = idx / 384, w = (idx / 128) % 3, c = idx & 127; const float* src = w == 0 ? ba : w == 1 ? bx : SP; cst[idx] = src[dir * 1024 + n * 128 + c] * (w == 2 ? -8.0f * 1.4426950408889634f : -1.4426950408889634f); }
    __syncthreads();
    const int tiles_per_b = MODE == 1 ? LRU_TILES : 64, nq = 16 * tiles_per_b, stride = (G >> 3) * NWAVES;
    for (int q = (blockIdx.x >> 3) * NWAVES + wave; q < nq; q += stride) {
        const int b = q / tiles_per_b, tile = MODE == 1 ? q % tiles_per_b : 8 + q % tiles_per_b;
        const size_t rowbase = tile < 8 ? (size_t)(TL + b * CTXL) : (size_t)b * SEQ; const int L = tile < 8 ? CTXL : SEQ, s0 = tile < 8 ? tile * 32 : (tile - 8) * 32;
        bf16x8 afr[8];
        if (MODE == 1) lru_conv_frags(LX, conv_w, conv_b, rowbase, L, s0, n, lane, afr, XC);
        else {
#pragma unroll
            for (int ks = 0; ks < 8; ++ks) afr[ks] = *(const bf16x8*)(XC + (abl == 4 ? (size_t)ql * 1024 : (rowbase + s0 + ql) * 1024 + n * 128) + 16 * ks + 8 * hl); }
#pragma unroll 1
        for (int cg = 0; cg < 4; ++cg) {
            const bf16x8 ax0 = cg == 0 ? afr[0] : cg == 1 ? afr[2] : cg == 2 ? afr[4] : afr[6], ax1 = cg == 0 ? afr[1] : cg == 1 ? afr[3] : cg == 2 ? afr[5] : afr[7];
            const int cl = cg * 32 + ql;
            float hinf = 0.f, hinb = 0.f;
            if (MODE == 2) { hinf = AGG[((size_t)b * LRU_TILES + tile) * 1024 + n * 128 + cl].x; hinb = AGG[((size_t)(16 + b) * LRU_TILES + tile) * 1024 + n * 128 + cl].x; }
            unsigned short gq[16];
            f32x16 xv;
#pragma unroll
            for (int i = 0; i < 16; ++i) xv[i] = 0.f;
            { bf16x8 idf[2];
#pragma unroll
              for (int kk = 0; kk < 2; ++kk)
#pragma unroll
                  for (int j = 0; j < 8; ++j) idf[kk][j] = (16 * kk + 8 * hl + j == ql) ? (short)0x3F80 : (short)0;
              xv = __builtin_amdgcn_mfma_f32_32x32x16_bf16(ax0, idf[0], xv, 0, 0, 0); xv = __builtin_amdgcn_mfma_f32_32x32x16_bf16(ax1, idf[1], xv, 0, 0, 0); }
            float hsum[16];
#pragma unroll
            for (int dir = 0; dir < 2; ++dir) {
                const LAS unsigned char* wr = lds + (dir * 256 + cl) * 256; const LAS unsigned char* wi = wr + 128 * 256;
                f32x16 accr, acci;
#pragma unroll
                for (int i = 0; i < 16; ++i) { accr[i] = 0.f; acci[i] = 0.f; }
                if (abl != 2) { bf16x8 bw[8];
#pragma unroll
                  for (int k = 0; k < 8; ++k) bw[k] = *(const LAS bf16x8*)(wr + (((2 * k + hl) ^ (cl & 15)) * 16));
#pragma unroll
                  for (int k = 0; k < 8; ++k) accr = __builtin_amdgcn_mfma_f32_32x32x16_bf16(afr[k], bw[k], accr, 0, 0, 0);
                  __builtin_amdgcn_sched_barrier(0);
#pragma unroll
                  for (int k = 0; k < 8; ++k) bw[k] = *(const LAS bf16x8*)(wi + (((2 * k + hl) ^ (cl & 15)) * 16));
#pragma unroll
                  for (int k = 0; k < 8; ++k) acci = __builtin_amdgcn_mfma_f32_32x32x16_bf16(afr[k], bw[k], acci, 0, 0, 0); }
                __builtin_amdgcn_sched_barrier(0);
                const float bav = cst[dir * 384 + cl], bxv = cst[dir * 384 + 128 + cl], sp = cst[dir * 384 + 256 + cl];
                const float hin0 = dir == 0 ? hinf : hinb;
                if (MODE == 2 && dir == 1 && abl != 3) {
#pragma unroll
                    for (int i = 0; i < 16; ++i) gq[i] = LG[(rowbase + s0 + (i & 3) + 8 * (i >> 2) + 4 * hl) * 1024 + n * 128 + cl]; }
                float hout[16], At, Ht;
                if (abl == 1) { _Pragma("unroll") for (int i = 0; i < 16; ++i) hout[i] = accr[i] + acci[i] * xv[i] + hin0 + bav + bxv + sp; At = 1.f; Ht = 0.f; }
                else if (dir == 0) lru_group_dir<0>(accr, acci, xv, bav, bxv, sp, hin0, hl, hout, At, Ht);
                else lru_group_dir<1>(accr, acci, xv, bav, bxv, sp, hin0, hl, hout, At, Ht);
                if (MODE == 1) { if (hl == 0) AGG[((size_t)(dir * 16 + b) * LRU_TILES + tile) * 1024 + n * 128 + cl] = (f32x2){At, Ht}; }
                else {
#pragma unroll
                    for (int i = 0; i < 16; ++i) hsum[i] = dir == 0 ? hout[i] : hsum[i] + hout[i]; }
            }
            if (MODE == 2) {
                if (abl == 3) { float t_ = 0.f; _Pragma("unroll") for (int i = 0; i < 16; ++i) t_ += hsum[i]; if (t_ == 123.456f) OL[0] = 0; }
                else {
#pragma unroll
                for (int i = 0; i < 16; ++i) OL[(rowbase + s0 + (i & 3) + 8 * (i >> 2) + 4 * hl) * 1024 + n * 128 + cl] = (bf16_t)f2bf(hsum[i] * bf2f(gq[i]));
                }
            }
        }
    }
}
__device__ __forceinline__ void p_lru_carry(f32x2* AGG, int tid) {
    const int gid = blockIdx.x * NTHREADS + tid;
    if (gid >= 2 * 16 * 1024) return;
    const int dir = gid >> 14, b = (gid >> 10) & 15, ch = gid & 1023;
    f32x2* base = AGG + (size_t)(dir * 16 + b) * LRU_TILES * 1024 + ch;
    float h = 0.f;
#pragma unroll 1
    for (int s0 = 0; s0 < LRU_TILES; s0 += 24) {
        f32x2 v[24];
#pragma unroll
        for (int s = 0; s < 24; ++s) { const int st = s0 + s, tile = dir == 0 ? st : (st < 8 ? 7 - st : 79 - st); v[s] = base[(size_t)tile * 1024]; }
#pragma unroll
        for (int s = 0; s < 24; ++s) { const int st = s0 + s, tile = dir == 0 ? st : (st < 8 ? 7 - st : 79 - st); base[(size_t)tile * 1024].x = h; h = v[s].x * h + v[s].y; }
    }
}

__device__ __forceinline__ unsigned char* lds_ptr(LAS unsigned char* ldsl, int i) {
    const LAS unsigned* t = (const LAS unsigned*)(ldsl + MISC_OFF + 1024) + 2 * i;
    const unsigned lo = __builtin_amdgcn_readfirstlane(t[0]), hi = __builtin_amdgcn_readfirstlane(t[1]);
    return (unsigned char*)(__attribute__((address_space(1))) unsigned char*)(((unsigned long long)hi << 32) | lo);
}
struct MArgs { const float* in[28]; float* out; unsigned char* ws; int ph_lo, ph_hi, li, extra; };
__global__ void __launch_bounds__(NTHREADS, 2) mega(MArgs a) {
    extern __shared__ __attribute__((aligned(16))) unsigned char lds[];
    const int wave = __builtin_amdgcn_readfirstlane(threadIdx.x >> 6);
#define LANE ((int)__builtin_amdgcn_mbcnt_hi(~0u, __builtin_amdgcn_mbcnt_lo(~0u, 0u)))
#define TID (wave * 64 + LANE)
    const int G = gridDim.x, gw = blockIdx.x * NWAVES + wave, ngw = G * NWAVES;
    LAS unsigned char* ldsl = (LAS unsigned char*)lds;
    volatile LAS unsigned* MISC = (volatile LAS unsigned*)(ldsl + MISC_OFF);
    for (int u = TID; u < (LDS_BYTES - MISC_OFF) / 4; u += NTHREADS) ((LAS unsigned*)(ldsl + MISC_OFF))[u] = 0u;
    __syncthreads();
    { LAS unsigned long long* pt = (LAS unsigned long long*)(ldsl + MISC_OFF + 1024);
      const int tid = TID;
      if (tid < 28) pt[tid] = (unsigned long long)a.in[tid];
      if (tid == 28) pt[28] = (unsigned long long)(a.extra ? (float*)(a.ws + WS_XB) : a.out);
      if (tid == 29) pt[29] = (unsigned long long)a.ws; }
    XcdBarrier bar = xcd_barrier_post((unsigned*)(a.ws + WS_CTL) + CW_BAR + a.li * XCD_BAR_WORDS, MISC + 8, wave == 0 && LANE == 0);
    const int lo = a.ph_lo, hi = a.ph_hi, extra = a.extra;
    __syncthreads();
#define PTR(i) ((const float*)lds_ptr(ldsl, (i)))
#define OUTP ((float*)lds_ptr(ldsl, 28))
#define WSP(off) (lds_ptr(ldsl, 29) + (off))
#define IN(k) (lo <= (k) && (k) < hi)
#define SEAM(k) do { if (IN(k) && IN((k) + 1)) xcd_barrier(bar, wave); } while (0)
    if (IN(0)) { unsigned char* ws = WSP(0); p0_prep(ws, ldsl, gw, ngw, LANE, wave); __syncthreads();
        p0_mod(PTR(1), PTR(3), PTR(4), PTR(5), PTR(20), PTR(22), (f32x4*)(ws + WS_MOD + 600 * 1024), PTR(16), (float*)(ws + WS_MOD + 760 * 1024), (float*)(ws + WS_MOD), (f32x2*)(ws + WS_MOD + 512 * 1024), (LAS float*)ldsl, TID); }
    SEAM(0);
    if (IN(1)) { unsigned char* ws = WSP(0); p1_router_tables(PTR(7), (const float*)(ws + WS_MOD), (const f32x4*)(ws + WS_MOD + 600 * 1024), PTR(21), PTR(23), (float*)(ws + WS_RWT), (float*)(ws + WS_RWT + 3 * MiB), gw, ngw, LANE);
        p1_adanorm(PTR(0), PTR(2), PTR(6), (const float*)(ws + WS_MOD), (bf16_t*)OUTP, gw, ngw, LANE); }
    SEAM(1);
    if (IN(2)) { unsigned char* ws = WSP(0); pg8::Gemm g{(const bf16_t*)OUTP, (const bf16_t*)(ws + WS_WIN), TALL, PROJ, 1024}; ProjOrder S; S.init(G, (int)blockIdx.x);
        EpiF<EpiProj> E{{(bf16_t*)(ws + WS_K), (bf16_t*)(ws + WS_V), (bf16_t*)(ws + WS_LX), (bf16_t*)(ws + WS_Q), (bf16_t*)(ws + WS_LG), ws + WS_GA, ws + WS_GB, (const f32x2*)(ws + WS_MOD + 512 * 1024)}};
        pg8::gemm_phase<EpiF<EpiProj>, ProjOrder, true, true>(ldsl, g, S, E, wave); }
    SEAM(2);
    if (IN(3)) { unsigned char* ws = WSP(0); bf16_t* LGb = (bf16_t*)(ws + WS_LG);
        p_lru<1>((const bf16_t*)(ws + WS_LX), (const bf16_t*)(ws + WS_LW), PTR(10), PTR(11), PTR(13), PTR(15), (const float*)(ws + WS_MOD + 760 * 1024), (f32x2*)OUTP, (bf16_t*)((unsigned char*)OUTP + 24 * MiB), LGb, LGb, ldsl, wave, LANE);
        __syncthreads(); }
    if (IN(3) || extra == 2) { unsigned char* ws = WSP(0); bf16_t* Qb = (bf16_t*)(ws + WS_Q);
        p3_attn(Qb, Qb, (const bf16_t*)(ws + WS_K), (const bf16_t*)(ws + WS_V), PTR(9), (const f32x2*)(ws + WS_MOD + 512 * 1024), ldsl, wave, LANE); }
    SEAM(3);
    if (IN(4)) p_lru_carry((f32x2*)OUTP, TID);
    if (IN(4)) { unsigned char* ws = WSP(0); pg8::Gemm g{(const bf16_t*)(ws + WS_Q), (const bf16_t*)(ws + WS_WA), TL, 1024, 512}; pg8::StaticOrder S; S.init(TL, 1024, G, (int)blockIdx.x); EpiF2<EpiUpAttn> E{{ws + WS_GA, (bf16_t*)(ws + WS_Y)}};
        pg8::gemm_phase<EpiF2<EpiUpAttn>, pg8::StaticOrder, true, true>(ldsl, g, S, E, wave); }
    SEAM(4);
    if (IN(5)) { unsigned char* ws = WSP(0); bf16_t* LGb = (bf16_t*)(ws + WS_LG);
        p_lru<2>((const bf16_t*)(ws + WS_LX), (const bf16_t*)(ws + WS_LW), PTR(10), PTR(11), PTR(13), PTR(15), (const float*)(ws + WS_MOD + 760 * 1024), (f32x2*)OUTP, (bf16_t*)((unsigned char*)OUTP + 24 * MiB), LGb, LGb, ldsl, wave, LANE, extra >= 10 ? extra - 10 : 0); }
    SEAM(5);
    if (IN(6)) { unsigned char* ws = WSP(0); bf16_t* Yb = (bf16_t*)(ws + WS_Y); pg8::Gemm g{(const bf16_t*)(ws + WS_LG), (const bf16_t*)(ws + WS_WL), TL, 1024, 1024}; pg8::StaticOrder S; S.init(TL, 1024, G, (int)blockIdx.x);
        EpiF2<EpiUpLru> E{{Yb, ws + WS_GB, Yb}};
        pg8::gemm_phase<EpiF2<EpiUpLru>, pg8::StaticOrder, true, true>(ldsl, g, S, E, wave); }
    SEAM(6);
    if (IN(7)) { unsigned char* ws = WSP(0); pg8::Gemm g{(const bf16_t*)(ws + WS_Y), (const bf16_t*)(ws + WS_WO), TL, 1024, 1024}; pg8::StaticOrder S; S.init(TL, 1024, G, (int)blockIdx.x);
        EpiF2<EpiOut> E{{PTR(0), (const float*)(ws + WS_MOD), (bf16_t*)(ws + WS_X1B)}};
        pg8::gemm_phase<EpiF2<EpiOut>, pg8::StaticOrder, true, true>(ldsl, g, S, E, wave); }
    SEAM(7);
    if (IN(8)) { unsigned char* ws = WSP(0);
        p8_route((const bf16_t*)(ws + WS_X1B), (const float*)(ws + WS_RWT), (const float*)(ws + WS_RWT + 3 * MiB), (unsigned*)(ws + WS_CTL), (int*)(ws + WS_TOK), ldsl, LANE, TID, wave); }
    SEAM(8);
    if (IN(9)) { unsigned char* ws = WSP(0); p9_scatter((const bf16_t*)(ws + WS_X1B), PTR(7), (const float*)(ws + WS_MOD), (unsigned*)(ws + WS_CTL), (int*)(ws + WS_TOK), (bf16_t*)(ws + WS_XB), (LAS unsigned*)ldsl, gw, ngw, LANE, TID); }
    SEAM(9);
    if (IN(10)) { unsigned char* ws = WSP(0); pg8::Gemm g{(const bf16_t*)(ws + WS_XB), (const bf16_t*)(ws + WS_W13), MOE_ROWS, 1024, 1024}; MoeOrder S; S.init((const unsigned*)(ws + WS_CTL), G, (int)blockIdx.x, (size_t)1024 * 1024 * 2);
        EpiF<EpiMoe1> E{{(bf16_t*)OUTP}};
        pg8::gemm_phase<EpiF<EpiMoe1>, MoeOrder, true, true>(ldsl, g, S, E, wave); }
    SEAM(10);
    if (IN(11)) { unsigned char* ws = WSP(0); pg8::Gemm g{(const bf16_t*)OUTP, (const bf16_t*)(ws + WS_W2), MOE_ROWS, 1024, 512}; MoeOrder S; S.init((const unsigned*)(ws + WS_CTL), G, (int)blockIdx.x, (size_t)1024 * 512 * 2);
        EpiF<EpiMoe2> E{{(bf16_t*)(ws + WS_YB)}};
        pg8::gemm_phase<EpiF<EpiMoe2>, MoeOrder, true, true>(ldsl, g, S, E, wave); }
    SEAM(11);
    if (IN(12)) { unsigned char* ws = WSP(0); p12_final((const bf16_t*)(ws + WS_X1B), OUTP, (const float*)(ws + WS_MOD), (const int*)(ws + WS_TOK), (const bf16_t*)(ws + WS_YB), PTR(27), gw, ngw, LANE); }
#undef PTR
#undef OUTP
#undef WSP
#undef LANE
#undef TID
#undef IN
#undef SEAM
}

extern "C" void kernel_launch(void* const* d_in, const int* in_sizes, int n_in, void* d_out, int out_size, void* d_ws, size_t ws_size, hipStream_t stream) {
    static int grid = 0;
    if (grid == 0) {
        if (n_in != 28 || out_size != TL * D || ws_size < WS_END) { fprintf(stderr, "kernel_launch: unexpected problem (n_in %d, out %d, ws %zu < %zu)\n", n_in, out_size, ws_size, (size_t)WS_END); grid = -1; return; }
        int dev = 0, cus = 0, per_cu = 0;
        if (hipGetDevice(&dev) != hipSuccess || hipDeviceGetAttribute(&cus, hipDeviceAttributeMultiprocessorCount, dev) != hipSuccess) { grid = -1; return; }
        if (hipFuncSetAttribute((const void*)mega, hipFuncAttributeMaxDynamicSharedMemorySize, LDS_BYTES) != hipSuccess) { fprintf(stderr, "kernel_launch: hipFuncSetAttribute failed\n"); grid = -1; return; }
        if (hipOccupancyMaxActiveBlocksPerMultiprocessor(&per_cu, (const void*)mega, NTHREADS, LDS_BYTES) != hipSuccess || per_cu < 1) { fprintf(stderr, "kernel_launch: occupancy query says %d blocks per CU\n", per_cu); grid = -1; return; }
        (void)hipGetLastError();
        grid = cus;
    }
    if (grid < 0) return;
    const float* const* in = (const float* const*)d_in;
    unsigned char* ws = (unsigned char*)d_ws; float* out = (float*)d_out;
    (void)hipMemsetAsync(ws + WS_CTL, 0, CTL_ZERO_BYTES, stream);
    MArgs a{};
    for (int i = 0; i < 28; ++i) a.in[i] = in[i];
    a.out = out; a.ws = ws;
    auto launch = [&](int lo, int hi, int li, int extra) {
        a.ph_lo = lo; a.ph_hi = hi; a.li = li; a.extra = extra; void* args[] = {&a};
        const hipError_t e = hipLaunchCooperativeKernel((const void*)mega, dim3(grid), dim3(NTHREADS), args, LDS_BYTES, stream);
        if (e != hipSuccess) fprintf(stderr, "kernel_launch: cooperative launch failed: %s (grid %d)\n", hipGetErrorString(e), grid);
    };
    launch(0, 13, 0, 0);
    EXTRA_LAUNCHES
}
```

```cpp
#include <hip/hip_runtime.h>
#include <cstdio>
#include <cstdint>

typedef float f32x2 __attribute__((ext_vector_type(2)));
typedef unsigned u32x2 __attribute__((ext_vector_type(2)));
#define EXTRA_LAUNCHES
namespace pg8 {
#define PG8_LAS __attribute__((address_space(3)))
typedef unsigned short bf16_t;
typedef short bf16x8 __attribute__((ext_vector_type(8)));
typedef float f32x4 __attribute__((ext_vector_type(4)));
typedef unsigned u32x4 __attribute__((ext_vector_type(4)));
constexpr int BM = 256, BK = 64, HALF = 128, HTB = HALF * BK * 2  , STAGE_BYTES = 8 * HTB, NXCD = 8, WGM = 8;

__host__ __device__ __forceinline__ int lds_byte(int r, int c) { const int st = (r >> 4) * 2 + (c >> 5), rr = r & 15, cc = c & 31, ob = rr * 64 + cc * 2; return st * 1024 + (ob ^ (((ob >> 9) & 1) << 5)); }
__host__ __device__ __forceinline__ void stage_rc(int b, int& R, int& C) { const int st = b / 1024, sb = b % 1024, swz = sb ^ (((sb >> 9) & 1) << 5); R = (st >> 1) * 16 + swz / 64; C = (st & 1) * 32 + (swz % 64) / 2; }
__host__ __device__ __forceinline__ int perm32(int rho) { const int n = rho >> 4, i = rho & 15; return 8 * (i >> 2) + 4 * n + (i & 3); }

struct Unit { int pm, pn; size_t bofs; };
struct Gemm { const bf16_t* A; const bf16_t* Bt; int M, N, K; };

struct StaticOrder {
    int nM, nN, nwg, G, c;
    __host__ __device__ __forceinline__ void init(int M, int N, int G_, int c_) { nM = M / BM; nN = N / BM; nwg = nM * nN; G = G_; c = c_; }
    __host__ __device__ __forceinline__ bool next(int i, Unit& u) const {
        const long L = (long)i * G + c; if (L >= nwg) return false;
        int wgid = (int)L; { const int q = nwg / NXCD, r = nwg % NXCD, xcd = wgid % NXCD, off = wgid / NXCD; wgid = (xcd < r ? xcd * (q + 1) : r * (q + 1) + (xcd - r) * q) + off; }
        const int nig = WGM * nN, gid = wgid / nig, fm = gid * WGM, gsz = (nM - fm) < WGM ? (nM - fm) : WGM;
        u.pm = fm + ((wgid % nig) % gsz); u.pn = (wgid % nig) / gsz; u.bofs = 0; return true;
    }
    __device__ __forceinline__ void a_ready(const Unit&) const {}
    __device__ __forceinline__ void done(const Unit&) const {}
};


template <class Epi, class Sched, bool ALIGN_EPI = false, bool SP2 = false>
__device__ __forceinline__ void gemm_phase(PG8_LAS unsigned char* lds, const Gemm g, const Sched& S, const Epi& E, int wid) {
    const int lane = (int)__builtin_amdgcn_mbcnt_hi(~0u, __builtin_amdgcn_mbcnt_lo(~0u, 0u)), tid = wid * 64 + lane, wr = wid >> 2, wc = wid & 3, fr = lane & 15, fq = lane >> 4;
    const int K = g.K, nt = K / BK;
    unsigned voffA[2], voffB[2];
#pragma unroll
    for (int i = 0; i < 2; ++i) { int R, C; stage_rc(tid * 16 + i * 8192, R, C); const int Rb = Epi::PERM ? ((R & ~31) + perm32(R & 31)) : R;
        voffA[i] = (unsigned)(R * K + C) * 2u; voffB[i] = (unsigned)(Rb * K + C) * 2u; }
    const size_t kstep = (size_t)(BK * 2);
    const size_t hstep = (size_t)HALF * K * 2;
    const size_t tstep = 2 * hstep;
    const unsigned ldsw = (unsigned)wid * 1024u;
    const int aoff = lds_byte(wr * 64 + fr, fq * 8), boff = lds_byte(wc * 32 + fr, fq * 8);
#define PG8_SA(b, h) (((b) * 2 + (h)) * HTB)
#define PG8_SB(b, h) ((4 + (b) * 2 + (h)) * HTB)
#define PG8_STAGE(bufoff, gbase, voff) do { _Pragma("unroll") for (int _i = 0; _i < 2; ++_i) \
        __builtin_amdgcn_global_load_lds((const unsigned*)((const char*)(gbase) + (voff)[_i]), (PG8_LAS unsigned*)(lds + (bufoff) + ldsw + _i * 8192), 16, 0, 0); } while (0)
#define PG8_LDA(dst, b, h) do { _Pragma("unroll") for (int m = 0; m < 4; ++m) _Pragma("unroll") for (int k = 0; k < 2; ++k) dst[m][k] = *(const PG8_LAS bf16x8*)(lds + PG8_SA(b, h) + aoff + m * 2048 + k * 1024); } while (0)
#define PG8_LDB(dst, b, h) do { _Pragma("unroll") for (int n = 0; n < 2; ++n) _Pragma("unroll") for (int k = 0; k < 2; ++k) dst[n][k] = *(const PG8_LAS bf16x8*)(lds + PG8_SB(b, h) + boff + n * 2048 + k * 1024); } while (0)
#define PG8_MMA(ai, bj, At, Bt) do { __builtin_amdgcn_s_setprio(1); _Pragma("unroll") for (int m = 0; m < 4; ++m) _Pragma("unroll") for (int n = 0; n < 2; ++n) _Pragma("unroll") for (int k = 0; k < 2; ++k) \
        acc[ai][bj][m][n] = __builtin_amdgcn_mfma_f32_16x16x32_bf16(Bt[n][k], At[m][k], acc[ai][bj][m][n], 0, 0, 0); __builtin_amdgcn_s_setprio(0); } while (0)
#define PG8_WAIT_V(n) asm volatile("s_waitcnt vmcnt(" #n ")" ::: "memory")
#define PG8_WAIT_L(n) asm volatile("s_waitcnt lgkmcnt(" #n ")" ::: "memory")
#define PG8_BAR __builtin_amdgcn_s_barrier()
#define PG8_SCHED __builtin_amdgcn_sched_barrier(0)
    Unit cur, nxt; int ui = 0;
    if (!S.next(0, cur)) return;
    f32x4 acc[2][2][4][2];
#pragma unroll
    for (int a = 0; a < 2; ++a)
#pragma unroll
        for (int b = 0; b < 2; ++b)
#pragma unroll
            for (int m = 0; m < 4; ++m)
#pragma unroll
                for (int n = 0; n < 2; ++n) acc[a][b][m][n] = (f32x4){0.f, 0.f, 0.f, 0.f};
    bf16x8 At[4][2], B0[2][2], B1[2][2];
    const char* cA = (const char*)g.A + (size_t)cur.pm * tstep; const char* cB = (const char*)g.Bt + (size_t)cur.pn * tstep + cur.bofs;
    S.a_ready(cur);
    if constexpr (SP2) {
        PG8_STAGE(PG8_SB(0, 0), cB, voffB); PG8_STAGE(PG8_SB(0, 1), cB + hstep, voffB); PG8_STAGE(PG8_SA(0, 0), cA, voffA); PG8_STAGE(PG8_SA(0, 1), cA + hstep, voffA);
        if (wr == 1) PG8_BAR;
        PG8_WAIT_V(2); PG8_BAR;
        PG8_STAGE(PG8_SB(1, 0), cB + kstep, voffB); PG8_STAGE(PG8_SA(1, 0), cA + kstep, voffA); PG8_STAGE(PG8_SB(1, 1), cB + hstep + kstep, voffB);
        PG8_WAIT_V(6); PG8_BAR;
    } else {
        PG8_STAGE(PG8_SB(0, 0), cB, voffB); PG8_STAGE(PG8_SA(0, 0), cA, voffA); PG8_STAGE(PG8_SB(0, 1), cB + hstep, voffB); PG8_STAGE(PG8_SA(0, 1), cA + hstep, voffA);
        if (wr == 1) PG8_BAR;
        PG8_WAIT_V(4); PG8_BAR;
        PG8_STAGE(PG8_SB(1, 0), cB + kstep, voffB); PG8_STAGE(PG8_SA(1, 0), cA + kstep, voffA); PG8_STAGE(PG8_SB(1, 1), cB + hstep + kstep, voffB);
        PG8_WAIT_V(6); PG8_BAR;
    }
    for (;;) {
        const bool has_next = S.next(ui + 1, nxt);
        const char* nA = has_next ? (const char*)g.A + (size_t)nxt.pm * tstep : cA; const char* nB = has_next ? (const char*)g.Bt + (size_t)nxt.pn * tstep + nxt.bofs : cB;
        for (int t = 0; t < nt; t += 2) {
            const bool last = (t == nt - 2);
            const char* a1 = cA + (size_t)(t + 1) * kstep;
            const char* a2 = last ? nA : cA + (size_t)(t + 2) * kstep; const char* b2 = last ? nB : cB + (size_t)(t + 2) * kstep;
            const char* a3 = a2 + kstep; const char* b3 = b2 + kstep;
            if (last && has_next) S.a_ready(nxt);
            if constexpr (SP2) {
            PG8_LDB(B0, 0, 0); PG8_LDB(B1, 0, 1); PG8_SCHED; PG8_LDA(At, 0, 0); PG8_STAGE(PG8_SA(1, 1), a1 + hstep, voffA);
            PG8_WAIT_V(8); PG8_WAIT_L(0); PG8_BAR; PG8_MMA(0, 0, At, B0); PG8_MMA(0, 1, At, B1); PG8_BAR; PG8_SCHED;
            PG8_LDA(At, 0, 1); PG8_STAGE(PG8_SB(0, 0), b2, voffB); PG8_STAGE(PG8_SB(0, 1), b2 + hstep, voffB); PG8_STAGE(PG8_SA(0, 0), a2, voffA);
            PG8_WAIT_V(8); PG8_WAIT_L(0); PG8_BAR; PG8_MMA(1, 0, At, B0); PG8_MMA(1, 1, At, B1); PG8_BAR; PG8_SCHED;
            PG8_LDB(B0, 1, 0); PG8_LDB(B1, 1, 1); PG8_SCHED; PG8_LDA(At, 1, 0); PG8_STAGE(PG8_SA(0, 1), a2 + hstep, voffA);
            PG8_WAIT_V(8); PG8_WAIT_L(0); PG8_BAR; PG8_MMA(0, 0, At, B0); PG8_MMA(0, 1, At, B1); PG8_BAR; PG8_SCHED;
            PG8_LDA(At, 1, 1); PG8_STAGE(PG8_SB(1, 0), b3, voffB); PG8_STAGE(PG8_SB(1, 1), b3 + hstep, voffB); PG8_STAGE(PG8_SA(1, 0), a3, voffA);
            PG8_WAIT_V(8); PG8_WAIT_L(0); PG8_BAR; PG8_MMA(1, 0, At, B0); PG8_MMA(1, 1, At, B1); PG8_BAR; PG8_SCHED;
            } else {
            PG8_LDB(B0, 0, 0); PG8_SCHED; PG8_LDA(At, 0, 0); PG8_STAGE(PG8_SA(1, 1), a1 + hstep, voffA);
            PG8_WAIT_L(8); PG8_BAR; PG8_WAIT_L(0); PG8_MMA(0, 0, At, B0); PG8_BAR; PG8_SCHED;
            PG8_LDB(B1, 0, 1); PG8_STAGE(PG8_SB(0, 0), b2, voffB);
            PG8_BAR; PG8_WAIT_L(0); PG8_MMA(0, 1, At, B1); PG8_BAR;
            PG8_LDA(At, 0, 1); PG8_STAGE(PG8_SA(0, 0), a2, voffA);
            PG8_BAR; PG8_WAIT_L(0); PG8_MMA(1, 0, At, B0); PG8_BAR; PG8_SCHED;
            PG8_STAGE(PG8_SB(0, 1), b2 + hstep, voffB);
            PG8_WAIT_V(6); PG8_BAR; PG8_MMA(1, 1, At, B1); PG8_BAR;
            PG8_LDB(B0, 1, 0); PG8_SCHED; PG8_LDA(At, 1, 0); PG8_STAGE(PG8_SA(0, 1), a2 + hstep, voffA);
            PG8_WAIT_L(8); PG8_BAR; PG8_WAIT_L(0); PG8_MMA(0, 0, At, B0); PG8_BAR; PG8_SCHED;
            PG8_LDB(B1, 1, 1); PG8_STAGE(PG8_SB(1, 0), b3, voffB);
            PG8_BAR; PG8_WAIT_L(0); PG8_MMA(0, 1, At, B1); PG8_BAR;
            PG8_LDA(At, 1, 1); PG8_STAGE(PG8_SA(1, 0), a3, voffA);
            PG8_BAR; PG8_WAIT_L(0); PG8_MMA(1, 0, At, B0); PG8_BAR; PG8_SCHED;
            PG8_STAGE(PG8_SB(1, 1), b3 + hstep, voffB);
            PG8_WAIT_V(6); PG8_BAR; PG8_MMA(1, 1, At, B1); PG8_BAR;
            }
        }
        if constexpr (ALIGN_EPI) { if (wr == 0) PG8_BAR; }
        if constexpr (!Epi::AFTER_DRAIN) { E(acc, cur, wr, wc, fr, fq); S.done(cur); }
        if (!has_next) break;
#pragma unroll
        for (int a = 0; a < 2; ++a)
#pragma unroll
            for (int b = 0; b < 2; ++b)
#pragma unroll
                for (int m = 0; m < 4; ++m)
#pragma unroll
                    for (int n = 0; n < 2; ++n) acc[a][b][m][n] = (f32x4){0.f, 0.f, 0.f, 0.f};
        cur = nxt; cA = nA; cB = nB; ++ui;
        if constexpr (ALIGN_EPI) { if (wr == 1) PG8_BAR; }
    }
    PG8_WAIT_V(0);
    if constexpr (!ALIGN_EPI) { if (wr == 0) PG8_BAR; }
    PG8_BAR;
    if constexpr (Epi::AFTER_DRAIN) { E.fused(acc, cur, wr, wc, fr, fq, lds, wid, lane); S.done(cur); }
#undef PG8_SA
#undef PG8_SB
#undef PG8_STAGE
#undef PG8_LDA
#undef PG8_LDB
#undef PG8_MMA
#undef PG8_WAIT_V
#undef PG8_WAIT_L
#undef PG8_BAR
#undef PG8_SCHED
}
}
using pg8::bf16_t; using pg8::f32x4; using pg8::u32x4;
#define LAS __attribute__((address_space(3)))

constexpr int D = 1024, NBATCH = 16, SEQ = 2048, CTXL = 256;
constexpr int TL = NBATCH * SEQ;
constexpr int TC = NBATCH * CTXL;
constexpr int TALL = TL + TC;
constexpr int PROJ = 5632;
constexpr int NEXP = 32, DEXP = 512;
constexpr int MOE_ROWS = 288 * 256;
constexpr float EPS = 1e-6f;
constexpr int NWAVES = 8, NTHREADS = 512;

constexpr size_t MiB = 1u << 20;
constexpr size_t WS_CTL = 0;
constexpr size_t CTL_ZERO_BYTES = 256 * 1024;
constexpr size_t WS_MOD = 1 * MiB;
constexpr size_t WS_TOK = 2 * MiB;
constexpr size_t WS_RWT = 3 * MiB;
constexpr size_t WS_WIN = 13 * MiB;
constexpr size_t WS_WA = 24 * MiB;
constexpr size_t WS_WL = 25 * MiB;
constexpr size_t WS_WO = 27 * MiB;
constexpr size_t WS_LW = 29 * MiB;
constexpr size_t WS_W13 = 30 * MiB;
constexpr size_t WS_W2 = 94 * MiB;
constexpr size_t WS_K = 126 * MiB;
constexpr size_t WS_V = 162 * MiB;
constexpr size_t WS_LX = 198 * MiB;
constexpr size_t WS_XB = WS_K;
constexpr size_t WS_Q = 270 * MiB;
constexpr size_t WS_LG = 302 * MiB;
constexpr size_t WS_H2 = WS_Q;
constexpr size_t WS_X1B = WS_LG;
constexpr size_t WS_GA = 366 * MiB;
constexpr size_t WS_GB = 398 * MiB;
constexpr size_t WS_Y = 430 * MiB;
constexpr size_t WS_YB = WS_GA;
constexpr size_t WS_END = 510 * MiB;
constexpr int CW_COUNT = 0, CW_CURSOR = 64, CW_NBLK = 128, CW_BLKE = 192;
constexpr int CW_BCNT = 16384;
constexpr int CW_BAR = 1024;

constexpr int RING_BYTES = 131072;
constexpr int MISC_OFF = 147456;
constexpr int LDS_BYTES = 163840;

__device__ __forceinline__ unsigned f2bf(float f) { unsigned u = __float_as_uint(f); return (u + 0x7fffu + ((u >> 16) & 1u)) >> 16; }
__device__ __forceinline__ float bf2f(unsigned h) { return __uint_as_float(h << 16); }
typedef __bf16 bf16x2_t __attribute__((ext_vector_type(2)));
__device__ __forceinline__ unsigned pk2(float lo, float hi) { const f32x2 v = {lo, hi}; const bf16x2_t b = __builtin_convertvector(v, bf16x2_t); return __builtin_bit_cast(unsigned, b); }
__device__ __forceinline__ float bflo(unsigned w) { return __uint_as_float(w << 16); }
__device__ __forceinline__ float bfhi(unsigned w) { return __uint_as_float(w & 0xffff0000u); }
__device__ __forceinline__ void unpack8(u32x4 w, float (&v)[8]) { v[0] = bflo(w.x); v[1] = bfhi(w.x); v[2] = bflo(w.y); v[3] = bfhi(w.y); v[4] = bflo(w.z); v[5] = bfhi(w.z); v[6] = bflo(w.w); v[7] = bfhi(w.w); }
__device__ __forceinline__ u32x4 pack8(const float (&v)[8]) { u32x4 w; w.x = pk2(v[0], v[1]); w.y = pk2(v[2], v[3]); w.z = pk2(v[4], v[5]); w.w = pk2(v[6], v[7]); return w; }
__device__ __forceinline__ unsigned q8(float v) { return (unsigned)(v * 255.0f + 0.5f); }
__device__ __forceinline__ u32x2 packq8(const float (&v)[8]) { u32x2 w; w.x = q8(v[0]) | (q8(v[1]) << 8) | (q8(v[2]) << 16) | (q8(v[3]) << 24); w.y = q8(v[4]) | (q8(v[5]) << 8) | (q8(v[6]) << 16) | (q8(v[7]) << 24); return w; }
__device__ __forceinline__ void unpackq8(u32x2 w, float (&v)[8]) { const float s = 1.0f / 255.0f;
    v[0] = (float)(w.x & 255u) * s; v[1] = (float)((w.x >> 8) & 255u) * s; v[2] = (float)((w.x >> 16) & 255u) * s; v[3] = (float)(w.x >> 24) * s;
    v[4] = (float)(w.y & 255u) * s; v[5] = (float)((w.y >> 8) & 255u) * s; v[6] = (float)((w.y >> 16) & 255u) * s; v[7] = (float)(w.y >> 24) * s; }
__device__ __forceinline__ float fast_exp(float x) { return __builtin_amdgcn_exp2f(x * 1.4426950408889634f); }
__device__ __forceinline__ float sigmoid_fast(float x) { return __builtin_amdgcn_rcpf(1.0f + fast_exp(-x)); }
__device__ __forceinline__ float silu_fast(float x) { return x * sigmoid_fast(x); }
__device__ __forceinline__ float gelu_tanh_fast(float x) { const float u2 = 1.5957691216057308f * (x + 0.044715f * x * x * x); return x * sigmoid_fast(u2); }
__device__ __forceinline__ float sigmoidf_(float x) { return 1.0f / (1.0f + expf(-x)); }
__device__ __forceinline__ float siluf_(float x) { return x / (1.0f + expf(-x)); }
__device__ __forceinline__ float wave_sum(float v) {
#pragma unroll
    for (int o = 1; o < 64; o <<= 1) v += __shfl_xor(v, o);
    return v;
}

template <int CTRL> __device__ __forceinline__ float dpp_f(float v) { return __int_as_float(__builtin_amdgcn_update_dpp(0, __float_as_int(v), CTRL, 0xF, 0xF, true)); }
__device__ __forceinline__ float row16_sum(float v) { v += dpp_f<0xB1>(v); v += dpp_f<0x4E>(v); v += dpp_f<0x141>(v); v += dpp_f<0x140>(v); return v; }
__device__ __forceinline__ float comb32(float a, float b) { const auto r = __builtin_amdgcn_permlane32_swap(__float_as_uint(a), __float_as_uint(b), false, false); return __uint_as_float(r[0]) + __uint_as_float(r[1]); }
__device__ __forceinline__ float comb16(float a, float b) { const auto r = __builtin_amdgcn_permlane16_swap(__float_as_uint(a), __float_as_uint(b), false, false); return __uint_as_float(r[0]) + __uint_as_float(r[1]); }
__device__ __forceinline__ float lane_f(float v, int l) { return __int_as_float(__builtin_amdgcn_readlane(__float_as_int(v), l)); }
__device__ __forceinline__ float wave_sum_fast(float v) { v = row16_sum(v); return (lane_f(v, 0) + lane_f(v, 16)) + (lane_f(v, 32) + lane_f(v, 48)); }
__device__ __forceinline__ float half_max(float v) { const auto r = __builtin_amdgcn_permlane32_swap(__float_as_uint(v), __float_as_uint(v), false, false); return fmaxf(__uint_as_float(r[0]), __uint_as_float(r[1])); }
__device__ __forceinline__ float half_sum(float v) { const auto r = __builtin_amdgcn_permlane32_swap(__float_as_uint(v), __float_as_uint(v), false, false); return __uint_as_float(r[0]) + __uint_as_float(r[1]); }

struct EpiProj {
    bf16_t *Kb, *Vb, *LXb, *Qb, *LGb; unsigned char *GAq, *GBq; const f32x2* rope;
    __device__ __forceinline__ void operator()(int row, int col, const float (&v)[8]) const {
        float o[8];
        if (col < 512) {
            if (row < TL) { const int t = row & 2047, p = col & 63, pos = (p < 32) ? (t >> 6) : (t & 63), i0 = (p & 31) >> 1;
#pragma unroll
                for (int j = 0; j < 4; ++j) { const f32x2 cs = rope[pos * 16 + i0 + j]; o[2 * j] = v[2 * j] * cs.x - v[2 * j + 1] * cs.y; o[2 * j + 1] = v[2 * j] * cs.y + v[2 * j + 1] * cs.x; }
            } else {
#pragma unroll
                for (int j = 0; j < 8; ++j) o[j] = v[j]; }
            *(u32x4*)(Kb + (size_t)row * 512 + col) = pack8(o);
        } else if (col < 1024) { *(u32x4*)(Vb + (size_t)row * 512 + (col - 512)) = pack8(v);
        } else if (col < 2048) { *(u32x4*)(LXb + (size_t)row * 1024 + (col - 1024)) = pack8(v);
        } else if (col < 2560) { *(u32x4*)(Qb + (size_t)row * 512 + (col - 2048)) = pack8(v);
        } else if (col < 3584) {
#pragma unroll
            for (int j = 0; j < 8; ++j) o[j] = gelu_tanh_fast(v[j]);
            *(u32x4*)(LGb + (size_t)row * 1024 + (col - 2560)) = pack8(o);
        } else {
#pragma unroll
            for (int j = 0; j < 8; ++j) o[j] = sigmoid_fast(v[j]);
            unsigned char* dst = (col < 4608) ? GAq + (size_t)row * 1024 + (col - 3584) : GBq + (size_t)row * 1024 + (col - 4608);
            *(u32x2*)dst = packq8(o);
        }
    }
};
struct EpiUpAttn {
    const unsigned char* GA; bf16_t* OUT;
    struct P { u32x2 g; };
    __device__ __forceinline__ void load(int row, int col, P& p) const { p.g = *(const u32x2*)(GA + (size_t)row * 1024 + col); }
    __device__ __forceinline__ void apply(int row, int col, const float (&v)[8], const P& p) const {
        float g[8], o[8]; unpackq8(p.g, g);
#pragma unroll
        for (int j = 0; j < 8; ++j) o[j] = g[j] * v[j];
        *(u32x4*)(OUT + (size_t)row * 1024 + col) = pack8(o);
    }
};
struct EpiUpLru {
    const bf16_t* Y; const unsigned char* GB; bf16_t* OUT;
    struct P { u32x2 g; u32x4 y; };
    __device__ __forceinline__ void load(int row, int col, P& p) const { p.g = *(const u32x2*)(GB + (size_t)row * 1024 + col); p.y = *(const u32x4*)(Y + (size_t)row * 1024 + col); }
    __device__ __forceinline__ void apply(int row, int col, const float (&v)[8], const P& p) const {
        float g[8], y[8], o[8]; unpackq8(p.g, g); unpack8(p.y, y);
#pragma unroll
        for (int j = 0; j < 8; ++j) o[j] = y[j] + g[j] * v[j];
        *(u32x4*)(OUT + (size_t)row * 1024 + col) = pack8(o);
    }
};
struct EpiOut {
    const float* x; const float* mod; bf16_t* x1;
    struct P { f32x4 x0, x1v, g0, g1; };
    __device__ __forceinline__ void load(int row, int col, P& p) const { const float* ga1 = mod + (row >> 11) * 6144 + 2048 + col; const float* xr = x + (size_t)row * D + col;
        p.x0 = *(const f32x4*)xr; p.x1v = *(const f32x4*)(xr + 4); p.g0 = *(const f32x4*)ga1; p.g1 = *(const f32x4*)(ga1 + 4); }
    __device__ __forceinline__ void apply(int row, int col, const float (&v)[8], const P& p) const {
        const float o[8] = {p.x0.x + p.g0.x * v[0], p.x0.y + p.g0.y * v[1], p.x0.z + p.g0.z * v[2], p.x0.w + p.g0.w * v[3], p.x1v.x + p.g1.x * v[4], p.x1v.y + p.g1.y * v[5], p.x1v.z + p.g1.z * v[6], p.x1v.w + p.g1.w * v[7]};
        *(u32x4*)(x1 + (size_t)row * D + col) = pack8(o);
    }
};
struct EpiMoe1 {
    bf16_t* HM;
    __device__ __forceinline__ void operator()(int row, int col, const float (&v)[8]) const {
        u32x2 w; w.x = pk2(silu_fast(v[0]) * v[1], silu_fast(v[2]) * v[3]); w.y = pk2(silu_fast(v[4]) * v[5], silu_fast(v[6]) * v[7]);
        *(u32x2*)(HM + (size_t)row * DEXP + (col >> 1)) = w;
    }
};
struct EpiMoe2 {
    bf16_t* YB;
    __device__ __forceinline__ void operator()(int row, int col, const float (&v)[8]) const { *(u32x4*)(YB + (size_t)row * D + col) = pack8(v); }
};
template <class F> struct EpiF {
    static constexpr bool PERM = true, AFTER_DRAIN = false; F f;
    __device__ __forceinline__ void operator()(const f32x4 (&acc)[2][2][4][2], const pg8::Unit& u, int wr, int wc, int fr, int fq) const {
#pragma unroll
        for (int ai = 0; ai < 2; ++ai)
#pragma unroll
            for (int m = 0; m < 4; ++m) { const int row = u.pm * 256 + ai * 128 + wr * 64 + m * 16 + fr;
#pragma unroll
                for (int bj = 0; bj < 2; ++bj) { const int col = u.pn * 256 + bj * 128 + wc * 32 + 8 * fq; const f32x4 a = acc[ai][bj][m][0], b = acc[ai][bj][m][1];
                    const float v[8] = {a[0], a[1], a[2], a[3], b[0], b[1], b[2], b[3]}; f(row, col, v); } }
    }
};
template <class F> struct EpiF2 {
    static constexpr bool PERM = true, AFTER_DRAIN = false; F f;
    __device__ __forceinline__ void operator()(const f32x4 (&acc)[2][2][4][2], const pg8::Unit& u, int wr, int wc, int fr, int fq) const {
#pragma unroll
        for (int ai = 0; ai < 2; ++ai)
#pragma unroll
            for (int mp = 0; mp < 2; ++mp) {
                typename F::P pre[2][2];
#pragma unroll
                for (int mm = 0; mm < 2; ++mm)
#pragma unroll
                    for (int bj = 0; bj < 2; ++bj) f.load(u.pm * 256 + ai * 128 + wr * 64 + (2 * mp + mm) * 16 + fr, u.pn * 256 + bj * 128 + wc * 32 + 8 * fq, pre[mm][bj]);
#pragma unroll
                for (int mm = 0; mm < 2; ++mm)
#pragma unroll
                    for (int bj = 0; bj < 2; ++bj) { const int m = 2 * mp + mm; const f32x4 a = acc[ai][bj][m][0], b = acc[ai][bj][m][1];
                        const float v[8] = {a[0], a[1], a[2], a[3], b[0], b[1], b[2], b[3]};
                        f.apply(u.pm * 256 + ai * 128 + wr * 64 + m * 16 + fr, u.pn * 256 + bj * 128 + wc * 32 + 8 * fq, v, pre[mm][bj]); }
                asm volatile("" ::: "memory");
            }
    }
};

struct ProjOrder {
    pg8::StaticOrder so; int G, c;
    __device__ __forceinline__ void init(int G_, int c_) { so.init(TL, PROJ, G_, c_); G = G_; c = c_; }
    __device__ __forceinline__ bool next(int i, pg8::Unit& u) const {
        const int L = i * G + c;
        if (L < so.nwg) return so.next(i, u);
        const int j = L - so.nwg; if (j >= 128) return false;
        u.pm = 128 + (j >> 3); u.pn = j & 7; u.bofs = 0; return true;
    }
    __device__ __forceinline__ void a_ready(const pg8::Unit&) const {}
    __device__ __forceinline__ void done(const pg8::Unit&) const {}
};
struct MoeOrder {
    const unsigned* ctl; int G, vcu, nunits; size_t estride;
    __device__ __forceinline__ void init(const unsigned* ctl_, int G_, int bx, size_t es) { ctl = ctl_; G = G_; vcu = (G_ % 8 == 0) ? (bx % 8) * (G_ / 8) + bx / 8 : bx; nunits = (int)ctl_[CW_NBLK] * 4; estride = es; }
    __device__ __forceinline__ bool next(int i, pg8::Unit& u) const {
        const int L = i * G + vcu; if (L >= nunits) return false;
        u.pm = L >> 2; u.pn = L & 3; u.bofs = (size_t)ctl[CW_BLKE + u.pm] * estride; return true;
    }
    __device__ __forceinline__ void a_ready(const pg8::Unit&) const {}
    __device__ __forceinline__ void done(const pg8::Unit&) const {}
};

#define XB_TMO      128
#define XB_XCNT(j)  (256  + 64 * (j))
#define XB_XSUB(j)  (1280 + 64 * (j))
#define XB_XGEN(j)  (2304 + 64 * (j))
#define XB_TOP      3328
#define XB_TOPGEN   3392
#define XCD_BAR_WORDS 3456
#define XB_SPIN_CAP (1u << 18)

__device__ __forceinline__ unsigned xb_ld(unsigned* p)              { return __hip_atomic_load(p, __ATOMIC_RELAXED, __HIP_MEMORY_SCOPE_AGENT); }
__device__ __forceinline__ unsigned xb_add(unsigned* p, unsigned v) { return __hip_atomic_fetch_add(p, v, __ATOMIC_RELAXED, __HIP_MEMORY_SCOPE_AGENT); }
__device__ __forceinline__ unsigned xb_xcc_id() { return (unsigned)__builtin_amdgcn_s_getreg((3 << 11) | 20) & 0xFu; }
#define XB_SPIN(cond, bar) do { unsigned _sp = 0; while (cond) { __builtin_amdgcn_s_sleep(1); \
    if ((++_sp & 255u) == 0u) { if (xb_ld(&(bar)[XB_TMO])) break; if (_sp > XB_SPIN_CAP) { atomicAdd(&(bar)[XB_TMO], 1u); break; } } } } while (0)

struct XcdBarrier {
    unsigned* bar; unsigned x;
    volatile LAS unsigned* st;
};

__device__ __forceinline__ XcdBarrier xcd_barrier_post(unsigned* bar, volatile LAS unsigned* st, bool leader) {
    XcdBarrier b; b.bar = bar; b.x = xb_xcc_id(); b.st = st;
    if (leader) (void)xb_add(&bar[XB_XCNT(b.x)], 1u);
    return b;
}
__device__ __forceinline__ void xcd_barrier_complete(unsigned* bar, unsigned x, unsigned& nloc, unsigned& nx) {
    const unsigned G = gridDim.x * gridDim.y * gridDim.z;
    unsigned sum, cnt, mine, sp = 0u;
    for (;;) {
        sum = 0u; cnt = 0u; mine = 0u;
#pragma unroll
        for (unsigned j = 0; j < 16; ++j) { const unsigned c = xb_ld(&bar[XB_XCNT(j)]); sum += c; cnt += (c > 0u) ? 1u : 0u; mine = (j == x) ? c : mine; }
        if (sum == G) break;
        __builtin_amdgcn_s_sleep(1);
        if ((++sp & 255u) == 0u) { if (xb_ld(&bar[XB_TMO])) break; if (sp > XB_SPIN_CAP) { atomicAdd(&bar[XB_TMO], 1u); break; } }
    }
    nloc = mine > 0u ? mine : 1u; nx = cnt > 0u ? cnt : 1u;
}

__device__ __forceinline__ void xcd_barrier(const XcdBarrier& b, int wave) {
    const bool leader_ = wave == 0 && __builtin_amdgcn_mbcnt_hi(~0u, __builtin_amdgcn_mbcnt_lo(~0u, 0u)) == 0u;
    asm volatile("s_waitcnt vmcnt(0)" ::: "memory");
    __syncthreads();
    if (leader_) {
        unsigned* bar = b.bar;
        __builtin_amdgcn_s_waitcnt(0);
        unsigned nloc = b.st[0], nx = b.st[1];
        if (nloc == 0u) { xcd_barrier_complete(bar, b.x, nloc, nx); b.st[0] = nloc; b.st[1] = nx; }
        const unsigned old = xb_add(&bar[XB_XSUB(b.x)], 1u);
        const unsigned gen = old / nloc;
        if (old + 1u == (gen + 1u) * nloc) {
            __builtin_amdgcn_fence(__ATOMIC_RELEASE, "agent");
            asm volatile("s_waitcnt vmcnt(0)" ::: "memory");
            const unsigned og = xb_add(&bar[XB_TOP], 1u);
            const unsigned tg = og / nx;
            if (og + 1u == (tg + 1u) * nx) xb_add(&bar[XB_TOPGEN], 1u);
            else XB_SPIN(xb_ld(&bar[XB_TOPGEN]) == tg, bar);
            __builtin_amdgcn_fence(__ATOMIC_ACQUIRE, "agent");
            xb_add(&bar[XB_XGEN(b.x)], 1u);
            asm volatile("s_waitcnt vmcnt(0)" ::: "memory");
        } else {
            XB_SPIN(xb_ld(&bar[XB_XGEN(b.x)]) == gen, bar);
            __builtin_amdgcn_fence(__ATOMIC_ACQUIRE, "agent");
            asm volatile("s_waitcnt vmcnt(0)" ::: "memory");
        }
    }
    __syncthreads();
}

__device__ __forceinline__ int win_perm(int n) {
    const bool qk = (n < 512) || (n >= 2048 && n < 2560);
    if (!qk) return n;
    const int d = n & 63, base = n - d, half = d >> 5, dd = d & 31, i = dd & 15, comp = dd >> 4;
    return base + half * 32 + 2 * i + comp;
}
template <int K, int N, int MODE, int ROWMUL>
__device__ __forceinline__ void prep_item(const float* W, bf16_t* WT, int rowoff, unsigned dstride, LAS float* scr, int item, int lane, float wscale = 1.0f) {
    constexpr int nblk = N / 32, per = (K / 64) * nblk;
    const int bi = item / per, r = item % per, kb = r / nblk, nb = r % nblk, k0 = 64 * kb, n0 = 32 * nb;
    const float* src = W + (size_t)bi * K * N;
    { float t_[32];
#pragma unroll
      for (int i = 0; i < 32; ++i) t_[i] = __builtin_nontemporal_load(src + (size_t)(k0 + 2 * i + (lane >> 5)) * N + n0 + (lane & 31));
#pragma unroll
      for (int i = 0; i < 32; ++i) scr[(2 * i + (lane >> 5)) * 33 + (lane & 31)] = t_[i]; }
    asm volatile("s_waitcnt lgkmcnt(0)" ::: "memory");
    const int c = lane & 7;
#pragma unroll
    for (int j = 0; j < 4; ++j) { const int n = (lane >> 3) + 8 * j; const LAS float* s = scr + (8 * c) * 33 + n;
        u32x4 o; o.x = pk2(s[0 * 33] * wscale, s[1 * 33] * wscale); o.y = pk2(s[2 * 33] * wscale, s[3 * 33] * wscale); o.z = pk2(s[4 * 33] * wscale, s[5 * 33] * wscale); o.w = pk2(s[6 * 33] * wscale, s[7 * 33] * wscale);
        int ng = n0 + n; if (MODE == 1) ng = win_perm(ng);
        *(u32x4*)(WT + (size_t)bi * dstride + (size_t)(ROWMUL * ng + rowoff) * K + k0 + 8 * c) = o; }
    asm volatile("s_waitcnt lgkmcnt(0)" ::: "memory");
}
__device__ __forceinline__ unsigned char* lds_ptr(LAS unsigned char* ldsl, int i);
__device__ __forceinline__ void p0_prep(unsigned char* ws, LAS unsigned char* ldsl, int gw, int ngw, int lane, int wave) {
    LAS float* scr = (LAS float*)(ldsl + wave * 8448);
#define in_(i) ((const float*)lds_ptr(ldsl, (i)))
    constexpr int I0 = 16 * 176, I1 = 8 * 32, I2 = 16 * 32, I3 = 16 * 32, I4 = 16 * 2 * 4, I5 = I4, I6 = 32 * 16 * 16, I7 = I6, I8 = 32 * 8 * 32;
    constexpr int TOT = I0 + I1 + I2 + I3 + I4 + I5 + I6 + I7 + I8;
    for (int it = gw; it < TOT; it += ngw) {
        int r = it;
        if (r < I0) { prep_item<1024, PROJ, 1, 1>(in_(8), (bf16_t*)(ws + WS_WIN), 0, 0u, scr, r, lane); continue; } r -= I0;
        if (r < I1) { prep_item<512, 1024, 0, 1>(in_(17), (bf16_t*)(ws + WS_WA), 0, 0u, scr, r, lane); continue; } r -= I1;
        if (r < I2) { prep_item<1024, 1024, 0, 1>(in_(18), (bf16_t*)(ws + WS_WL), 0, 0u, scr, r, lane); continue; } r -= I2;
        if (r < I3) { prep_item<1024, 1024, 0, 1>(in_(19), (bf16_t*)(ws + WS_WO), 0, 0u, scr, r, lane); continue; } r -= I3;
        if (r < I4) { prep_item<128, 128, 0, 1>(in_(12), (bf16_t*)(ws + WS_LW), 0, 256u * 128u, scr, r, lane, -1.4426950408889634f); continue; } r -= I4;
        if (r < I5) { prep_item<128, 128, 0, 1>(in_(14), (bf16_t*)(ws + WS_LW), 128, 256u * 128u, scr, r, lane, -1.4426950408889634f); continue; } r -= I5;
        if (r < I6) { prep_item<1024, 512, 0, 2>(in_(24), (bf16_t*)(ws + WS_W13), 0, 1024u * 1024u, scr, r, lane); continue; } r -= I6;
        if (r < I7) { prep_item<1024, 512, 0, 2>(in_(25), (bf16_t*)(ws + WS_W13), 1, 1024u * 1024u, scr, r, lane); continue; } r -= I7;
        prep_item<512, 1024, 0, 1>(in_(26), (bf16_t*)(ws + WS_W2), 0, 1024u * 512u, scr, r, lane);
    }
#undef in_
}
__device__ __forceinline__ void p0_mod(const float* c, const float* c_ctx, const float* w_mod, const float* b_mod, const float* wg, const float* we, f32x4* W4g, const float* lam, float* SPt, float* mod, f32x2* rope, LAS float* lds_f, int tid) {
    LAS float* sc = lds_f;
    LAS float* red = lds_f + 17 * 1024;
    for (int i = tid; i < 17 * 1024; i += NTHREADS) { const float v = (i < 16 * 1024) ? c[i] : c_ctx[i - 16 * 1024]; sc[i] = siluf_(v); }
    for (int idx = blockIdx.x * NTHREADS + tid; idx < 36 * 256; idx += gridDim.x * NTHREADS) { const int cc = idx >> 8, kq = idx & 255; f32x4 w;
        if (cc < 4) { const float* s = wg + (size_t)(4 * kq) * 4 + cc; w.x = s[0]; w.y = s[4]; w.z = s[8]; w.w = s[12]; }
        else { const float* s = we + (size_t)(4 * kq) * 32 + (cc - 4); w.x = s[0]; w.y = s[32]; w.z = s[64]; w.w = s[96]; }
        W4g[idx] = w; }
    if (blockIdx.x == 1) for (int i = tid; i < 2048; i += NTHREADS) { const float lm = lam[i]; SPt[i] = (-lm > 20.f) ? -lm : log1pf(expf(-lm)); }
    if (blockIdx.x == 0) for (int i = tid; i < 64 * 16; i += NTHREADS) { const int pos = i >> 4, f = i & 15; const double inv = exp(-(double)f / 16.0 * log(10000.0)); const double ang = (double)pos * inv;
        rope[i] = (f32x2){(float)cos(ang), (float)sin(ang)}; }
    __syncthreads();
    for (int cb = blockIdx.x; cb < 256; cb += gridDim.x) {
        const int ks = tid / 24, col = tid % 24;
        if (ks < 21) {
            float acc[17];
#pragma unroll
            for (int b = 0; b < 17; ++b) acc[b] = 0.f;
            for (int k = ks; k < 1024; k += 21) { const float w = w_mod[(size_t)k * 6144 + cb * 24 + col];
#pragma unroll
                for (int b = 0; b < 17; ++b) acc[b] += sc[b * 1024 + k] * w; }
#pragma unroll
            for (int b = 0; b < 17; ++b) red[(ks * 17 + b) * 24 + col] = acc[b];
        }
        __syncthreads();
        if (tid < 17 * 24) { const int b = tid / 24, cc = tid % 24; float s = b_mod[cb * 24 + cc];
            for (int q = 0; q < 21; ++q) s += red[(q * 17 + b) * 24 + cc];
            mod[b * 6144 + cb * 24 + cc] = s; }
        __syncthreads();
    }
}

__device__ __forceinline__ void p1_adanorm(const float* x, const float* ctx, const float* gain, const float* mod, bf16_t* H, int gw, int ngw, int lane) {
    f32x4 nA[4], nB[4];
#define AD_SRC(r_) ((r_) < TL ? x + (size_t)(r_) * D : ctx + (size_t)((r_) - TL) * D)
#define AD_LOAD(dst, r_) do { if ((r_) < TALL) { const float* s_ = AD_SRC(r_); _Pragma("unroll") for (int j = 0; j < 4; ++j) dst[j] = __builtin_nontemporal_load((const f32x4*)(s_ + lane * 4 + 256 * j)); } } while (0)
#define AD_ROW(src_, r_) do { const int row_ = (r_); const int mb = row_ < TL ? (row_ >> 11) : 16; const float* shift = mod + mb * 6144; const float* scale = shift + 1024; \
        f32x4 v[4]; float ss = 0.f; \
        _Pragma("unroll") for (int j = 0; j < 4; ++j) { v[j] = src_[j]; ss += v[j].x * v[j].x + v[j].y * v[j].y + v[j].z * v[j].z + v[j].w * v[j].w; } \
        AD_LOAD(src_, row_ + 2 * ngw); \
        const float rstd = rsqrtf(wave_sum_fast(ss) * (1.0f / D) + EPS); \
        _Pragma("unroll") for (int j = 0; j < 4; ++j) { const int k = lane * 4 + 256 * j; const f32x4 g = *(const f32x4*)(gain + k), sh = *(const f32x4*)(shift + k), sc = *(const f32x4*)(scale + k); \
            const f32x4 o = (v[j] * rstd * g) * (1.0f + sc) + sh; \
            u32x2 w; w.x = pk2(o.x, o.y); w.y = pk2(o.z, o.w); *(u32x2*)(H + (size_t)row_ * D + k) = w; } } while (0)
    AD_LOAD(nA, gw); AD_LOAD(nB, gw + ngw);
    for (int row = gw; row < TALL; row += 2 * ngw) { AD_ROW(nA, row); if (row + ngw < TALL) AD_ROW(nB, row + ngw); }
#undef AD_SRC
#undef AD_LOAD
#undef AD_ROW
}

__device__ __forceinline__ void p1_router_tables(const float* gain, const float* mod, const f32x4* W4g, const float* bg, const float* be, float* WT, float* biasb, int gw, int ngw, int lane) {
    for (int it = gw; it < 16 * 48; it += ngw) {
        const int b = it / 48, j = it % 48; const float* shift = mod + b * 6144 + 3072; const float* scale = shift + 1024;
        float part = 0.f;
#pragma unroll
        for (int i = 0; i < 4; ++i) { const int kq = lane + 64 * i; const f32x4 g = *(const f32x4*)(gain + 4 * kq), sc = *(const f32x4*)(scale + 4 * kq), sh = *(const f32x4*)(shift + 4 * kq);
            f32x4 w = (f32x4){0.f, 0.f, 0.f, 0.f}; if (j < 36) w = W4g[j * 256 + kq];
            *(f32x4*)(WT + (size_t)(b * 48 + j) * 1024 + 4 * kq) = g * (1.0f + sc) * w;
            part += sh.x * w.x + sh.y * w.y + sh.z * w.z + sh.w * w.w; }
        part = wave_sum_fast(part);
        if (lane == 0) biasb[b * 48 + j] = part + (j < 4 ? bg[j] : j < 36 ? be[j - 4] : 0.f);
    }
}
constexpr int RT_CHUNK_FLOATS = 48 * 132, RT_LG_OFF = 2 * RT_CHUNK_FLOATS * 4;
__device__ __forceinline__ void p8_route(const bf16_t* x1, const float* WT, const float* biasb, unsigned* ctl, int* tok, LAS unsigned char* lds, int lane, int tid, int wave) {
    LAS unsigned* hist = (LAS unsigned*)(lds + MISC_OFF + 256);
    if (tid < 32) hist[tid] = 0u;
    LAS float* Lg = (LAS float*)(lds + RT_LG_OFF + wave * 3072);
    const int i = lane & 15, kk = lane >> 4;
    for (int blk = blockIdx.x; blk < TL / 128; blk += gridDim.x) {
        const int R0 = 128 * blk + 16 * wave, b = (128 * blk) >> 11;
        const bf16_t* xr = x1 + (size_t)(R0 + i) * D + 4 * kk; const float* wtb = WT + (size_t)b * 48 * 1024;
        f32x4 a0 = (f32x4){0.f, 0.f, 0.f, 0.f}, a1 = a0, a2 = a0; float ss = 0.f;
        f32x4 stg[3];
#define RT_LOAD(c_) do { _Pragma("unroll") for (int q = 0; q < 3; ++q) { const int id = tid + NTHREADS * q, col = id >> 5, k4 = id & 31; stg[q] = *(const f32x4*)(wtb + (size_t)col * 1024 + 128 * (c_) + 4 * k4); } } while (0)
#define RT_STORE(buf_) do { _Pragma("unroll") for (int q = 0; q < 3; ++q) { const int id = tid + NTHREADS * q, col = id >> 5, k4 = id & 31; *(LAS f32x4*)((LAS float*)lds + (buf_) * RT_CHUNK_FLOATS + col * 132 + 4 * k4) = stg[q]; } } while (0)
        __syncthreads();
        RT_LOAD(0); RT_STORE(0);
        u32x2 cx[8];
#pragma unroll
        for (int u = 0; u < 8; ++u) cx[u] = *(const u32x2*)(xr + 16 * u);
        __syncthreads();
#pragma unroll 1
        for (int c = 0; c < 8; ++c) {
            if (c < 7) RT_LOAD(c + 1);
            u32x2 nx[8];
            if (c < 7) {
#pragma unroll
                for (int u = 0; u < 8; ++u) nx[u] = *(const u32x2*)(xr + 128 * (c + 1) + 16 * u); }
            const LAS float* wl = (const LAS float*)lds + (c & 1) * RT_CHUNK_FLOATS + i * 132 + 4 * kk;
#pragma unroll
            for (int u = 0; u < 8; ++u) { const f32x4 xa = (f32x4){bflo(cx[u].x), bfhi(cx[u].x), bflo(cx[u].y), bfhi(cx[u].y)}, b0 = *(const LAS f32x4*)(wl + 16 * u), b1 = *(const LAS f32x4*)(wl + 16 * 132 + 16 * u), b2 = *(const LAS f32x4*)(wl + 32 * 132 + 16 * u);
                ss += xa.x * xa.x + xa.y * xa.y + xa.z * xa.z + xa.w * xa.w;
                a0 = __builtin_amdgcn_mfma_f32_16x16x4f32(xa.x, b0.x, a0, 0, 0, 0); a1 = __builtin_amdgcn_mfma_f32_16x16x4f32(xa.x, b1.x, a1, 0, 0, 0); a2 = __builtin_amdgcn_mfma_f32_16x16x4f32(xa.x, b2.x, a2, 0, 0, 0);
                a0 = __builtin_amdgcn_mfma_f32_16x16x4f32(xa.y, b0.y, a0, 0, 0, 0); a1 = __builtin_amdgcn_mfma_f32_16x16x4f32(xa.y, b1.y, a1, 0, 0, 0); a2 = __builtin_amdgcn_mfma_f32_16x16x4f32(xa.y, b2.y, a2, 0, 0, 0);
                a0 = __builtin_amdgcn_mfma_f32_16x16x4f32(xa.z, b0.z, a0, 0, 0, 0); a1 = __builtin_amdgcn_mfma_f32_16x16x4f32(xa.z, b1.z, a1, 0, 0, 0); a2 = __builtin_amdgcn_mfma_f32_16x16x4f32(xa.z, b2.z, a2, 0, 0, 0);
                a0 = __builtin_amdgcn_mfma_f32_16x16x4f32(xa.w, b0.w, a0, 0, 0, 0); a1 = __builtin_amdgcn_mfma_f32_16x16x4f32(xa.w, b1.w, a1, 0, 0, 0); a2 = __builtin_amdgcn_mfma_f32_16x16x4f32(xa.w, b2.w, a2, 0, 0, 0); }
            if (c < 7) { RT_STORE((c + 1) & 1);
#pragma unroll
                for (int u = 0; u < 8; ++u) cx[u] = nx[u]; }
            __syncthreads();
        }
#undef RT_LOAD
#undef RT_STORE
        ss = half_sum(ss); { const auto r = __builtin_amdgcn_permlane16_swap(__float_as_uint(ss), __float_as_uint(ss), false, false); ss = __uint_as_float(r[0]) + __uint_as_float(r[1]); }
        const float rstd = rsqrtf(ss * (1.0f / D) + EPS);
#pragma unroll
        for (int rg = 0; rg < 4; ++rg) { Lg[(4 * kk + rg) * 48 + i] = a0[rg]; Lg[(4 * kk + rg) * 48 + 16 + i] = a1[rg]; Lg[(4 * kk + rg) * 48 + 32 + i] = a2[rg]; }
        if (lane < 16) {
            const int row = R0 + lane; const float* bb = biasb + b * 48; const LAS float* lr = Lg + lane * 48;
            float acc[36];
#pragma unroll
            for (int c4 = 0; c4 < 9; ++c4) { const f32x4 v = *(const LAS f32x4*)(lr + 4 * c4), bv = *(const f32x4*)(bb + 4 * c4);
                acc[4 * c4] = rstd * v.x + bv.x; acc[4 * c4 + 1] = rstd * v.y + bv.y; acc[4 * c4 + 2] = rstd * v.z + bv.z; acc[4 * c4 + 3] = rstd * v.w + bv.w; }
            int gi = 0; float gm = -1e30f;
#pragma unroll
            for (int g = 0; g < 4; ++g) if (acc[g] > gm) { gm = acc[g]; gi = g; }
            float gs = 0.f;
#pragma unroll
            for (int g = 0; g < 4; ++g) gs += expf(acc[g] - gm);
            const float p_top = 1.0f / gs;
            float le[8];
#pragma unroll
            for (int j = 0; j < 8; ++j) le[j] = gi == 0 ? acc[4 + j] : gi == 1 ? acc[12 + j] : gi == 2 ? acc[20 + j] : acc[28 + j];
            int e1 = 0; float v1 = -1e30f;
#pragma unroll
            for (int j = 0; j < 8; ++j) if (le[j] > v1) { v1 = le[j]; e1 = j; }
            int e2 = 0; float v2 = -1e30f;
#pragma unroll
            for (int j = 0; j < 8; ++j) if (j != e1 && le[j] > v2) { v2 = le[j]; e2 = j; }
            const float p2 = expf(v2 - v1), inv = 1.0f / (1.0f + p2);
            const int eid0 = gi * 8 + e1, eid1 = gi * 8 + e2;
            const int s0 = (int)__hip_atomic_fetch_add(&hist[eid0], 1u, __ATOMIC_RELAXED, __HIP_MEMORY_SCOPE_WORKGROUP), s1 = (int)__hip_atomic_fetch_add(&hist[eid1], 1u, __ATOMIC_RELAXED, __HIP_MEMORY_SCOPE_WORKGROUP);
            int* tr = tok + row * 8; tr[0] = eid0; tr[1] = eid1; ((float*)tr)[2] = p_top * inv; ((float*)tr)[3] = p_top * p2 * inv; tr[4] = s0; tr[5] = s1; ((float*)tr)[6] = rstd;
        }
    }
    __syncthreads();
    if (tid < 32) ctl[CW_BCNT + blockIdx.x * 32 + tid] = hist[tid];
}

__device__ __forceinline__ void p9_scatter(const bf16_t* x1, const float* gain, const float* mod, unsigned* ctl, int* tok, bf16_t* XB, LAS unsigned* sl, int gw, int ngw, int lane, int tid) {
    const int G = gridDim.x;
    { const int e = tid & 31, part = tid >> 5; unsigned sall = 0, sbef = 0;
      for (int bb = part; bb < G; bb += 16) { const unsigned v = ctl[CW_BCNT + bb * 32 + e]; sall += v; if (bb < (int)blockIdx.x) sbef += v; }
      sl[part * 32 + e] = sall; sl[512 + part * 32 + e] = sbef; }
    __syncthreads();
    if (tid < 64) {
        unsigned cnt = 0, bef = 0;
        if (lane < 32) for (int q = 0; q < 16; ++q) { cnt += sl[q * 32 + lane]; bef += sl[512 + q * 32 + lane]; }
        const unsigned padded = (cnt + 255u) & ~255u; unsigned incl = padded;
#pragma unroll
        for (int o = 1; o < 32; o <<= 1) { const unsigned t = __shfl_up(incl, o); if ((lane & 31) >= o) incl += t; }
        const unsigned excl = incl - padded;
        if (lane < 32) sl[1024 + lane] = excl + bef;
        if (blockIdx.x == 0) {
            const unsigned total = __shfl(incl, 31);
            if (lane == 0) ctl[CW_NBLK] = total >> 8;
            if (lane < 32) for (unsigned i = excl >> 8; i < (incl >> 8); ++i) ctl[CW_BLKE + i] = (unsigned)lane;
        }
    }
    __syncthreads();
    for (int blk = blockIdx.x; blk < TL / 128; blk += gridDim.x) {
        const int R0 = 128 * blk + 16 * (tid >> 6); const float* shift = mod + (R0 >> 11) * 6144 + 3072; const float* scale = shift + 1024;
        f32x4 G[4], S[4];
#pragma unroll
        for (int j = 0; j < 4; ++j) { const int k = lane * 4 + 256 * j; G[j] = *(const f32x4*)(gain + k) * (1.0f + *(const f32x4*)(scale + k)); S[j] = *(const f32x4*)(shift + k); }
#pragma unroll 4
        for (int rr = 0; rr < 16; ++rr) { const int row = R0 + rr; const int* tr = tok + row * 8;
            const int e0 = tr[0], e1 = tr[1]; const float rstd = ((const float*)tr)[6];
            const unsigned d0 = sl[1024 + e0] + (unsigned)tr[4], d1 = sl[1024 + e1] + (unsigned)tr[5];
            u32x2 w[4];
#pragma unroll
            for (int j = 0; j < 4; ++j) { const u32x2 xb = *(const u32x2*)(x1 + (size_t)row * D + lane * 4 + 256 * j); const f32x4 o = (f32x4){bflo(xb.x), bfhi(xb.x), bflo(xb.y), bfhi(xb.y)} * rstd * G[j] + S[j]; w[j].x = pk2(o.x, o.y); w[j].y = pk2(o.z, o.w); }
#pragma unroll
            for (int j = 0; j < 4; ++j) { *(u32x2*)(XB + (size_t)d0 * D + lane * 4 + 256 * j) = w[j]; *(u32x2*)(XB + (size_t)d1 * D + lane * 4 + 256 * j) = w[j]; }
            if (lane == 0) { tok[row * 8 + 4] = (int)d0; tok[row * 8 + 5] = (int)d1; } }
    }
}

__device__ __forceinline__ void p12_final(const bf16_t* x1, float* outp, const float* mod, const int* tok, const bf16_t* YB, const float* gfin, int gw, int ngw, int lane) {
    u32x2 nxv[4]; u32x2 nya[4], nyb[4]; float nw0 = 0.f, nw1 = 0.f; int t2d0 = 0, t2d1 = 0; float t2w0 = 0.f, t2w1 = 0.f;
    if (gw < TL) { const int d0 = tok[gw * 8 + 4], d1 = tok[gw * 8 + 5]; nw0 = ((const float*)tok)[gw * 8 + 2]; nw1 = ((const float*)tok)[gw * 8 + 3];
#pragma unroll
        for (int j = 0; j < 4; ++j) { const int k = lane * 4 + 256 * j; nxv[j] = *(const u32x2*)(x1 + (size_t)gw * D + k); nya[j] = *(const u32x2*)(YB + (size_t)d0 * D + k); nyb[j] = *(const u32x2*)(YB + (size_t)d1 * D + k); } }
    if (gw + ngw < TL) { const int r2 = gw + ngw; t2d0 = tok[r2 * 8 + 4]; t2d1 = tok[r2 * 8 + 5]; t2w0 = ((const float*)tok)[r2 * 8 + 2]; t2w1 = ((const float*)tok)[r2 * 8 + 3]; }
    for (int row = gw; row < TL; row += ngw) {
        const float* ga2 = mod + (row >> 11) * 6144 + 5120; float* dst = outp + (size_t)row * D;
        const float w0 = nw0, w1 = nw1;
        f32x4 xv[4]; u32x2 ya[4], yb[4];
#pragma unroll
        for (int j = 0; j < 4; ++j) { xv[j] = (f32x4){bflo(nxv[j].x), bfhi(nxv[j].x), bflo(nxv[j].y), bfhi(nxv[j].y)}; ya[j] = nya[j]; yb[j] = nyb[j]; }
        const int nrow = row + ngw;
        if (nrow < TL) { nw0 = t2w0; nw1 = t2w1;
#pragma unroll
            for (int j = 0; j < 4; ++j) { const int k = lane * 4 + 256 * j; nxv[j] = *(const u32x2*)(x1 + (size_t)nrow * D + k); nya[j] = *(const u32x2*)(YB + (size_t)t2d0 * D + k); nyb[j] = *(const u32x2*)(YB + (size_t)t2d1 * D + k); }
            const int r2 = nrow + ngw;
            if (r2 < TL) { t2d0 = tok[r2 * 8 + 4]; t2d1 = tok[r2 * 8 + 5]; t2w0 = ((const float*)tok)[r2 * 8 + 2]; t2w1 = ((const float*)tok)[r2 * 8 + 3]; } }
        f32x4 v[4]; float ss = 0.f;
#pragma unroll
        for (int j = 0; j < 4; ++j) { const int k = lane * 4 + 256 * j; const f32x4 g = *(const f32x4*)(ga2 + k); const u32x2 a = ya[j], bq = yb[j];
            f32x4 y; y.x = w0 * bflo(a.x) + w1 * bflo(bq.x); y.y = w0 * bfhi(a.x) + w1 * bfhi(bq.x); y.z = w0 * bflo(a.y) + w1 * bflo(bq.y); y.w = w0 * bfhi(a.y) + w1 * bfhi(bq.y);
            v[j] = xv[j] + g * y; ss += v[j].x * v[j].x + v[j].y * v[j].y + v[j].z * v[j].z + v[j].w * v[j].w; }
        const float rstd = rsqrtf(wave_sum_fast(ss) * (1.0f / D) + EPS);
#pragma unroll
        for (int j = 0; j < 4; ++j) { const int k = lane * 4 + 256 * j; const f32x4 g = *(const f32x4*)(gfin + k); *(f32x4*)(dst + k) = v[j] * rstd * g; }
    }
}

typedef float f32x16 __attribute__((ext_vector_type(16)));
typedef short v4i16_t __attribute__((ext_vector_type(4)));
using pg8::bf16x8;
constexpr int ATT_CK_OFF = 2048, ATT_CV_OFF = ATT_CK_OFF + 32768, ATT_RING_OFF = ATT_CV_OFF + 32768, ATT_SK_OFF = ATT_RING_OFF + 32768, ATT_SV_OFF = ATT_SK_OFF + 11 * 2048;
static_assert(ATT_SV_OFF + 11 * 2048 <= MISC_OFF, "attention LDS map");
__device__ __forceinline__ void p3_attn(const bf16_t* Qb, bf16_t* Ob, const bf16_t* Kb, const bf16_t* Vb, const float* rpb, const f32x2* rope, LAS unsigned char* lds, int wave, int lane) {
    constexpr float L2E = 1.4426950408889634f, SC = 0.125f * L2E;
    const int tid = wave * 64 + lane, ql = lane & 31, hl = lane >> 5, skey = tid >> 3, sch = tid & 7;
    LAS float* rpbL = (LAS float*)lds;
    const int vq = (lane & 15) >> 2, vcol = (16 * ((lane >> 4) & 1) + 4 * (lane & 3)) * 2;
    const int g = wave & 1, sside = skey >= 24 && skey < 40;
    for (int it = blockIdx.x; it < NBATCH * 8 * 2; it += gridDim.x) {
        const int rh = it & 1, h = (it >> 1) & 7, b = it >> 4;
        __syncthreads();
        if (tid < 15 * 32) { const int c = tid & 31, dr = tid >> 5; rpbL[tid] = c < 31 ? rpb[(h * 15 + dr) * 31 + c] * L2E : -1e30f; }
#pragma unroll
        for (int i = 0; i < 4; ++i) { const int key = skey + 64 * i; const size_t row = (size_t)(TL + b * CTXL + key) * 512 + h * 64 + 8 * sch;
            *(LAS u32x4*)(lds + ATT_CK_OFF + key * 128 + ((sch ^ (key & 7)) * 16)) = *(const u32x4*)(Kb + row);
            *(LAS u32x4*)(lds + ATT_CV_OFF + key * 128 + sch * 16) = *(const u32x4*)(Vb + row); }
#pragma unroll 1
        for (int pass = 0; pass < 4; ++pass) {
            const int R0 = 16 * rh + 4 * pass, r = R0 + (wave >> 1);
            const int cq = 32 * g + ql, rs = min(max(r - 4, 0), 24), cstart = min(max(cq - 8, 0), 48);
            const int kmin = min(max(R0 - 4, 0), 24), kmax = min(max(R0 - 1, 0), 24) + 7, nsteps = kmax - kmin + 1;
            const bf16_t* qp = Qb + (size_t)(b * SEQ + r * 64 + cq) * 512 + h * 64; bf16_t* op = Ob + (size_t)(b * SEQ + r * 64 + cq) * 512 + h * 64;
#define ATT_PUT(slot_, krel_, kv_, vv_) do { *(LAS u32x4*)(lds + (slot_) + skey * 128 + ((sch ^ (skey & 7)) * 16)) = (kv_); *(LAS u32x4*)(lds + (slot_) + 8192 + skey * 128 + sch * 16) = (vv_); \
                if (sside) { *(LAS u32x4*)(lds + ATT_SK_OFF + ((krel_) * 16 + skey - 24) * 128 + ((sch ^ (skey & 7)) * 16)) = (kv_); *(LAS u32x4*)(lds + ATT_SV_OFF + ((krel_) * 16 + skey - 24) * 128 + sch * 16) = (vv_); } } while (0)
            { const size_t row = (size_t)(b * SEQ + kmin * 64 + skey) * 512 + h * 64 + 8 * sch; const u32x4 kv = *(const u32x4*)(Kb + row), vv = *(const u32x4*)(Vb + row); ATT_PUT(ATT_RING_OFF, 0, kv, vv); }
            bf16x8 qplain[4], qrot[4];
#pragma unroll
            for (int d0 = 0; d0 < 4; ++d0) { float v[8], o[8], pl[8]; unpack8(*(const u32x4*)(qp + 16 * d0 + 8 * hl), v);
                const int pos = d0 < 2 ? r : cq, i0 = ((16 * d0 + 8 * hl) & 31) >> 1;
#pragma unroll
                for (int j = 0; j < 4; ++j) { const f32x2 cs = rope[pos * 16 + i0 + j]; o[2 * j] = (v[2 * j] * cs.x - v[2 * j + 1] * cs.y) * SC; o[2 * j + 1] = (v[2 * j] * cs.y + v[2 * j + 1] * cs.x) * SC; }
#pragma unroll
                for (int j = 0; j < 8; ++j) pl[j] = v[j] * SC;
                qrot[d0] = __builtin_bit_cast(bf16x8, pack8(o)); qplain[d0] = __builtin_bit_cast(bf16x8, pack8(pl)); }
            int dco[16];
#pragma unroll
            for (int i = 0; i < 16; ++i) { const int kc = 32 * g + (i & 3) + 8 * (i >> 2) + 4 * hl; const bool ok = kc >= cstart && kc < cstart + 16; dco[i] = ok ? (kc - cq + 15) * 4 : 31 * 4; }
            f32x16 o0, o1;
#pragma unroll
            for (int i = 0; i < 16; ++i) { o0[i] = 0.f; o1[i] = 0.f; }
            float m = -1e30f, l = 0.f;
#define ATT_TILE(kp_, vb_, vsk_, ve_, qf) do { \
            _Pragma("unroll") for (int d0 = 0; d0 < 4; ++d0) s = __builtin_amdgcn_mfma_f32_32x32x16_bf16(*(const LAS bf16x8*)((kp_) + (((2 * d0 + hl) ^ (ql & 7)) * 16)), qf[d0], s, 0, 0, 0); \
            float mt = fmaxf(fmaxf(s[0], s[1]), s[2]); \
            _Pragma("unroll") for (int i = 3; i < 15; i += 2) mt = fmaxf(fmaxf(mt, s[i]), s[i + 1]); \
            mt = half_max(fmaxf(mt, s[15])); \
            if (__any(mt > m)) { const float mn = fmaxf(m, mt), alpha = __builtin_amdgcn_exp2f(m - mn); m = mn; l *= alpha; \
                _Pragma("unroll") for (int i = 0; i < 16; ++i) { o0[i] *= alpha; o1[i] *= alpha; } } \
            float ps = 0.f; \
            _Pragma("unroll") for (int i = 0; i < 16; ++i) { s[i] = __builtin_amdgcn_exp2f(s[i] - m); ps += s[i]; } \
            l += ps; \
            bf16x8 pb[2]; \
            _Pragma("unroll") for (int sk = 0; sk < 2; ++sk) { u32x4 w; w.x = pk2(s[8 * sk], s[8 * sk + 1]); w.y = pk2(s[8 * sk + 2], s[8 * sk + 3]); w.z = pk2(s[8 * sk + 4], s[8 * sk + 5]); w.w = pk2(s[8 * sk + 6], s[8 * sk + 7]); \
                pb[sk] = __builtin_bit_cast(bf16x8, w); } \
            _Pragma("unroll") for (int dt = 0; dt < 2; ++dt) _Pragma("unroll") for (int sk = 0; sk < 2; ++sk) { \
                const v4i16_t lo = __builtin_amdgcn_ds_read_tr16_b64_v4i16((LAS v4i16_t*)((vb_) + sk * (vsk_) + dt * 64)); \
                const v4i16_t hi = __builtin_amdgcn_ds_read_tr16_b64_v4i16((LAS v4i16_t*)((vb_) + sk * (vsk_) + (ve_) + dt * 64)); \
                const bf16x8 va = (bf16x8){lo[0], lo[1], lo[2], lo[3], hi[0], hi[1], hi[2], hi[3]}; \
                if (dt == 0) o0 = __builtin_amdgcn_mfma_f32_32x32x16_bf16(va, pb[sk], o0, 0, 0, 0); else o1 = __builtin_amdgcn_mfma_f32_32x32x16_bf16(va, pb[sk], o1, 0, 0, 0); } } while (0)
            __syncthreads();
#pragma unroll 1
            for (int st = 0; st < nsteps; ++st) {
                const int kr = kmin + st, slot = ATT_RING_OFF + (st & 1) * 16384;
                u32x4 nk, nv; const bool more = st + 1 < nsteps;
                if (more) { const size_t row = (size_t)(b * SEQ + (kr + 1) * 64 + skey) * 512 + h * 64 + 8 * sch; nk = *(const u32x4*)(Kb + row); nv = *(const u32x4*)(Vb + row); }
                if (kr >= rs && kr < rs + 8) {
                    const LAS unsigned char* brow = (const LAS unsigned char*)(rpbL + (kr - r + 7) * 32);
                    f32x16 s;
#pragma unroll
                    for (int i = 0; i < 16; ++i) s[i] = *(const LAS float*)(brow + dco[i]);
                    const LAS unsigned char* kp = lds + slot + g * 4096 + ql * 128; const LAS unsigned char* vb = lds + slot + 8192 + g * 4096 + (4 * hl + vq) * 128 + vcol;
                    ATT_TILE(kp, vb, 2048, 1024, qrot);
                }
                if (more) { const int ns = ATT_RING_OFF + ((st + 1) & 1) * 16384; ATT_PUT(ns, st + 1, nk, nv); }
                __syncthreads();
            }
#pragma unroll 1
            for (int x = 0; x < 2; ++x) {
                const int cb = g == 0 ? 8 : 0, krel0 = rs + 4 * x - kmin;
                f32x16 s;
#pragma unroll
                for (int i = 0; i < 16; ++i) { const int kc = 24 + cb + (i & 3) + 4 * hl, dr = rs + 4 * x + (i >> 2) - r + 7; const bool ok = kc >= cstart && kc < cstart + 16;
                    s[i] = ok ? rpbL[dr * 32 + (kc - cq + 15)] : -1e30f; }
                const LAS unsigned char* kp = lds + ATT_SK_OFF + ((krel0 + (ql >> 3)) * 16 + cb + (ql & 7)) * 128;
                const LAS unsigned char* vb = lds + ATT_SV_OFF + (krel0 * 16 + cb + 4 * hl + vq) * 128 + vcol;
                ATT_TILE(kp, vb, 4096, 2048, qrot);
            }
            __syncthreads();
#pragma unroll 1
            for (int ct = 0; ct < 8; ++ct) { f32x16 s;
#pragma unroll
                for (int i = 0; i < 16; ++i) s[i] = 0.f;
                const LAS unsigned char* kp = lds + ATT_CK_OFF + ct * 4096 + ql * 128; const LAS unsigned char* vb = lds + ATT_CV_OFF + ct * 4096 + (4 * hl + vq) * 128 + vcol;
                ATT_TILE(kp, vb, 2048, 1024, qplain); }
#undef ATT_TILE
#undef ATT_PUT
            l = half_sum(l);
            const float il = 1.0f / l;
#pragma unroll
            for (int dt = 0; dt < 2; ++dt)
#pragma unroll
                for (int g4 = 0; g4 < 4; ++g4) { u32x2 w;
                    if (dt == 0) { w.x = pk2(o0[4 * g4] * il, o0[4 * g4 + 1] * il); w.y = pk2(o0[4 * g4 + 2] * il, o0[4 * g4 + 3] * il); }
                    else { w.x = pk2(o1[4 * g4] * il, o1[4 * g4 + 1] * il); w.y = pk2(o1[4 * g4 + 2] * il, o1[4 * g4 + 3] * il); }
                    *(u32x2*)(op + 32 * dt + 8 * g4 + 4 * hl) = w; }
        }
    }
}

constexpr int LRU_WLDS = 8192;
constexpr int LRU_TILES = 72;
__device__ __forceinline__ void lru_conv_frags(const bf16_t* LX, const float* conv_w, const float* conv_b, size_t rowbase, int L, int s0, int n, int lane, bf16x8 (&afr)[8], bf16_t* XC) {
    const int token = lane & 31, hl = lane >> 5, s = s0 + token;
    u32x4 xr[2][2][4];
#define LRU_LDPAIR(pp, buf) do { _Pragma("unroll") for (int q = 0; q < 2; ++q) _Pragma("unroll") for (int j = 0; j < 4; ++j) { const int sj = s + j - 2; xr[buf][q][j] = (u32x4){0u, 0u, 0u, 0u}; \
        if (sj >= 0 && sj < L) xr[buf][q][j] = *(const u32x4*)(LX + (rowbase + sj) * 1024 + n * 128 + 16 * (2 * (pp) + q) + 8 * hl); } } while (0)
    LRU_LDPAIR(0, 0);
#pragma unroll
    for (int pp = 0; pp < 4; ++pp) {
        if (pp < 3) LRU_LDPAIR(pp + 1, (pp + 1) & 1);
        __builtin_amdgcn_sched_barrier(0);
#pragma unroll
        for (int q = 0; q < 2; ++q) { const int ch0 = n * 128 + 16 * (2 * pp + q) + 8 * hl;
            float acc[8];
            { const f32x4 b0 = *(const f32x4*)(conv_b + ch0), b1 = *(const f32x4*)(conv_b + ch0 + 4); acc[0] = b0.x; acc[1] = b0.y; acc[2] = b0.z; acc[3] = b0.w; acc[4] = b1.x; acc[5] = b1.y; acc[6] = b1.z; acc[7] = b1.w; }
#pragma unroll
            for (int j = 0; j < 4; ++j) { float xv[8]; unpack8(xr[pp & 1][q][j], xv);
                const f32x4 w0 = *(const f32x4*)(conv_w + j * 1024 + ch0), w1 = *(const f32x4*)(conv_w + j * 1024 + ch0 + 4);
                acc[0] += w0.x * xv[0]; acc[1] += w0.y * xv[1]; acc[2] += w0.z * xv[2]; acc[3] += w0.w * xv[3]; acc[4] += w1.x * xv[4]; acc[5] += w1.y * xv[5]; acc[6] += w1.z * xv[6]; acc[7] += w1.w * xv[7]; }
            const u32x4 pk = pack8(acc); afr[2 * pp + q] = __builtin_bit_cast(bf16x8, pk);
            if (XC) *(u32x4*)(XC + (rowbase + s) * 1024 + ch0) = pk; }
        __builtin_amdgcn_sched_barrier(0);
    }
#undef LRU_LDPAIR
}
template <int DIR>
__device__ __forceinline__ void lru_group_dir(const f32x16& accr, const f32x16& acci, const f32x16& xv, float bav, float bxv, float sp, float hin0, int hl, float (&hloc)[16], float& At, float& Ht) {
    float aloc[16], As[4], Hs[4];
#pragma unroll
    for (int g = 0; g < 4; ++g) { float h = 0.f, A = 1.f;
#pragma unroll
        for (int ee = 0; ee < 4; ++ee) { const int e4 = DIR == 0 ? ee : 3 - ee, i = 4 * g + e4;
            const float rg = __builtin_amdgcn_rcpf(1.0f + __builtin_amdgcn_exp2f(accr[i] + bav)), ig = __builtin_amdgcn_rcpf(1.0f + __builtin_amdgcn_exp2f(acci[i] + bxv));
            const float a = __builtin_amdgcn_exp2f(rg * sp), u = __builtin_amdgcn_sqrtf(__builtin_fmaf(-a, a, 1.0f)) * (ig * xv[i]);
            h = a * h + u; A *= a; hloc[i] = h; aloc[i] = A; }
        As[g] = A; Hs[g] = h; }
    float Alo[4], Ahi[4], Hlo[4], Hhi[4];
#pragma unroll
    for (int g = 0; g < 4; ++g) { const auto ra = __builtin_amdgcn_permlane32_swap(__float_as_uint(As[g]), __float_as_uint(As[g]), false, false); Alo[g] = __uint_as_float(ra[0]); Ahi[g] = __uint_as_float(ra[1]);
        const auto rh = __builtin_amdgcn_permlane32_swap(__float_as_uint(Hs[g]), __float_as_uint(Hs[g]), false, false); Hlo[g] = __uint_as_float(rh[0]); Hhi[g] = __uint_as_float(rh[1]); }
    float hin[4]; float st = hin0, Ap = 1.f, st0 = 0.f;
#pragma unroll
    for (int gg = 0; gg < 4; ++gg) { const int g = DIR == 0 ? gg : 3 - gg;
        const float A1 = DIR == 0 ? Alo[g] : Ahi[g], H1 = DIR == 0 ? Hlo[g] : Hhi[g], A2 = DIR == 0 ? Ahi[g] : Alo[g], H2 = DIR == 0 ? Hhi[g] : Hlo[g];
        const float in1 = st; st = A1 * st + H1; st0 = A1 * st0 + H1; const float in2 = st; st = A2 * st + H2; st0 = A2 * st0 + H2; Ap *= A1 * A2;
        hin[g] = (DIR == 0) == (hl == 0) ? in1 : in2; }
    At = Ap; Ht = st0;
#pragma unroll
    for (int i = 0; i < 16; ++i) hloc[i] += aloc[i] * hin[i >> 2];
}
constexpr int LRU_CONST_OFF = 131072;
template <int MODE>
__device__ __forceinline__ void p_lru(const bf16_t* LX, const bf16_t* LW, const float* conv_w, const float* conv_b, const float* ba, const float* bx, const float* SP, f32x2* AGG, bf16_t* XC, const bf16_t* LG, bf16_t* OL,
                                      LAS unsigned char* lds, int wave, int lane) {
    constexpr int abl = 0;
    const int G = gridDim.x, n = blockIdx.x & 7, ql = lane & 31, hl = lane >> 5, tid = wave * 64 + lane;
    LAS float* cst = (LAS float*)(lds + LRU_CONST_OFF);
    for (int idx = tid; idx < 2 * 256 * 16; idx += NTHREADS) { const int dir = idx >> 12, j = (idx >> 4) & 255, c = idx & 15;
        *(LAS u32x4*)(lds + (dir * 256 + j) * 256 + ((c ^ (j & 15)) * 16)) = *(const u32x4*)(LW + ((size_t)(dir * 8 + n) * 256 + j) * 128 + 8 * c); }
    for (int idx = tid; idx < 2 * 3 * 128; idx += NTHREADS) { const int dir = idx / 384, w = (idx / 128) % 3, c = idx & 127; const float* src = w == 0 ? ba : w == 1 ? bx : SP; cst[idx] = src[dir * 1024 + n * 128 + c] * (w == 2 ? -8.0f * 1.4426950408889634f : -1.4426950408889634f); }
    __syncthreads();
    const int tiles_per_b = MODE == 1 ? LRU_TILES : 64, nq = 16 * tiles_per_b, stride = (G >> 3) * NWAVES;
    for (int q = (blockIdx.x >> 3) * NWAVES + wave; q < nq; q += stride) {
        const int b = q / tiles_per_b, tile = MODE == 1 ? q % tiles_per_b : 8 + q % tiles_per_b;
        const size_t rowbase = tile < 8 ? (size_t)(TL + b * CTXL) : (size_t)b * SEQ; const int L = tile < 8 ? CTXL : SEQ, s0 = tile < 8 ? tile * 32 : (tile - 8) * 32;
        bf16x8 afr[8];
        if (MODE == 1) lru_conv_frags(LX, conv_w, conv_b, rowbase, L, s0, n, lane, afr, XC);
        else {
#pragma unroll
            for (int ks = 0; ks < 8; ++ks) afr[ks] = *(const bf16x8*)(XC + (abl == 4 ? (size_t)ql * 1024 : (rowbase + s0 + ql) * 1024 + n * 128) + 16 * ks + 8 * hl); }
#pragma unroll 1
        for (int cg = 0; cg < 4; ++cg) {
            const bf16x8 ax0 = cg == 0 ? afr[0] : cg == 1 ? afr[2] : cg == 2 ? afr[4] : afr[6], ax1 = cg == 0 ? afr[1] : cg == 1 ? afr[3] : cg == 2 ? afr[5] : afr[7];
            const int cl = cg * 32 + ql;
            float hinf = 0.f, hinb = 0.f;
            if (MODE == 2) { hinf = AGG[((size_t)b * LRU_TILES + tile) * 1024 + n * 128 + cl].x; hinb = AGG[((size_t)(16 + b) * LRU_TILES + tile) * 1024 + n * 128 + cl].x; }
            unsigned short gq[16];
            f32x16 xv;
#pragma unroll
            for (int i = 0; i < 16; ++i) xv[i] = 0.f;
            { bf16x8 idf[2];
#pragma unroll
              for (int kk = 0; kk < 2; ++kk)
#pragma unroll
                  for (int j = 0; j < 8; ++j) idf[kk][j] = (16 * kk + 8 * hl + j == ql) ? (short)0x3F80 : (short)0;
              xv = __builtin_amdgcn_mfma_f32_32x32x16_bf16(ax0, idf[0], xv, 0, 0, 0); xv = __builtin_amdgcn_mfma_f32_32x32x16_bf16(ax1, idf[1], xv, 0, 0, 0); }
            float hsum[16];
#pragma unroll
            for (int dir = 0; dir < 2; ++dir) {
                const LAS unsigned char* wr = lds + (dir * 256 + cl) * 256; const LAS unsigned char* wi = wr + 128 * 256;
                f32x16 accr, acci;
#pragma unroll
                for (int i = 0; i < 16; ++i) { accr[i] = 0.f; acci[i] = 0.f; }
                if (abl != 2) { bf16x8 bw[8];
#pragma unroll
                  for (int k = 0; k < 8; ++k) bw[k] = *(const LAS bf16x8*)(wr + (((2 * k + hl) ^ (cl & 15)) * 16));
#pragma unroll
                  for (int k = 0; k < 8; ++k) accr = __builtin_amdgcn_mfma_f32_32x32x16_bf16(afr[k], bw[k], accr, 0, 0, 0);
                  __builtin_amdgcn_sched_barrier(0);
#pragma unroll
                  for (int k = 0; k < 8; ++k) bw[k] = *(const LAS bf16x8*)(wi + (((2 * k + hl) ^ (cl & 15)) * 16));
#pragma unroll
                  for (int k = 0; k < 8; ++k) acci = __builtin_amdgcn_mfma_f32_32x32x16_bf16(afr[k], bw[k], acci, 0, 0, 0); }
                __builtin_amdgcn_sched_barrier(0);
                const float bav = cst[dir * 384 + cl], bxv = cst[dir * 384 + 128 + cl], sp = cst[dir * 384 + 256 + cl];
                const float hin0 = dir == 0 ? hinf : hinb;
                if (MODE == 2 && dir == 1 && abl != 3) {
#pragma unroll
                    for (int i = 0; i < 16; ++i) gq[i] = LG[(rowbase + s0 + (i & 3) + 8 * (i >> 2) + 4 * hl) * 1024 + n * 128 + cl]; }
                float hout[16], At, Ht;
                if (abl == 1) { _Pragma("unroll") for (int i = 0; i < 16; ++i) hout[i] = accr[i] + acci[i] * xv[i] + hin0 + bav + bxv + sp; At = 1.f; Ht = 0.f; }
                else if (dir == 0) lru_group_dir<0>(accr, acci, xv, bav, bxv, sp, hin0, hl, hout, At, Ht);
                else lru_group_dir<1>(accr, acci, xv, bav, bxv, sp, hin0, hl, hout, At, Ht);
                if (MODE == 1) { if (hl == 0) AGG[((size_t)(dir * 16 + b) * LRU_TILES + tile) * 1024 + n * 128 + cl] = (f32x2){At, Ht}; }
                else {
#pragma unroll
                    for (int i = 0; i < 16; ++i) hsum[i] = dir == 0 ? hout[i] : hsum[i] + hout[i]; }
            }
            if (MODE == 2) {
                if (abl == 3) { float t_ = 0.f; _Pragma("unroll") for (int i = 0; i < 16; ++i) t_ += hsum[i]; if (t_ == 123.456f) OL[0] = 0; }
                else {
#pragma unroll
                for (int i = 0; i < 16; ++i) OL[(rowbase + s0 + (i & 3) + 8 * (i >> 2) + 4 * hl) * 1024 + n * 128 + cl] = (bf16_t)f2bf(hsum[i] * bf2f(gq[i]));
                }
            }
        }
    }
}
__device__ __forceinline__ void p_lru_carry(f32x2* AGG, int tid) {
    const int gid = blockIdx.x * NTHREADS + tid;
    if (gid >= 2 * 16 * 1024) return;
    const int dir = gid >> 14, b = (gid >> 10) & 15, ch = gid & 1023;
    f32x2* base = AGG + (size_t)(dir * 16 + b) * LRU_TILES * 1024 + ch;
    float h = 0.f;
#pragma unroll 1
    for (int s0 = 0; s0 < LRU_TILES; s0 += 24) {
        f32x2 v[24];
#pragma unroll
        for (int s = 0; s < 24; ++s) { const int st = s0 + s, tile = dir == 0 ? st : (st < 8 ? 7 - st : 79 - st); v[s] = base[(size_t)tile * 1024]; }
#pragma unroll
        for (int s = 0; s < 24; ++s) { const int st = s0 + s, tile = dir == 0 ? st : (st < 8 ? 7 - st : 79 - st); base[(size_t)tile * 1024].x = h; h = v[s].x * h + v[s].y; }
    }
}

__device__ __forceinline__ unsigned char* lds_ptr(LAS unsigned char* ldsl, int i) {
    const LAS unsigned* t = (const LAS unsigned*)(ldsl + MISC_OFF + 1024) + 2 * i;
    const unsigned lo = __builtin_amdgcn_readfirstlane(t[0]), hi = __builtin_amdgcn_readfirstlane(t[1]);
    return (unsigned char*)(__attribute__((address_space(1))) unsigned char*)(((unsigned long long)hi << 32) | lo);
}
struct MArgs { const float* in[28]; float* out; unsigned char* ws; int ph_lo, ph_hi, li, extra; };
__global__ void __launch_bounds__(NTHREADS, 2) mega(MArgs a) {
    extern __shared__ __attribute__((aligned(16))) unsigned char lds[];
    const int wave = __builtin_amdgcn_readfirstlane(threadIdx.x >> 6);
#define LANE ((int)__builtin_amdgcn_mbcnt_hi(~0u, __builtin_amdgcn_mbcnt_lo(~0u, 0u)))
#define TID (wave * 64 + LANE)
    const int G = gridDim.x, gw = blockIdx.x * NWAVES + wave, ngw = G * NWAVES;
    LAS unsigned char* ldsl = (LAS unsigned char*)lds;
    volatile LAS unsigned* MISC = (volatile LAS unsigned*)(ldsl + MISC_OFF);
    for (int u = TID; u < (LDS_BYTES - MISC_OFF) / 4; u += NTHREADS) ((LAS unsigned*)(ldsl + MISC_OFF))[u] = 0u;
    __syncthreads();
    { LAS unsigned long long* pt = (LAS unsigned long long*)(ldsl + MISC_OFF + 1024);
      const int tid = TID;
      if (tid < 28) pt[tid] = (unsigned long long)a.in[tid];
      if (tid == 28) pt[28] = (unsigned long long)(a.extra ? (float*)(a.ws + WS_XB) : a.out);
      if (tid == 29) pt[29] = (unsigned long long)a.ws; }
    XcdBarrier bar = xcd_barrier_post((unsigned*)(a.ws + WS_CTL) + CW_BAR + a.li * XCD_BAR_WORDS, MISC + 8, wave == 0 && LANE == 0);
    const int lo = a.ph_lo, hi = a.ph_hi, extra = a.extra;
    __syncthreads();
#define PTR(i) ((const float*)lds_ptr(ldsl, (i)))
#define OUTP ((float*)lds_ptr(ldsl, 28))
#define WSP(off) (lds_ptr(ldsl, 29) + (off))
#define IN(k) (lo <= (k) && (k) < hi)
#define SEAM(k) do { if (IN(k) && IN((k) + 1)) xcd_barrier(bar, wave); } while (0)
    if (IN(0)) { unsigned char* ws = WSP(0); p0_prep(ws, ldsl, gw, ngw, LANE, wave); __syncthreads();
        p0_mod(PTR(1), PTR(3), PTR(4), PTR(5), PTR(20), PTR(22), (f32x4*)(ws + WS_MOD + 600 * 1024), PTR(16), (float*)(ws + WS_MOD + 760 * 1024), (float*)(ws + WS_MOD), (f32x2*)(ws + WS_MOD + 512 * 1024), (LAS float*)ldsl, TID); }
    SEAM(0);
    if (IN(1)) { unsigned char* ws = WSP(0); p1_router_tables(PTR(7), (const float*)(ws + WS_MOD), (const f32x4*)(ws + WS_MOD + 600 * 1024), PTR(21), PTR(23), (float*)(ws + WS_RWT), (float*)(ws + WS_RWT + 3 * MiB), gw, ngw, LANE);
        p1_adanorm(PTR(0), PTR(2), PTR(6), (const float*)(ws + WS_MOD), (bf16_t*)OUTP, gw, ngw, LANE); }
    SEAM(1);
    if (IN(2)) { unsigned char* ws = WSP(0); pg8::Gemm g{(const bf16_t*)OUTP, (const bf16_t*)(ws + WS_WIN), TALL, PROJ, 1024}; ProjOrder S; S.init(G, (int)blockIdx.x);
        EpiF<EpiProj> E{{(bf16_t*)(ws + WS_K), (bf16_t*)(ws + WS_V), (bf16_t*)(ws + WS_LX), (bf16_t*)(ws + WS_Q), (bf16_t*)(ws + WS_LG), ws + WS_GA, ws + WS_GB, (const f32x2*)(ws + WS_MOD + 512 * 1024)}};
        pg8::gemm_phase<EpiF<EpiProj>, ProjOrder, true, true>(ldsl, g, S, E, wave); }
    SEAM(2);
    if (IN(3)) { unsigned char* ws = WSP(0); bf16_t* LGb = (bf16_t*)(ws + WS_LG);
        p_lru<1>((const bf16_t*)(ws + WS_LX), (const bf16_t*)(ws + WS_LW), PTR(10), PTR(11), PTR(13), PTR(15), (const float*)(ws + WS_MOD + 760 * 1024), (f32x2*)OUTP, (bf16_t*)((unsigned char*)OUTP + 24 * MiB), LGb, LGb, ldsl, wave, LANE);
        __syncthreads(); }
    if (IN(3) || extra == 2) { unsigned char* ws = WSP(0); bf16_t* Qb = (bf16_t*)(ws + WS_Q);
        p3_attn(Qb, Qb, (const bf16_t*)(ws + WS_K), (const bf16_t*)(ws + WS_V), PTR(9), (const f32x2*)(ws + WS_MOD + 512 * 1024), ldsl, wave, LANE); }
    SEAM(3);
    if (IN(4)) p_lru_carry((f32x2*)OUTP, TID);
    if (IN(4)) { unsigned char* ws = WSP(0); pg8::Gemm g{(const bf16_t*)(ws + WS_Q), (const bf16_t*)(ws + WS_WA), TL, 1024, 512}; pg8::StaticOrder S; S.init(TL, 1024, G, (int)blockIdx.x); EpiF2<EpiUpAttn> E{{ws + WS_GA, (bf16_t*)(ws + WS_Y)}};
        pg8::gemm_phase<EpiF2<EpiUpAttn>, pg8::StaticOrder, true, true>(ldsl, g, S, E, wave); }
    SEAM(4);
    if (IN(5)) { unsigned char* ws = WSP(0); bf16_t* LGb = (bf16_t*)(ws + WS_LG);
        p_lru<2>((const bf16_t*)(ws + WS_LX), (const bf16_t*)(ws + WS_LW), PTR(10), PTR(11), PTR(13), PTR(15), (const float*)(ws + WS_MOD + 760 * 1024), (f32x2*)OUTP, (bf16_t*)((unsigned char*)OUTP + 24 * MiB), LGb, LGb, ldsl, wave, LANE); }
    SEAM(5);
    if (IN(6)) { unsigned char* ws = WSP(0); bf16_t* Yb = (bf16_t*)(ws + WS_Y); pg8::Gemm g{(const bf16_t*)(ws + WS_LG), (const bf16_t*)(ws + WS_WL), TL, 1024, 1024}; pg8::StaticOrder S; S.init(TL, 1024, G, (int)blockIdx.x);
        EpiF2<EpiUpLru> E{{Yb, ws + WS_GB, Yb}};
        pg8::gemm_phase<EpiF2<EpiUpLru>, pg8::StaticOrder, true, true>(ldsl, g, S, E, wave); }
    SEAM(6);
    if (IN(7)) { unsigned char* ws = WSP(0); pg8::Gemm g{(const bf16_t*)(ws + WS_Y), (const bf16_t*)(ws + WS_WO), TL, 1024, 1024}; pg8::StaticOrder S; S.init(TL, 1024, G, (int)blockIdx.x);
        EpiF2<EpiOut> E{{PTR(0), (const float*)(ws + WS_MOD), (bf16_t*)(ws + WS_X1B)}};
        pg8::gemm_phase<EpiF2<EpiOut>, pg8::StaticOrder, true, true>(ldsl, g, S, E, wave); }
    SEAM(7);
    if (IN(8)) { unsigned char* ws = WSP(0);
        p8_route((const bf16_t*)(ws + WS_X1B), (const float*)(ws + WS_RWT), (const float*)(ws + WS_RWT + 3 * MiB), (unsigned*)(ws + WS_CTL), (int*)(ws + WS_TOK), ldsl, LANE, TID, wave); }
    SEAM(8);
    if (IN(9)) { unsigned char* ws = WSP(0); p9_scatter((const bf16_t*)(ws + WS_X1B), PTR(7), (const float*)(ws + WS_MOD), (unsigned*)(ws + WS_CTL), (int*)(ws + WS_TOK), (bf16_t*)(ws + WS_XB), (LAS unsigned*)ldsl, gw, ngw, LANE, TID); }
    SEAM(9);
    if (IN(10)) { unsigned char* ws = WSP(0); pg8::Gemm g{(const bf16_t*)(ws + WS_XB), (const bf16_t*)(ws + WS_W13), MOE_ROWS, 1024, 1024}; MoeOrder S; S.init((const unsigned*)(ws + WS_CTL), G, (int)blockIdx.x, (size_t)1024 * 1024 * 2);
        EpiF<EpiMoe1> E{{(bf16_t*)OUTP}};
        pg8::gemm_phase<EpiF<EpiMoe1>, MoeOrder, true, true>(ldsl, g, S, E, wave); }
    SEAM(10);
    if (IN(11)) { unsigned char* ws = WSP(0); pg8::Gemm g{(const bf16_t*)OUTP, (const bf16_t*)(ws + WS_W2), MOE_ROWS, 1024, 512}; MoeOrder S; S.init((const unsigned*)(ws + WS_CTL), G, (int)blockIdx.x, (size_t)1024 * 512 * 2);
        EpiF<EpiMoe2> E{{(bf16_t*)(ws + WS_YB)}};
        pg8::gemm_phase<EpiF<EpiMoe2>, MoeOrder, true, true>(ldsl, g, S, E, wave); }
    SEAM(11);
    if (IN(12)) { unsigned char* ws = WSP(0); p12_final((const bf16_t*)(ws + WS_X1B), OUTP, (const float*)(ws + WS_MOD), (const int*)(ws + WS_TOK), (const bf16_t*)(ws + WS_YB), PTR(27), gw, ngw, LANE); }
#undef PTR
#undef OUTP
#undef WSP
#undef LANE
#undef TID
#undef IN
#undef SEAM
}

extern "C" void kernel_launch(void* const* d_in, const int* in_sizes, int n_in, void* d_out, int out_size, void* d_ws, size_t ws_size, hipStream_t stream) {
    static int grid = 0;
    if (grid == 0) {
        if (n_in != 28 || out_size != TL * D || ws_size < WS_END) { fprintf(stderr, "kernel_launch: unexpected problem (n_in %d, out %d, ws %zu < %zu)\n", n_in, out_size, ws_size, (size_t)WS_END); grid = -1; return; }
        int dev = 0, cus = 0, per_cu = 0;
        if (hipGetDevice(&dev) != hipSuccess || hipDeviceGetAttribute(&cus, hipDeviceAttributeMultiprocessorCount, dev) != hipSuccess) { grid = -1; return; }
        if (hipFuncSetAttribute((const void*)mega, hipFuncAttributeMaxDynamicSharedMemorySize, LDS_BYTES) != hipSuccess) { fprintf(stderr, "kernel_launch: hipFuncSetAttribute failed\n"); grid = -1; return; }
        if (hipOccupancyMaxActiveBlocksPerMultiprocessor(&per_cu, (const void*)mega, NTHREADS, LDS_BYTES) != hipSuccess || per_cu < 1) { fprintf(stderr, "kernel_launch: occupancy query says %d blocks per CU\n", per_cu); grid = -1; return; }
        (void)hipGetLastError();
        grid = cus;
    }
    if (grid < 0) return;
    const float* const* in = (const float* const*)d_in;
    unsigned char* ws = (unsigned char*)d_ws; float* out = (float*)d_out;
    (void)hipMemsetAsync(ws + WS_CTL, 0, CTL_ZERO_BYTES, stream);
    MArgs a{};
    for (int i = 0; i < 28; ++i) a.in[i] = in[i];
    a.out = out; a.ws = ws;
    auto launch = [&](int lo, int hi, int li, int extra) {
        a.ph_lo = lo; a.ph_hi = hi; a.li = li; a.extra = extra; void* args[] = {&a};
        const hipError_t e = hipLaunchCooperativeKernel((const void*)mega, dim3(grid), dim3(NTHREADS), args, LDS_BYTES, stream);
        if (e != hipSuccess) fprintf(stderr, "kernel_launch: cooperative launch failed: %s (grid %d)\n", hipGetErrorString(e), grid);
    };
    launch(0, 13, 0, 0);
    EXTRA_LAUNCHES
}
```

```cpp
#include <hip/hip_runtime.h>
#include <cstdio>
#include <cstdint>

typedef float f32x2 __attribute__((ext_vector_type(2)));
typedef unsigned u32x2 __attribute__((ext_vector_type(2)));
#define EXTRA_LAUNCHES
namespace pg8 {
#define PG8_LAS __attribute__((address_space(3)))
typedef unsigned short bf16_t;
typedef short bf16x8 __attribute__((ext_vector_type(8)));
typedef float f32x4 __attribute__((ext_vector_type(4)));
typedef unsigned u32x4 __attribute__((ext_vector_type(4)));
constexpr int BM = 256, BK = 64, HALF = 128, HTB = HALF * BK * 2  , STAGE_BYTES = 8 * HTB, NXCD = 8, WGM = 8;

__host__ __device__ __forceinline__ int lds_byte(int r, int c) { const int st = (r >> 4) * 2 + (c >> 5), rr = r & 15, cc = c & 31, ob = rr * 64 + cc * 2; return st * 1024 + (ob ^ (((ob >> 9) & 1) << 5)); }
__host__ __device__ __forceinline__ void stage_rc(int b, int& R, int& C) { const int st = b / 1024, sb = b % 1024, swz = sb ^ (((sb >> 9) & 1) << 5); R = (st >> 1) * 16 + swz / 64; C = (st & 1) * 32 + (swz % 64) / 2; }
__host__ __device__ __forceinline__ int perm32(int rho) { const int n = rho >> 4, i = rho & 15; return 8 * (i >> 2) + 4 * n + (i & 3); }

struct Unit { int pm, pn; size_t bofs; };
struct Gemm { const bf16_t* A; const bf16_t* Bt; int M, N, K; };

struct StaticOrder {
    int nM, nN, nwg, G, c;
    __host__ __device__ __forceinline__ void init(int M, int N, int G_, int c_) { nM = M / BM; nN = N / BM; nwg = nM * nN; G = G_; c = c_; }
    __host__ __device__ __forceinline__ bool next(int i, Unit& u) const {
        const long L = (long)i * G + c; if (L >= nwg) return false;
        int wgid = (int)L; { const int q = nwg / NXCD, r = nwg % NXCD, xcd = wgid % NXCD, off = wgid / NXCD; wgid = (xcd < r ? xcd * (q + 1) : r * (q + 1) + (xcd - r) * q) + off; }
        const int nig = WGM * nN, gid = wgid / nig, fm = gid * WGM, gsz = (nM - fm) < WGM ? (nM - fm) : WGM;
        u.pm = fm + ((wgid % nig) % gsz); u.pn = (wgid % nig) / gsz; u.bofs = 0; return true;
    }
    __device__ __forceinline__ void a_ready(const Unit&) const {}
    __device__ __forceinline__ void done(const Unit&) const {}
};


template <class Epi, class Sched, bool ALIGN_EPI = false, bool SP2 = false>
__device__ __forceinline__ void gemm_phase(PG8_LAS unsigned char* lds, const Gemm g, const Sched& S, const Epi& E, int wid) {
    const int lane = (int)__builtin_amdgcn_mbcnt_hi(~0u, __builtin_amdgcn_mbcnt_lo(~0u, 0u)), tid = wid * 64 + lane, wr = wid >> 2, wc = wid & 3, fr = lane & 15, fq = lane >> 4;
    const int K = g.K, nt = K / BK;
    unsigned voffA[2], voffB[2];
#pragma unroll
    for (int i = 0; i < 2; ++i) { int R, C; stage_rc(tid * 16 + i * 8192, R, C); const int Rb = Epi::PERM ? ((R & ~31) + perm32(R & 31)) : R;
        voffA[i] = (unsigned)(R * K + C) * 2u; voffB[i] = (unsigned)(Rb * K + C) * 2u; }
    const size_t kstep = (size_t)(BK * 2);
    const size_t hstep = (size_t)HALF * K * 2;
    const size_t tstep = 2 * hstep;
    const unsigned ldsw = (unsigned)wid * 1024u;
    const int aoff = lds_byte(wr * 64 + fr, fq * 8), boff = lds_byte(wc * 32 + fr, fq * 8);
#define PG8_SA(b, h) (((b) * 2 + (h)) * HTB)
#define PG8_SB(b, h) ((4 + (b) * 2 + (h)) * HTB)
#define PG8_STAGE(bufoff, gbase, voff) do { _Pragma("unroll") for (int _i = 0; _i < 2; ++_i) \
        __builtin_amdgcn_global_load_lds((const unsigned*)((const char*)(gbase) + (voff)[_i]), (PG8_LAS unsigned*)(lds + (bufoff) + ldsw + _i * 8192), 16, 0, 0); } while (0)
#define PG8_LDA(dst, b, h) do { _Pragma("unroll") for (int m = 0; m < 4; ++m) _Pragma("unroll") for (int k = 0; k < 2; ++k) dst[m][k] = *(const PG8_LAS bf16x8*)(lds + PG8_SA(b, h) + aoff + m * 2048 + k * 1024); } while (0)
#define PG8_LDB(dst, b, h) do { _Pragma("unroll") for (int n = 0; n < 2; ++n) _Pragma("unroll") for (int k = 0; k < 2; ++k) dst[n][k] = *(const PG8_LAS bf16x8*)(lds + PG8_SB(b, h) + boff + n * 2048 + k * 1024); } while (0)
#define PG8_MMA(ai, bj, At, Bt) do { __builtin_amdgcn_s_setprio(1); _Pragma("unroll") for (int m = 0; m < 4; ++m) _Pragma("unroll") for (int n = 0; n < 2; ++n) _Pragma("unroll") for (int k = 0; k < 2; ++k) \
        acc[ai][bj][m][n] = __builtin_amdgcn_mfma_f32_16x16x32_bf16(Bt[n][k], At[m][k], acc[ai][bj][m][n], 0, 0, 0); __builtin_amdgcn_s_setprio(0); } while (0)
#define PG8_WAIT_V(n) asm volatile("s_waitcnt vmcnt(" #n ")" ::: "memory")
#define PG8_WAIT_L(n) asm volatile("s_waitcnt lgkmcnt(" #n ")" ::: "memory")
#define PG8_BAR __builtin_amdgcn_s_barrier()
#define PG8_SCHED __builtin_amdgcn_sched_barrier(0)
    Unit cur, nxt; int ui = 0;
    if (!S.next(0, cur)) return;
    f32x4 acc[2][2][4][2];
#pragma unroll
    for (int a = 0; a < 2; ++a)
#pragma unroll
        for (int b = 0; b < 2; ++b)
#pragma unroll
            for (int m = 0; m < 4; ++m)
#pragma unroll
                for (int n = 0; n < 2; ++n) acc[a][b][m][n] = (f32x4){0.f, 0.f, 0.f, 0.f};
    bf16x8 At[4][2], B0[2][2], B1[2][2];
    const char* cA = (const char*)g.A + (size_t)cur.pm * tstep; const char* cB = (const char*)g.Bt + (size_t)cur.pn * tstep + cur.bofs;
    S.a_ready(cur);
    if constexpr (SP2) {
        PG8_STAGE(PG8_SB(0, 0), cB, voffB); PG8_STAGE(PG8_SB(0, 1), cB + hstep, voffB); PG8_STAGE(PG8_SA(0, 0), cA, voffA); PG8_STAGE(PG8_SA(0, 1), cA + hstep, voffA);
        if (wr == 1) PG8_BAR;
        PG8_WAIT_V(2); PG8_BAR;
        PG8_STAGE(PG8_SB(1, 0), cB + kstep, voffB); PG8_STAGE(PG8_SA(1, 0), cA + kstep, voffA); PG8_STAGE(PG8_SB(1, 1), cB + hstep + kstep, voffB);
        PG8_WAIT_V(6); PG8_BAR;
    } else {
        PG8_STAGE(PG8_SB(0, 0), cB, voffB); PG8_STAGE(PG8_SA(0, 0), cA, voffA); PG8_STAGE(PG8_SB(0, 1), cB + hstep, voffB); PG8_STAGE(PG8_SA(0, 1), cA + hstep, voffA);
        if (wr == 1) PG8_BAR;
        PG8_WAIT_V(4); PG8_BAR;
        PG8_STAGE(PG8_SB(1, 0), cB + kstep, voffB); PG8_STAGE(PG8_SA(1, 0), cA + kstep, voffA); PG8_STAGE(PG8_SB(1, 1), cB + hstep + kstep, voffB);
        PG8_WAIT_V(6); PG8_BAR;
    }
    for (;;) {
        const bool has_next = S.next(ui + 1, nxt);
        const char* nA = has_next ? (const char*)g.A + (size_t)nxt.pm * tstep : cA; const char* nB = has_next ? (const char*)g.Bt + (size_t)nxt.pn * tstep + nxt.bofs : cB;
        for (int t = 0; t < nt; t += 2) {
            const bool last = (t == nt - 2);
            const char* a1 = cA + (size_t)(t + 1) * kstep;
            const char* a2 = last ? nA : cA + (size_t)(t + 2) * kstep; const char* b2 = last ? nB : cB + (size_t)(t + 2) * kstep;
            const char* a3 = a2 + kstep; const char* b3 = b2 + kstep;
            if (last && has_next) S.a_ready(nxt);
            if constexpr (SP2) {
            PG8_LDB(B0, 0, 0); PG8_LDB(B1, 0, 1); PG8_SCHED; PG8_LDA(At, 0, 0); PG8_STAGE(PG8_SA(1, 1), a1 + hstep, voffA);
            PG8_WAIT_V(8); PG8_WAIT_L(0); PG8_BAR; PG8_MMA(0, 0, At, B0); PG8_MMA(0, 1, At, B1); PG8_BAR; PG8_SCHED;
            PG8_LDA(At, 0, 1); PG8_STAGE(PG8_SB(0, 0), b2, voffB); PG8_STAGE(PG8_SB(0, 1), b2 + hstep, voffB); PG8_STAGE(PG8_SA(0, 0), a2, voffA);
            PG8_WAIT_V(8); PG8_WAIT_L(0); PG8_BAR; PG8_MMA(1, 0, At, B0); PG8_MMA(1, 1, At, B1); PG8_BAR; PG8_SCHED;
            PG8_LDB(B0, 1, 0); PG8_LDB(B1, 1, 1); PG8_SCHED; PG8_LDA(At, 1, 0); PG8_STAGE(PG8_SA(0, 1), a2 + hstep, voffA);
            PG8_WAIT_V(8); PG8_WAIT_L(0); PG8_BAR; PG8_MMA(0, 0, At, B0); PG8_MMA(0, 1, At, B1); PG8_BAR; PG8_SCHED;
            PG8_LDA(At, 1, 1); PG8_STAGE(PG8_SB(1, 0), b3, voffB); PG8_STAGE(PG8_SB(1, 1), b3 + hstep, voffB); PG8_STAGE(PG8_SA(1, 0), a3, voffA);
            PG8_WAIT_V(8); PG8_WAIT_L(0); PG8_BAR; PG8_MMA(1, 0, At, B0); PG8_MMA(1, 1, At, B1); PG8_BAR; PG8_SCHED;
            } else {
            PG8_LDB(B0, 0, 0); PG8_SCHED; PG8_LDA(At, 0, 0); PG8_STAGE(PG8_SA(1, 1), a1 + hstep, voffA);
            PG8_WAIT_L(8); PG8_BAR; PG8_WAIT_L(0); PG8_MMA(0, 0, At, B0); PG8_BAR; PG8_SCHED;
            PG8_LDB(B1, 0, 1); PG8_STAGE(PG8_SB(0, 0), b2, voffB);
            PG8_BAR; PG8_WAIT_L(0); PG8_MMA(0, 1, At, B1); PG8_BAR;
            PG8_LDA(At, 0, 1); PG8_STAGE(PG8_SA(0, 0), a2, voffA);
            PG8_BAR; PG8_WAIT_L(0); PG8_MMA(1, 0, At, B0); PG8_BAR; PG8_SCHED;
            PG8_STAGE(PG8_SB(0, 1), b2 + hstep, voffB);
            PG8_WAIT_V(6); PG8_BAR; PG8_MMA(1, 1, At, B1); PG8_BAR;
            PG8_LDB(B0, 1, 0); PG8_SCHED; PG8_LDA(At, 1, 0); PG8_STAGE(PG8_SA(0, 1), a2 + hstep, voffA);
            PG8_WAIT_L(8); PG8_BAR; PG8_WAIT_L(0); PG8_MMA(0, 0, At, B0); PG8_BAR; PG8_SCHED;
            PG8_LDB(B1, 1, 1); PG8_STAGE(PG8_SB(1, 0), b3, voffB);
            PG8_BAR; PG8_WAIT_L(0); PG8_MMA(0, 1, At, B1); PG8_BAR;
            PG8_LDA(At, 1, 1); PG8_STAGE(PG8_SA(1, 0), a3, voffA);
            PG8_BAR; PG8_WAIT_L(0); PG8_MMA(1, 0, At, B0); PG8_BAR; PG8_SCHED;
            PG8_STAGE(PG8_SB(1, 1), b3 + hstep, voffB);
            PG8_WAIT_V(6); PG8_BAR; PG8_MMA(1, 1, At, B1); PG8_BAR;
            }
        }
        if constexpr (ALIGN_EPI) { if (wr == 0) PG8_BAR; }
        if constexpr (!Epi::AFTER_DRAIN) { E(acc, cur, wr, wc, fr, fq); S.done(cur); }
        if (!has_next) break;
#pragma unroll
        for (int a = 0; a < 2; ++a)
#pragma unroll
            for (int b = 0; b < 2; ++b)
#pragma unroll
                for (int m = 0; m < 4; ++m)
#pragma unroll
                    for (int n = 0; n < 2; ++n) acc[a][b][m][n] = (f32x4){0.f, 0.f, 0.f, 0.f};
        cur = nxt; cA = nA; cB = nB; ++ui;
        if constexpr (ALIGN_EPI) { if (wr == 1) PG8_BAR; }
    }
    PG8_WAIT_V(0);
    if constexpr (!ALIGN_EPI) { if (wr == 0) PG8_BAR; }
    PG8_BAR;
    if constexpr (Epi::AFTER_DRAIN) { E.fused(acc, cur, wr, wc, fr, fq, lds, wid, lane); S.done(cur); }
#undef PG8_SA
#undef PG8_SB
#undef PG8_STAGE
#undef PG8_LDA
#undef PG8_LDB
#undef PG8_MMA
#undef PG8_WAIT_V
#undef PG8_WAIT_L
#undef PG8_BAR
#undef PG8_SCHED
}
}
using pg8::bf16_t; using pg8::f32x4; using pg8::u32x4;
#define LAS __attribute__((address_space(3)))

constexpr int D = 1024, NBATCH = 16, SEQ = 2048, CTXL = 256;
constexpr int TL = NBATCH * SEQ;
constexpr int TC = NBATCH * CTXL;
constexpr int TALL = TL + TC;
constexpr int PROJ = 5632;
constexpr int NEXP = 32, DEXP = 512;
constexpr int MOE_ROWS = 288 * 256;
constexpr float EPS = 1e-6f;
constexpr int NWAVES = 8, NTHREADS = 512;

constexpr size_t MiB = 1u << 20;
constexpr size_t WS_CTL = 0;
constexpr size_t CTL_ZERO_BYTES = 256 * 1024;
constexpr size_t WS_MOD = 1 * MiB;
constexpr size_t WS_TOK = 2 * MiB;
constexpr size_t WS_RWT = 3 * MiB;
constexpr size_t WS_WIN = 13 * MiB;
constexpr size_t WS_WA = 24 * MiB;
constexpr size_t WS_WL = 25 * MiB;
constexpr size_t WS_WO = 27 * MiB;
constexpr size_t WS_LW = 29 * MiB;
constexpr size_t WS_W13 = 30 * MiB;
constexpr size_t WS_W2 = 94 * MiB;
constexpr size_t WS_K = 126 * MiB;
constexpr size_t WS_V = 162 * MiB;
constexpr size_t WS_LX = 198 * MiB;
constexpr size_t WS_XB = WS_K;
constexpr size_t WS_Q = 270 * MiB;
constexpr size_t WS_LG = 302 * MiB;
constexpr size_t WS_H2 = WS_Q;
constexpr size_t WS_X1B = WS_LG;
constexpr size_t WS_GA = 366 * MiB;
constexpr size_t WS_GB = 398 * MiB;
constexpr size_t WS_Y = 430 * MiB;
constexpr size_t WS_YB = WS_GA;
constexpr size_t WS_END = 510 * MiB;
constexpr int CW_COUNT = 0, CW_CURSOR = 64, CW_NBLK = 128, CW_BLKE = 192;
constexpr int CW_BCNT = 16384;
constexpr int CW_BAR = 1024;

constexpr int RING_BYTES = 131072;
constexpr int MISC_OFF = 147456;
constexpr int LDS_BYTES = 163840;

__device__ __forceinline__ unsigned f2bf(float f) { unsigned u = __float_as_uint(f); return (u + 0x7fffu + ((u >> 16) & 1u)) >> 16; }
__device__ __forceinline__ float bf2f(unsigned h) { return __uint_as_float(h << 16); }
typedef __bf16 bf16x2_t __attribute__((ext_vector_type(2)));
__device__ __forceinline__ unsigned pk2(float lo, float hi) { const f32x2 v = {lo, hi}; const bf16x2_t b = __builtin_convertvector(v, bf16x2_t); return __builtin_bit_cast(unsigned, b); }
__device__ __forceinline__ float bflo(unsigned w) { return __uint_as_float(w << 16); }
__device__ __forceinline__ float bfhi(unsigned w) { return __uint_as_float(w & 0xffff0000u); }
__device__ __forceinline__ void unpack8(u32x4 w, float (&v)[8]) { v[0] = bflo(w.x); v[1] = bfhi(w.x); v[2] = bflo(w.y); v[3] = bfhi(w.y); v[4] = bflo(w.z); v[5] = bfhi(w.z); v[6] = bflo(w.w); v[7] = bfhi(w.w); }
__device__ __forceinline__ u32x4 pack8(const float (&v)[8]) { u32x4 w; w.x = pk2(v[0], v[1]); w.y = pk2(v[2], v[3]); w.z = pk2(v[4], v[5]); w.w = pk2(v[6], v[7]); return w; }
__device__ __forceinline__ unsigned q8(float v) { return (unsigned)(v * 255.0f + 0.5f); }
__device__ __forceinline__ u32x2 packq8(const float (&v)[8]) { u32x2 w; w.x = q8(v[0]) | (q8(v[1]) << 8) | (q8(v[2]) << 16) | (q8(v[3]) << 24); w.y = q8(v[4]) | (q8(v[5]) << 8) | (q8(v[6]) << 16) | (q8(v[7]) << 24); return w; }
__device__ __forceinline__ void unpackq8(u32x2 w, float (&v)[8]) { const float s = 1.0f / 255.0f;
    v[0] = (float)(w.x & 255u) * s; v[1] = (float)((w.x >> 8) & 255u) * s; v[2] = (float)((w.x >> 16) & 255u) * s; v[3] = (float)(w.x >> 24) * s;
    v[4] = (float)(w.y & 255u) * s; v[5] = (float)((w.y >> 8) & 255u) * s; v[6] = (float)((w.y >> 16) & 255u) * s; v[7] = (float)(w.y >> 24) * s; }
__device__ __forceinline__ float fast_exp(float x) { return __builtin_amdgcn_exp2f(x * 1.4426950408889634f); }
__device__ __forceinline__ float sigmoid_fast(float x) { return __builtin_amdgcn_rcpf(1.0f + fast_exp(-x)); }
__device__ __forceinline__ float silu_fast(float x) { return x * sigmoid_fast(x); }
__device__ __forceinline__ float gelu_tanh_fast(float x) { const float u2 = 1.5957691216057308f * (x + 0.044715f * x * x * x); return x * sigmoid_fast(u2); }
__device__ __forceinline__ float sigmoidf_(float x) { return 1.0f / (1.0f + expf(-x)); }
__device__ __forceinline__ float siluf_(float x) { return x / (1.0f + expf(-x)); }
__device__ __forceinline__ float wave_sum(float v) {
#pragma unroll
    for (int o = 1; o < 64; o <<= 1) v += __shfl_xor(v, o);
    return v;
}

template <int CTRL> __device__ __forceinline__ float dpp_f(float v) { return __int_as_float(__builtin_amdgcn_update_dpp(0, __float_as_int(v), CTRL, 0xF, 0xF, true)); }
__device__ __forceinline__ float row16_sum(float v) { v += dpp_f<0xB1>(v); v += dpp_f<0x4E>(v); v += dpp_f<0x141>(v); v += dpp_f<0x140>(v); return v; }
__device__ __forceinline__ float comb32(float a, float b) { const auto r = __builtin_amdgcn_permlane32_swap(__float_as_uint(a), __float_as_uint(b), false, false); return __uint_as_float(r[0]) + __uint_as_float(r[1]); }
__device__ __forceinline__ float comb16(float a, float b) { const auto r = __builtin_amdgcn_permlane16_swap(__float_as_uint(a), __float_as_uint(b), false, false); return __uint_as_float(r[0]) + __uint_as_float(r[1]); }
__device__ __forceinline__ float lane_f(float v, int l) { return __int_as_float(__builtin_amdgcn_readlane(__float_as_int(v), l)); }
__device__ __forceinline__ float wave_sum_fast(float v) { v = row16_sum(v); return (lane_f(v, 0) + lane_f(v, 16)) + (lane_f(v, 32) + lane_f(v, 48)); }
__device__ __forceinline__ float half_max(float v) { const auto r = __builtin_amdgcn_permlane32_swap(__float_as_uint(v), __float_as_uint(v), false, false); return fmaxf(__uint_as_float(r[0]), __uint_as_float(r[1])); }
__device__ __forceinline__ float half_sum(float v) { const auto r = __builtin_amdgcn_permlane32_swap(__float_as_uint(v), __float_as_uint(v), false, false); return __uint_as_float(r[0]) + __uint_as_float(r[1]); }

struct EpiProj {
    bf16_t *Kb, *Vb, *LXb, *Qb, *LGb; unsigned char *GAq, *GBq; const f32x2* rope;
    __device__ __forceinline__ void operator()(int row, int col, const float (&v)[8]) const {
        float o[8];
        if (col < 512) {
            if (row < TL) { const int t = row & 2047, p = col & 63, pos = (p < 32) ? (t >> 6) : (t & 63), i0 = (p & 31) >> 1;
#pragma unroll
                for (int j = 0; j < 4; ++j) { const f32x2 cs = rope[pos * 16 + i0 + j]; o[2 * j] = v[2 * j] * cs.x - v[2 * j + 1] * cs.y; o[2 * j + 1] = v[2 * j] * cs.y + v[2 * j + 1] * cs.x; }
            } else {
#pragma unroll
                for (int j = 0; j < 8; ++j) o[j] = v[j]; }
            *(u32x4*)(Kb + (size_t)row * 512 + col) = pack8(o);
        } else if (col < 1024) { *(u32x4*)(Vb + (size_t)row * 512 + (col - 512)) = pack8(v);
        } else if (col < 2048) { *(u32x4*)(LXb + (size_t)row * 1024 + (col - 1024)) = pack8(v);
        } else if (col < 2560) { *(u32x4*)(Qb + (size_t)row * 512 + (col - 2048)) = pack8(v);
        } else if (col < 3584) {
#pragma unroll
            for (int j = 0; j < 8; ++j) o[j] = gelu_tanh_fast(v[j]);
            *(u32x4*)(LGb + (size_t)row * 1024 + (col - 2560)) = pack8(o);
        } else {
#pragma unroll
            for (int j = 0; j < 8; ++j) o[j] = sigmoid_fast(v[j]);
            unsigned char* dst = (col < 4608) ? GAq + (size_t)row * 1024 + (col - 3584) : GBq + (size_t)row * 1024 + (col - 4608);
            *(u32x2*)dst = packq8(o);
        }
    }
};
struct EpiUpAttn {
    const unsigned char* GA; bf16_t* OUT;
    struct P { u32x2 g; };
    __device__ __forceinline__ void load(int row, int col, P& p) const { p.g = *(const u32x2*)(GA + (size_t)row * 1024 + col); }
    __device__ __forceinline__ void apply(int row, int col, const float (&v)[8], const P& p) const {
        float g[8], o[8]; unpackq8(p.g, g);
#pragma unroll
        for (int j = 0; j < 8; ++j) o[j] = g[j] * v[j];
        *(u32x4*)(OUT + (size_t)row * 1024 + col) = pack8(o);
    }
};
struct EpiUpLru {
    const bf16_t* Y; const unsigned char* GB; bf16_t* OUT;
    struct P { u32x2 g; u32x4 y; };
    __device__ __forceinline__ void load(int row, int col, P& p) const { p.g = *(const u32x2*)(GB + (size_t)row * 1024 + col); p.y = *(const u32x4*)(Y + (size_t)row * 1024 + col); }
    __device__ __forceinline__ void apply(int row, int col, const float (&v)[8], const P& p) const {
        float g[8], y[8], o[8]; unpackq8(p.g, g); unpack8(p.y, y);
#pragma unroll
        for (int j = 0; j < 8; ++j) o[j] = y[j] + g[j] * v[j];
        *(u32x4*)(OUT + (size_t)row * 1024 + col) = pack8(o);
    }
};
struct EpiOut {
    const float* x; const float* mod; bf16_t* x1;
    struct P { f32x4 x0, x1v, g0, g1; };
    __device__ __forceinline__ void load(int row, int col, P& p) const { const float* ga1 = mod + (row >> 11) * 6144 + 2048 + col; const float* xr = x + (size_t)row * D + col;
        p.x0 = *(const f32x4*)xr; p.x1v = *(const f32x4*)(xr + 4); p.g0 = *(const f32x4*)ga1; p.g1 = *(const f32x4*)(ga1 + 4); }
    __device__ __forceinline__ void apply(int row, int col, const float (&v)[8], const P& p) const {
        const float o[8] = {p.x0.x + p.g0.x * v[0], p.x0.y + p.g0.y * v[1], p.x0.z + p.g0.z * v[2], p.x0.w + p.g0.w * v[3], p.x1v.x + p.g1.x * v[4], p.x1v.y + p.g1.y * v[5], p.x1v.z + p.g1.z * v[6], p.x1v.w + p.g1.w * v[7]};
        *(u32x4*)(x1 + (size_t)row * D + col) = pack8(o);
    }
};
struct EpiMoe1 {
    bf16_t* HM;
    __device__ __forceinline__ void operator()(int row, int col, const float (&v)[8]) const {
        u32x2 w; w.x = pk2(silu_fast(v[0]) * v[1], silu_fast(v[2]) * v[3]); w.y = pk2(silu_fast(v[4]) * v[5], silu_fast(v[6]) * v[7]);
        *(u32x2*)(HM + (size_t)row * DEXP + (col >> 1)) = w;
    }
};
struct EpiMoe2 {
    bf16_t* YB;
    __device__ __forceinline__ void operator()(int row, int col, const float (&v)[8]) const { *(u32x4*)(YB + (size_t)row * D + col) = pack8(v); }
};
template <class F> struct EpiF {
    static constexpr bool PERM = true, AFTER_DRAIN = false; F f;
    __device__ __forceinline__ void operator()(const f32x4 (&acc)[2][2][4][2], const pg8::Unit& u, int wr, int wc, int fr, int fq) const {
#pragma unroll
        for (int ai = 0; ai < 2; ++ai)
#pragma unroll
            for (int m = 0; m < 4; ++m) { const int row = u.pm * 256 + ai * 128 + wr * 64 + m * 16 + fr;
#pragma unroll
                for (int bj = 0; bj < 2; ++bj) { const int col = u.pn * 256 + bj * 128 + wc * 32 + 8 * fq; const f32x4 a = acc[ai][bj][m][0], b = acc[ai][bj][m][1];
                    const float v[8] = {a[0], a[1], a[2], a[3], b[0], b[1], b[2], b[3]}; f(row, col, v); } }
    }
};
template <class F> struct EpiF2 {
    static constexpr bool PERM = true, AFTER_DRAIN = false; F f;
    __device__ __forceinline__ void operator()(const f32x4 (&acc)[2][2][4][2], const pg8::Unit& u, int wr, int wc, int fr, int fq) const {
#pragma unroll
        for (int ai = 0; ai < 2; ++ai)
#pragma unroll
            for (int mp = 0; mp < 2; ++mp) {
                typename F::P pre[2][2];
#pragma unroll
                for (int mm = 0; mm < 2; ++mm)
#pragma unroll
                    for (int bj = 0; bj < 2; ++bj) f.load(u.pm * 256 + ai * 128 + wr * 64 + (2 * mp + mm) * 16 + fr, u.pn * 256 + bj * 128 + wc * 32 + 8 * fq, pre[mm][bj]);
#pragma unroll
                for (int mm = 0; mm < 2; ++mm)
#pragma unroll
                    for (int bj = 0; bj < 2; ++bj) { const int m = 2 * mp + mm; const f32x4 a = acc[ai][bj][m][0], b = acc[ai][bj][m][1];
                        const float v[8] = {a[0], a[1], a[2], a[3], b[0], b[1], b[2], b[3]};
                        f.apply(u.pm * 256 + ai * 128 + wr * 64 + m * 16 + fr, u.pn * 256 + bj * 128 + wc * 32 + 8 * fq, v, pre[mm][bj]); }
                asm volatile("" ::: "memory");
            }
    }
};

struct ProjOrder {
    pg8::StaticOrder so; int G, c;
    __device__ __forceinline__ void init(int G_, int c_) { so.init(TL, PROJ, G_, c_); G = G_; c = c_; }
    __device__ __forceinline__ bool next(int i, pg8::Unit& u) const {
        const int L = i * G + c;
        if (L < so.nwg) return so.next(i, u);
        const int j = L - so.nwg; if (j >= 128) return false;
        u.pm = 128 + (j >> 3); u.pn = j & 7; u.bofs = 0; return true;
    }
    __device__ __forceinline__ void a_ready(const pg8::Unit&) const {}
    __device__ __forceinline__ void done(const pg8::Unit&) const {}
};
struct MoeOrder {
    const unsigned* ctl; int G, vcu, nunits; size_t estride;
    __device__ __forceinline__ void init(const unsigned* ctl_, int G_, int bx, size_t es) { ctl = ctl_; G = G_; vcu = (G_ % 8 == 0) ? (bx % 8) * (G_ / 8) + bx / 8 : bx; nunits = (int)ctl_[CW_NBLK] * 4; estride = es; }
    __device__ __forceinline__ bool next(int i, pg8::Unit& u) const {
        const int L = i * G + vcu; if (L >= nunits) return false;
        u.pm = L >> 2; u.pn = L & 3; u.bofs = (size_t)ctl[CW_BLKE + u.pm] * estride; return true;
    }
    __device__ __forceinline__ void a_ready(const pg8::Unit&) const {}
    __device__ __forceinline__ void done(const pg8::Unit&) const {}
};

#define XB_TMO      128
#define XB_XCNT(j)  (256  + 64 * (j))
#define XB_XSUB(j)  (1280 + 64 * (j))
#define XB_XGEN(j)  (2304 + 64 * (j))
#define XB_TOP      3328
#define XB_TOPGEN   3392
#define XCD_BAR_WORDS 3456
#define XB_SPIN_CAP (1u << 18)

__device__ __forceinline__ unsigned xb_ld(unsigned* p)              { return __hip_atomic_load(p, __ATOMIC_RELAXED, __HIP_MEMORY_SCOPE_AGENT); }
__device__ __forceinline__ unsigned xb_add(unsigned* p, unsigned v) { return __hip_atomic_fetch_add(p, v, __ATOMIC_RELAXED, __HIP_MEMORY_SCOPE_AGENT); }
__device__ __forceinline__ unsigned xb_xcc_id() { return (unsigned)__builtin_amdgcn_s_getreg((3 << 11) | 20) & 0xFu; }
#define XB_SPIN(cond, bar) do { unsigned _sp = 0; while (cond) { __builtin_amdgcn_s_sleep(1); \
    if ((++_sp & 255u) == 0u) { if (xb_ld(&(bar)[XB_TMO])) break; if (_sp > XB_SPIN_CAP) { atomicAdd(&(bar)[XB_TMO], 1u); break; } } } } while (0)

struct XcdBarrier {
    unsigned* bar; unsigned x;
    volatile LAS unsigned* st;
};

__device__ __forceinline__ XcdBarrier xcd_barrier_post(unsigned* bar, volatile LAS unsigned* st, bool leader) {
    XcdBarrier b; b.bar = bar; b.x = xb_xcc_id(); b.st = st;
    if (leader) (void)xb_add(&bar[XB_XCNT(b.x)], 1u);
    return b;
}
__device__ __forceinline__ void xcd_barrier_complete(unsigned* bar, unsigned x, unsigned& nloc, unsigned& nx) {
    const unsigned G = gridDim.x * gridDim.y * gridDim.z;
    unsigned sum, cnt, mine, sp = 0u;
    for (;;) {
        sum = 0u; cnt = 0u; mine = 0u;
#pragma unroll
        for (unsigned j = 0; j < 16; ++j) { const unsigned c = xb_ld(&bar[XB_XCNT(j)]); sum += c; cnt += (c > 0u) ? 1u : 0u; mine = (j == x) ? c : mine; }
        if (sum == G) break;
        __builtin_amdgcn_s_sleep(1);
        if ((++sp & 255u) == 0u) { if (xb_ld(&bar[XB_TMO])) break; if (sp > XB_SPIN_CAP) { atomicAdd(&bar[XB_TMO], 1u); break; } }
    }
    nloc = mine > 0u ? mine : 1u; nx = cnt > 0u ? cnt : 1u;
}

__device__ __forceinline__ void xcd_barrier(const XcdBarrier& b, int wave) {
    const bool leader_ = wave == 0 && __builtin_amdgcn_mbcnt_hi(~0u, __builtin_amdgcn_mbcnt_lo(~0u, 0u)) == 0u;
    asm volatile("s_waitcnt vmcnt(0)" ::: "memory");
    __syncthreads();
    if (leader_) {
        unsigned* bar = b.bar;
        __builtin_amdgcn_s_waitcnt(0);
        unsigned nloc = b.st[0], nx = b.st[1];
        if (nloc == 0u) { xcd_barrier_complete(bar, b.x, nloc, nx); b.st[0] = nloc; b.st[1] = nx; }
        const unsigned old = xb_add(&bar[XB_XSUB(b.x)], 1u);
        const unsigned gen = old / nloc;
        if (old + 1u == (gen + 1u) * nloc) {
            __builtin_amdgcn_fence(__ATOMIC_RELEASE, "agent");
            asm volatile("s_waitcnt vmcnt(0)" ::: "memory");
            const unsigned og = xb_add(&bar[XB_TOP], 1u);
            const unsigned tg = og / nx;
            if (og + 1u == (tg + 1u) * nx) xb_add(&bar[XB_TOPGEN], 1u);
            else XB_SPIN(xb_ld(&bar[XB_TOPGEN]) == tg, bar);
            __builtin_amdgcn_fence(__ATOMIC_ACQUIRE, "agent");
            xb_add(&bar[XB_XGEN(b.x)], 1u);
            asm volatile("s_waitcnt vmcnt(0)" ::: "memory");
        } else {
            XB_SPIN(xb_ld(&bar[XB_XGEN(b.x)]) == gen, bar);
            __builtin_amdgcn_fence(__ATOMIC_ACQUIRE, "agent");
            asm volatile("s_waitcnt vmcnt(0)" ::: "memory");
        }
    }
    __syncthreads();
}

__device__ __forceinline__ int win_perm(int n) {
    const bool qk = (n < 512) || (n >= 2048 && n < 2560);
    if (!qk) return n;
    const int d = n & 63, base = n - d, half = d >> 5, dd = d & 31, i = dd & 15, comp = dd >> 4;
    return base + half * 32 + 2 * i + comp;
}
template <int K, int N, int MODE, int ROWMUL>
__device__ __forceinline__ void prep_item(const float* W, bf16_t* WT, int rowoff, unsigned dstride, LAS float* scr, int item, int lane, float wscale = 1.0f) {
    constexpr int nblk = N / 32, per = (K / 64) * nblk;
    const int bi = item / per, r = item % per, kb = r / nblk, nb = r % nblk, k0 = 64 * kb, n0 = 32 * nb;
    const float* src = W + (size_t)bi * K * N;
    { float t_[32];
#pragma unroll
      for (int i = 0; i < 32; ++i) t_[i] = __builtin_nontemporal_load(src + (size_t)(k0 + 2 * i + (lane >> 5)) * N + n0 + (lane & 31));
#pragma unroll
      for (int i = 0; i < 32; ++i) scr[(2 * i + (lane >> 5)) * 33 + (lane & 31)] = t_[i]; }
    asm volatile("s_waitcnt lgkmcnt(0)" ::: "memory");
    const int c = lane & 7;
#pragma unroll
    for (int j = 0; j < 4; ++j) { const int n = (lane >> 3) + 8 * j; const LAS float* s = scr + (8 * c) * 33 + n;
        u32x4 o; o.x = pk2(s[0 * 33] * wscale, s[1 * 33] * wscale); o.y = pk2(s[2 * 33] * wscale, s[3 * 33] * wscale); o.z = pk2(s[4 * 33] * wscale, s[5 * 33] * wscale); o.w = pk2(s[6 * 33] * wscale, s[7 * 33] * wscale);
        int ng = n0 + n; if (MODE == 1) ng = win_perm(ng);
        *(u32x4*)(WT + (size_t)bi * dstride + (size_t)(ROWMUL * ng + rowoff) * K + k0 + 8 * c) = o; }
    asm volatile("s_waitcnt lgkmcnt(0)" ::: "memory");
}
__device__ __forceinline__ unsigned char* lds_ptr(LAS unsigned char* ldsl, int i);
__device__ __forceinline__ void p0_prep(unsigned char* ws, LAS unsigned char* ldsl, int gw, int ngw, int lane, int wave) {
    LAS float* scr = (LAS float*)(ldsl + wave * 8448);
#define in_(i) ((const float*)lds_ptr(ldsl, (i)))
    constexpr int I0 = 16 * 176, I1 = 8 * 32, I2 = 16 * 32, I3 = 16 * 32, I4 = 16 * 2 * 4, I5 = I4, I6 = 32 * 16 * 16, I7 = I6, I8 = 32 * 8 * 32;
    constexpr int TOT = I0 + I1 + I2 + I3 + I4 + I5 + I6 + I7 + I8;
    for (int it = gw; it < TOT; it += ngw) {
        int r = it;
        if (r < I0) { prep_item<1024, PROJ, 1, 1>(in_(8), (bf16_t*)(ws + WS_WIN), 0, 0u, scr, r, lane); continue; } r -= I0;
        if (r < I1) { prep_item<512, 1024, 0, 1>(in_(17), (bf16_t*)(ws + WS_WA), 0, 0u, scr, r, lane); continue; } r -= I1;
        if (r < I2) { prep_item<1024, 1024, 0, 1>(in_(18), (bf16_t*)(ws + WS_WL), 0, 0u, scr, r, lane); continue; } r -= I2;
        if (r < I3) { prep_item<1024, 1024, 0, 1>(in_(19), (bf16_t*)(ws + WS_WO), 0, 0u, scr, r, lane); continue; } r -= I3;
        if (r < I4) { prep_item<128, 128, 0, 1>(in_(12), (bf16_t*)(ws + WS_LW), 0, 256u * 128u, scr, r, lane, -1.4426950408889634f); continue; } r -= I4;
        if (r < I5) { prep_item<128, 128, 0, 1>(in_(14), (bf16_t*)(ws + WS_LW), 128, 256u * 128u, scr, r, lane, -1.4426950408889634f); continue; } r -= I5;
        if (r < I6) { prep_item<1024, 512, 0, 2>(in_(24), (bf16_t*)(ws + WS_W13), 0, 1024u * 1024u, scr, r, lane); continue; } r -= I6;
        if (r < I7) { prep_item<1024, 512, 0, 2>(in_(25), (bf16_t*)(ws + WS_W13), 1, 1024u * 1024u, scr, r, lane); continue; } r -= I7;
        prep_item<512, 1024, 0, 1>(in_(26), (bf16_t*)(ws + WS_W2), 0, 1024u * 512u, scr, r, lane);
    }
#undef in_
}
__device__ __forceinline__ void p0_mod(const float* c, const float* c_ctx, const float* w_mod, const float* b_mod, const float* wg, const float* we, f32x4* W4g, const float* lam, float* SPt, float* mod, f32x2* rope, LAS float* lds_f, int tid) {
    LAS float* sc = lds_f;
    LAS float* red = lds_f + 17 * 1024;
    for (int i = tid; i < 17 * 1024; i += NTHREADS) { const float v = (i < 16 * 1024) ? c[i] : c_ctx[i - 16 * 1024]; sc[i] = siluf_(v); }
    for (int idx = blockIdx.x * NTHREADS + tid; idx < 36 * 256; idx += gridDim.x * NTHREADS) { const int cc = idx >> 8, kq = idx & 255; f32x4 w;
        if (cc < 4) { const float* s = wg + (size_t)(4 * kq) * 4 + cc; w.x = s[0]; w.y = s[4]; w.z = s[8]; w.w = s[12]; }
        else { const float* s = we + (size_t)(4 * kq) * 32 + (cc - 4); w.x = s[0]; w.y = s[32]; w.z = s[64]; w.w = s[96]; }
        W4g[idx] = w; }
    if (blockIdx.x == 1) for (int i = tid; i < 2048; i += NTHREADS) { const float lm = lam[i]; SPt[i] = (-lm > 20.f) ? -lm : log1pf(expf(-lm)); }
    if (blockIdx.x == 0) for (int i = tid; i < 64 * 16; i += NTHREADS) { const int pos = i >> 4, f = i & 15; const double inv = exp(-(double)f / 16.0 * log(10000.0)); const double ang = (double)pos * inv;
        rope[i] = (f32x2){(float)cos(ang), (float)sin(ang)}; }
    __syncthreads();
    for (int cb = blockIdx.x; cb < 256; cb += gridDim.x) {
        const int ks = tid / 24, col = tid % 24;
        if (ks < 21) {
            float acc[17];
#pragma unroll
            for (int b = 0; b < 17; ++b) acc[b] = 0.f;
            for (int k = ks; k < 1024; k += 21) { const float w = w_mod[(size_t)k * 6144 + cb * 24 + col];
#pragma unroll
                for (int b = 0; b < 17; ++b) acc[b] += sc[b * 1024 + k] * w; }
#pragma unroll
            for (int b = 0; b < 17; ++b) red[(ks * 17 + b) * 24 + col] = acc[b];
        }
        __syncthreads();
        if (tid < 17 * 24) { const int b = tid / 24, cc = tid % 24; float s = b_mod[cb * 24 + cc];
            for (int q = 0; q < 21; ++q) s += red[(q * 17 + b) * 24 + cc];
            mod[b * 6144 + cb * 24 + cc] = s; }
        __syncthreads();
    }
}

__device__ __forceinline__ void p1_adanorm(const float* x, const float* ctx, const float* gain, const float* mod, bf16_t* H, int gw, int ngw, int lane) {
    f32x4 nA[4], nB[4];
#define AD_SRC(r_) ((r_) < TL ? x + (size_t)(r_) * D : ctx + (size_t)((r_) - TL) * D)
#define AD_LOAD(dst, r_) do { if ((r_) < TALL) { const float* s_ = AD_SRC(r_); _Pragma("unroll") for (int j = 0; j < 4; ++j) dst[j] = __builtin_nontemporal_load((const f32x4*)(s_ + lane * 4 + 256 * j)); } } while (0)
#define AD_ROW(src_, r_) do { const int row_ = (r_); const int mb = row_ < TL ? (row_ >> 11) : 16; const float* shift = mod + mb * 6144; const float* scale = shift + 1024; \
        f32x4 v[4]; float ss = 0.f; \
        _Pragma("unroll") for (int j = 0; j < 4; ++j) { v[j] = src_[j]; ss += v[j].x * v[j].x + v[j].y * v[j].y + v[j].z * v[j].z + v[j].w * v[j].w; } \
        AD_LOAD(src_, row_ + 2 * ngw); \
        const float rstd = rsqrtf(wave_sum_fast(ss) * (1.0f / D) + EPS); \
        _Pragma("unroll") for (int j = 0; j < 4; ++j) { const int k = lane * 4 + 256 * j; const f32x4 g = *(const f32x4*)(gain + k), sh = *(const f32x4*)(shift + k), sc = *(const f32x4*)(scale + k); \
            const f32x4 o = (v[j] * rstd * g) * (1.0f + sc) + sh; \
            u32x2 w; w.x = pk2(o.x, o.y); w.y = pk2(o.z, o.w); *(u32x2*)(H + (size_t)row_ * D + k) = w; } } while (0)
    AD_LOAD(nA, gw); AD_LOAD(nB, gw + ngw);
    for (int row = gw; row < TALL; row += 2 * ngw) { AD_ROW(nA, row); if (row + ngw < TALL) AD_ROW(nB, row + ngw); }
#undef AD_SRC
#undef AD_LOAD
#undef AD_ROW
}

__device__ __forceinline__ void p1_router_tables(const float* gain, const float* mod, const f32x4* W4g, const float* bg, const float* be, float* WT, float* biasb, int gw, int ngw, int lane) {
    for (int it = gw; it < 16 * 48; it += ngw) {
        const int b = it / 48, j = it % 48; const float* shift = mod + b * 6144 + 3072; const float* scale = shift + 1024;
        float part = 0.f;
#pragma unroll
        for (int i = 0; i < 4; ++i) { const int kq = lane + 64 * i; const f32x4 g = *(const f32x4*)(gain + 4 * kq), sc = *(const f32x4*)(scale + 4 * kq), sh = *(const f32x4*)(shift + 4 * kq);
            f32x4 w = (f32x4){0.f, 0.f, 0.f, 0.f}; if (j < 36) w = W4g[j * 256 + kq];
            *(f32x4*)(WT + (size_t)(b * 48 + j) * 1024 + 4 * kq) = g * (1.0f + sc) * w;
            part += sh.x * w.x + sh.y * w.y + sh.z * w.z + sh.w * w.w; }
        part = wave_sum_fast(part);
        if (lane == 0) biasb[b * 48 + j] = part + (j < 4 ? bg[j] : j < 36 ? be[j - 4] : 0.f);
    }
}
constexpr int RT_CHUNK_FLOATS = 48 * 132, RT_LG_OFF = 2 * RT_CHUNK_FLOATS * 4;
__device__ __forceinline__ void p8_route(const bf16_t* x1, const float* WT, const float* biasb, unsigned* ctl, int* tok, LAS unsigned char* lds, int lane, int tid, int wave) {
    LAS unsigned* hist = (LAS unsigned*)(lds + MISC_OFF + 256);
    if (tid < 32) hist[tid] = 0u;
    LAS float* Lg = (LAS float*)(lds + RT_LG_OFF + wave * 3072);
    const int i = lane & 15, kk = lane >> 4;
    for (int blk = blockIdx.x; blk < TL / 128; blk += gridDim.x) {
        const int R0 = 128 * blk + 16 * wave, b = (128 * blk) >> 11;
        const bf16_t* xr = x1 + (size_t)(R0 + i) * D + 4 * kk; const float* wtb = WT + (size_t)b * 48 * 1024;
        f32x4 a0 = (f32x4){0.f, 0.f, 0.f, 0.f}, a1 = a0, a2 = a0; float ss = 0.f;
        f32x4 stg[3];
#define RT_LOAD(c_) do { _Pragma("unroll") for (int q = 0; q < 3; ++q) { const int id = tid + NTHREADS * q, col = id >> 5, k4 = id & 31; stg[q] = *(const f32x4*)(wtb + (size_t)col * 1024 + 128 * (c_) + 4 * k4); } } while (0)
#define RT_STORE(buf_) do { _Pragma("unroll") for (int q = 0; q < 3; ++q) { const int id = tid + NTHREADS * q, col = id >> 5, k4 = id & 31; *(LAS f32x4*)((LAS float*)lds + (buf_) * RT_CHUNK_FLOATS + col * 132 + 4 * k4) = stg[q]; } } while (0)
        __syncthreads();
        RT_LOAD(0); RT_STORE(0);
        u32x2 cx[8];
#pragma unroll
        for (int u = 0; u < 8; ++u) cx[u] = *(const u32x2*)(xr + 16 * u);
        __syncthreads();
#pragma unroll 1
        for (int c = 0; c < 8; ++c) {
            if (c < 7) RT_LOAD(c + 1);
            u32x2 nx[8];
            if (c < 7) {
#pragma unroll
                for (int u = 0; u < 8; ++u) nx[u] = *(const u32x2*)(xr + 128 * (c + 1) + 16 * u); }
            const LAS float* wl = (const LAS float*)lds + (c & 1) * RT_CHUNK_FLOATS + i * 132 + 4 * kk;
#pragma unroll
            for (int u = 0; u < 8; ++u) { const f32x4 xa = (f32x4){bflo(cx[u].x), bfhi(cx[u].x), bflo(cx[u].y), bfhi(cx[u].y)}, b0 = *(const LAS f32x4*)(wl + 16 * u), b1 = *(const LAS f32x4*)(wl + 16 * 132 + 16 * u), b2 = *(const LAS f32x4*)(wl + 32 * 132 + 16 * u);
                ss += xa.x * xa.x + xa.y * xa.y + xa.z * xa.z + xa.w * xa.w;
                a0 = __builtin_amdgcn_mfma_f32_16x16x4f32(xa.x, b0.x, a0, 0, 0, 0); a1 = __builtin_amdgcn_mfma_f32_16x16x4f32(xa.x, b1.x, a1, 0, 0, 0); a2 = __builtin_amdgcn_mfma_f32_16x16x4f32(xa.x, b2.x, a2, 0, 0, 0);
                a0 = __builtin_amdgcn_mfma_f32_16x16x4f32(xa.y, b0.y, a0, 0, 0, 0); a1 = __builtin_amdgcn_mfma_f32_16x16x4f32(xa.y, b1.y, a1, 0, 0, 0); a2 = __builtin_amdgcn_mfma_f32_16x16x4f32(xa.y, b2.y, a2, 0, 0, 0);
                a0 = __builtin_amdgcn_mfma_f32_16x16x4f32(xa.z, b0.z, a0, 0, 0, 0); a1 = __builtin_amdgcn_mfma_f32_16x16x4f32(xa.z, b1.z, a1, 0, 0, 0); a2 = __builtin_amdgcn_mfma_f32_16x16x4f32(xa.z, b2.z, a2, 0, 0, 0);
                a0 = __builtin_amdgcn_mfma_f32_16x16x4f32(xa.w, b0.w, a0, 0, 0, 0); a1 = __builtin_amdgcn_mfma_f32_16x16x4f32(xa.w, b1.w, a1, 0, 0, 0); a2 = __builtin_amdgcn_mfma_f32_16x16x4f32(xa.w, b2.w, a2, 0, 0, 0); }
            if (c < 7) { RT_STORE((c + 1) & 1);
#pragma unroll
                for (int u = 0; u < 8; ++u) cx[u] = nx[u]; }
            __syncthreads();
        }
#undef RT_LOAD
#undef RT_STORE
        ss = half_sum(ss); { const auto r = __builtin_amdgcn_permlane16_swap(__float_as_uint(ss), __float_as_uint(ss), false, false); ss = __uint_as_float(r[0]) + __uint_as_float(r[1]); }
        const float rstd = rsqrtf(ss * (1.0f / D) + EPS);
#pragma unroll
        for (int rg = 0; rg < 4; ++rg) { Lg[(4 * kk + rg) * 48 + i] = a0[rg]; Lg[(4 * kk + rg) * 48 + 16 + i] = a1[rg]; Lg[(4 * kk + rg) * 48 + 32 + i] = a2[rg]; }
        if (lane < 16) {
            const int row = R0 + lane; const float* bb = biasb + b * 48; const LAS float* lr = Lg + lane * 48;
            float acc[36];
#pragma unroll
            for (int c4 = 0; c4 < 9; ++c4) { const f32x4 v = *(const LAS f32x4*)(lr + 4 * c4), bv = *(const f32x4*)(bb + 4 * c4);
                acc[4 * c4] = rstd * v.x + bv.x; acc[4 * c4 + 1] = rstd * v.y + bv.y; acc[4 * c4 + 2] = rstd * v.z + bv.z; acc[4 * c4 + 3] = rstd * v.w + bv.w; }
            int gi = 0; float gm = -1e30f;
#pragma unroll
            for (int g = 0; g < 4; ++g) if (acc[g] > gm) { gm = acc[g]; gi = g; }
            float gs = 0.f;
#pragma unroll
            for (int g = 0; g < 4; ++g) gs += expf(acc[g] - gm);
            const float p_top = 1.0f / gs;
            float le[8];
#pragma unroll
            for (int j = 0; j < 8; ++j) le[j] = gi == 0 ? acc[4 + j] : gi == 1 ? acc[12 + j] : gi == 2 ? acc[20 + j] : acc[28 + j];
            int e1 = 0; float v1 = -1e30f;
#pragma unroll
            for (int j = 0; j < 8; ++j) if (le[j] > v1) { v1 = le[j]; e1 = j; }
            int e2 = 0; float v2 = -1e30f;
#pragma unroll
            for (int j = 0; j < 8; ++j) if (j != e1 && le[j] > v2) { v2 = le[j]; e2 = j; }
            const float p2 = expf(v2 - v1), inv = 1.0f / (1.0f + p2);
            const int eid0 = gi * 8 + e1, eid1 = gi * 8 + e2;
            const int s0 = (int)__hip_atomic_fetch_add(&hist[eid0], 1u, __ATOMIC_RELAXED, __HIP_MEMORY_SCOPE_WORKGROUP), s1 = (int)__hip_atomic_fetch_add(&hist[eid1], 1u, __ATOMIC_RELAXED, __HIP_MEMORY_SCOPE_WORKGROUP);
            int* tr = tok + row * 8; tr[0] = eid0; tr[1] = eid1; ((float*)tr)[2] = p_top * inv; ((float*)tr)[3] = p_top * p2 * inv; tr[4] = s0; tr[5] = s1; ((float*)tr)[6] = rstd;
        }
    }
    __syncthreads();
    if (tid < 32) ctl[CW_BCNT + blockIdx.x * 32 + tid] = hist[tid];
}

__device__ __forceinline__ void p9_scatter(const bf16_t* x1, const float* gain, const float* mod, unsigned* ctl, int* tok, bf16_t* XB, LAS unsigned* sl, int gw, int ngw, int lane, int tid) {
    const int G = gridDim.x;
    { const int e = tid & 31, part = tid >> 5; unsigned sall = 0, sbef = 0;
      for (int bb = part; bb < G; bb += 16) { const unsigned v = ctl[CW_BCNT + bb * 32 + e]; sall += v; if (bb < (int)blockIdx.x) sbef += v; }
      sl[part * 32 + e] = sall; sl[512 + part * 32 + e] = sbef; }
    __syncthreads();
    if (tid < 64) {
        unsigned cnt = 0, bef = 0;
        if (lane < 32) for (int q = 0; q < 16; ++q) { cnt += sl[q * 32 + lane]; bef += sl[512 + q * 32 + lane]; }
        const unsigned padded = (cnt + 255u) & ~255u; unsigned incl = padded;
#pragma unroll
        for (int o = 1; o < 32; o <<= 1) { const unsigned t = __shfl_up(incl, o); if ((lane & 31) >= o) incl += t; }
        const unsigned excl = incl - padded;
        if (lane < 32) sl[1024 + lane] = excl + bef;
        if (blockIdx.x == 0) {
            const unsigned total = __shfl(incl, 31);
            if (lane == 0) ctl[CW_NBLK] = total >> 8;
            if (lane < 32) for (unsigned i = excl >> 8; i < (incl >> 8); ++i) ctl[CW_BLKE + i] = (unsigned)lane;
        }
    }
    __syncthreads();
    for (int blk = blockIdx.x; blk < TL / 128; blk += gridDim.x) {
        const int R0 = 128 * blk + 16 * (tid >> 6); const float* shift = mod + (R0 >> 11) * 6144 + 3072; const float* scale = shift + 1024;
        f32x4 G[4], S[4];
#pragma unroll
        for (int j = 0; j < 4; ++j) { const int k = lane * 4 + 256 * j; G[j] = *(const f32x4*)(gain + k) * (1.0f + *(const f32x4*)(scale + k)); S[j] = *(const f32x4*)(shift + k); }
#pragma unroll 4
        for (int rr = 0; rr < 16; ++rr) { const int row = R0 + rr; const int* tr = tok + row * 8;
            const int e0 = tr[0], e1 = tr[1]; const float rstd = ((const float*)tr)[6];
            const unsigned d0 = sl[1024 + e0] + (unsigned)tr[4], d1 = sl[1024 + e1] + (unsigned)tr[5];
            u32x2 w[4];
#pragma unroll
            for (int j = 0; j < 4; ++j) { const u32x2 xb = *(const u32x2*)(x1 + (size_t)row * D + lane * 4 + 256 * j); const f32x4 o = (f32x4){bflo(xb.x), bfhi(xb.x), bflo(xb.y), bfhi(xb.y)} * rstd * G[j] + S[j]; w[j].x = pk2(o.x, o.y); w[j].y = pk2(o.z, o.w); }
#pragma unroll
            for (int j = 0; j < 4; ++j) { *(u32x2*)(XB + (size_t)d0 * D + lane * 4 + 256 * j) = w[j]; *(u32x2*)(XB + (size_t)d1 * D + lane * 4 + 256 * j) = w[j]; }
            if (lane == 0) { tok[row * 8 + 4] = (int)d0; tok[row * 8 + 5] = (int)d1; } }
    }
}

__device__ __forceinline__ void p12_final(const bf16_t* x1, float* outp, const float* mod, const int* tok, const bf16_t* YB, const float* gfin, int gw, int ngw, int lane) {
    u32x2 nxv[4]; u32x2 nya[4], nyb[4]; float nw0 = 0.f, nw1 = 0.f; int t2d0 = 0, t2d1 = 0; float t2w0 = 0.f, t2w1 = 0.f;
    if (gw < TL) { const int d0 = tok[gw * 8 + 4], d1 = tok[gw * 8 + 5]; nw0 = ((const float*)tok)[gw * 8 + 2]; nw1 = ((const float*)tok)[gw * 8 + 3];
#pragma unroll
        for (int j = 0; j < 4; ++j) { const int k = lane * 4 + 256 * j; nxv[j] = *(const u32x2*)(x1 + (size_t)gw * D + k); nya[j] = *(const u32x2*)(YB + (size_t)d0 * D + k); nyb[j] = *(const u32x2*)(YB + (size_t)d1 * D + k); } }
    if (gw + ngw < TL) { const int r2 = gw + ngw; t2d0 = tok[r2 * 8 + 4]; t2d1 = tok[r2 * 8 + 5]; t2w0 = ((const float*)tok)[r2 * 8 + 2]; t2w1 = ((const float*)tok)[r2 * 8 + 3]; }
    for (int row = gw; row < TL; row += ngw) {
        const float* ga2 = mod + (row >> 11) * 6144 + 5120; float* dst = outp + (size_t)row * D;
        const float w0 = nw0, w1 = nw1;
        f32x4 xv[4]; u32x2 ya[4], yb[4];
#pragma unroll
        for (int j = 0; j < 4; ++j) { xv[j] = (f32x4){bflo(nxv[j].x), bfhi(nxv[j].x), bflo(nxv[j].y), bfhi(nxv[j].y)}; ya[j] = nya[j]; yb[j] = nyb[j]; }
        const int nrow = row + ngw;
        if (nrow < TL) { nw0 = t2w0; nw1 = t2w1;
#pragma unroll
            for (int j = 0; j < 4; ++j) { const int k = lane * 4 + 256 * j; nxv[j] = *(const u32x2*)(x1 + (size_t)nrow * D + k); nya[j] = *(const u32x2*)(YB + (size_t)t2d0 * D + k); nyb[j] = *(const u32x2*)(YB + (size_t)t2d1 * D + k); }
            const int r2 = nrow + ngw;
            if (r2 < TL) { t2d0 = tok[r2 * 8 + 4]; t2d1 = tok[r2 * 8 + 5]; t2w0 = ((const float*)tok)[r2 * 8 + 2]; t2w1 = ((const float*)tok)[r2 * 8 + 3]; } }
        f32x4 v[4]; float ss = 0.f;
#pragma unroll
        for (int j = 0; j < 4; ++j) { const int k = lane * 4 + 256 * j; const f32x4 g = *(const f32x4*)(ga2 + k); const u32x2 a = ya[j], bq = yb[j];
            f32x4 y; y.x = w0 * bflo(a.x) + w1 * bflo(bq.x); y.y = w0 * bfhi(a.x) + w1 * bfhi(bq.x); y.z = w0 * bflo(a.y) + w1 * bflo(bq.y); y.w = w0 * bfhi(a.y) + w1 * bfhi(bq.y);
            v[j] = xv[j] + g * y; ss += v[j].x * v[j].x + v[j].y * v[j].y + v[j].z * v[j].z + v[j].w * v[j].w; }
        const float rstd = rsqrtf(wave_sum_fast(ss) * (1.0f / D) + EPS);
#pragma unroll
        for (int j = 0; j < 4; ++j) { const int k = lane * 4 + 256 * j; const f32x4 g = *(const f32x4*)(gfin + k); *(f32x4*)(dst + k) = v[j] * rstd * g; }
    }
}

typedef float f32x16 __attribute__((ext_vector_type(16)));
typedef short v4i16_t __attribute__((ext_vector_type(4)));
using pg8::bf16x8;
constexpr int ATT_CK_OFF = 2048, ATT_CV_OFF = ATT_CK_OFF + 32768, ATT_RING_OFF = ATT_CV_OFF + 32768, ATT_SK_OFF = ATT_RING_OFF + 32768, ATT_SV_OFF = ATT_SK_OFF + 11 * 2048;
static_assert(ATT_SV_OFF + 11 * 2048 <= MISC_OFF, "attention LDS map");
__device__ __forceinline__ void p3_attn(const bf16_t* Qb, bf16_t* Ob, const bf16_t* Kb, const bf16_t* Vb, const float* rpb, const f32x2* rope, LAS unsigned char* lds, int wave, int lane) {
    constexpr float L2E = 1.4426950408889634f, SC = 0.125f * L2E;
    const int tid = wave * 64 + lane, ql = lane & 31, hl = lane >> 5, skey = tid >> 3, sch = tid & 7;
    LAS float* rpbL = (LAS float*)lds;
    const int vq = (lane & 15) >> 2, vcol = (16 * ((lane >> 4) & 1) + 4 * (lane & 3)) * 2;
    const int g = wave & 1, sside = skey >= 24 && skey < 40;
    for (int it = blockIdx.x; it < NBATCH * 8 * 2; it += gridDim.x) {
        const int rh = it & 1, h = (it >> 1) & 7, b = it >> 4;
        __syncthreads();
        if (tid < 15 * 32) { const int c = tid & 31, dr = tid >> 5; rpbL[tid] = c < 31 ? rpb[(h * 15 + dr) * 31 + c] * L2E : -1e30f; }
#pragma unroll
        for (int i = 0; i < 4; ++i) { const int key = skey + 64 * i; const size_t row = (size_t)(TL + b * CTXL + key) * 512 + h * 64 + 8 * sch;
            *(LAS u32x4*)(lds + ATT_CK_OFF + key * 128 + ((sch ^ (key & 7)) * 16)) = *(const u32x4*)(Kb + row);
            *(LAS u32x4*)(lds + ATT_CV_OFF + key * 128 + sch * 16) = *(const u32x4*)(Vb + row); }
#pragma unroll 1
        for (int pass = 0; pass < 4; ++pass) {
            const int R0 = 16 * rh + 4 * pass, r = R0 + (wave >> 1);
            const int cq = 32 * g + ql, rs = min(max(r - 4, 0), 24), cstart = min(max(cq - 8, 0), 48);
            const int kmin = min(max(R0 - 4, 0), 24), kmax = min(max(R0 - 1, 0), 24) + 7, nsteps = kmax - kmin + 1;
            const bf16_t* qp = Qb + (size_t)(b * SEQ + r * 64 + cq) * 512 + h * 64; bf16_t* op = Ob + (size_t)(b * SEQ + r * 64 + cq) * 512 + h * 64;
#define ATT_PUT(slot_, krel_, kv_, vv_) do { *(LAS u32x4*)(lds + (slot_) + skey * 128 + ((sch ^ (skey & 7)) * 16)) = (kv_); *(LAS u32x4*)(lds + (slot_) + 8192 + skey * 128 + sch * 16) = (vv_); \
                if (sside) { *(LAS u32x4*)(lds + ATT_SK_OFF + ((krel_) * 16 + skey - 24) * 128 + ((sch ^ (skey & 7)) * 16)) = (kv_); *(LAS u32x4*)(lds + ATT_SV_OFF + ((krel_) * 16 + skey - 24) * 128 + sch * 16) = (vv_); } } while (0)
            { const size_t row = (size_t)(b * SEQ + kmin * 64 + skey) * 512 + h * 64 + 8 * sch; const u32x4 kv = *(const u32x4*)(Kb + row), vv = *(const u32x4*)(Vb + row); ATT_PUT(ATT_RING_OFF, 0, kv, vv); }
            bf16x8 qplain[4], qrot[4];
#pragma unroll
            for (int d0 = 0; d0 < 4; ++d0) { float v[8], o[8], pl[8]; unpack8(*(const u32x4*)(qp + 16 * d0 + 8 * hl), v);
                const int pos = d0 < 2 ? r : cq, i0 = ((16 * d0 + 8 * hl) & 31) >> 1;
#pragma unroll
                for (int j = 0; j < 4; ++j) { const f32x2 cs = rope[pos * 16 + i0 + j]; o[2 * j] = (v[2 * j] * cs.x - v[2 * j + 1] * cs.y) * SC; o[2 * j + 1] = (v[2 * j] * cs.y + v[2 * j + 1] * cs.x) * SC; }
#pragma unroll
                for (int j = 0; j < 8; ++j) pl[j] = v[j] * SC;
                qrot[d0] = __builtin_bit_cast(bf16x8, pack8(o)); qplain[d0] = __builtin_bit_cast(bf16x8, pack8(pl)); }
            int dco[16];
#pragma unroll
            for (int i = 0; i < 16; ++i) { const int kc = 32 * g + (i & 3) + 8 * (i >> 2) + 4 * hl; const bool ok = kc >= cstart && kc < cstart + 16; dco[i] = ok ? (kc - cq + 15) * 4 : 31 * 4; }
            f32x16 o0, o1;
#pragma unroll
            for (int i = 0; i < 16; ++i) { o0[i] = 0.f; o1[i] = 0.f; }
            float m = -1e30f, l = 0.f;
#define ATT_TILE(kp_, vb_, vsk_, ve_, qf) do { \
            _Pragma("unroll") for (int d0 = 0; d0 < 4; ++d0) s = __builtin_amdgcn_mfma_f32_32x32x16_bf16(*(const LAS bf16x8*)((kp_) + (((2 * d0 + hl) ^ (ql & 7)) * 16)), qf[d0], s, 0, 0, 0); \
            float mt = fmaxf(fmaxf(s[0], s[1]), s[2]); \
            _Pragma("unroll") for (int i = 3; i < 15; i += 2) mt = fmaxf(fmaxf(mt, s[i]), s[i + 1]); \
            mt = half_max(fmaxf(mt, s[15])); \
            if (__any(mt > m)) { const float mn = fmaxf(m, mt), alpha = __builtin_amdgcn_exp2f(m - mn); m = mn; l *= alpha; \
                _Pragma("unroll") for (int i = 0; i < 16; ++i) { o0[i] *= alpha; o1[i] *= alpha; } } \
            float ps = 0.f; \
            _Pragma("unroll") for (int i = 0; i < 16; ++i) { s[i] = __builtin_amdgcn_exp2f(s[i] - m); ps += s[i]; } \
            l += ps; \
            bf16x8 pb[2]; \
            _Pragma("unroll") for (int sk = 0; sk < 2; ++sk) { u32x4 w; w.x = pk2(s[8 * sk], s[8 * sk + 1]); w.y = pk2(s[8 * sk + 2], s[8 * sk + 3]); w.z = pk2(s[8 * sk + 4], s[8 * sk + 5]); w.w = pk2(s[8 * sk + 6], s[8 * sk + 7]); \
                pb[sk] = __builtin_bit_cast(bf16x8, w); } \
            _Pragma("unroll") for (int dt = 0; dt < 2; ++dt) _Pragma("unroll") for (int sk = 0; sk < 2; ++sk) { \
                const v4i16_t lo = __builtin_amdgcn_ds_read_tr16_b64_v4i16((LAS v4i16_t*)((vb_) + sk * (vsk_) + dt * 64)); \
                const v4i16_t hi = __builtin_amdgcn_ds_read_tr16_b64_v4i16((LAS v4i16_t*)((vb_) + sk * (vsk_) + (ve_) + dt * 64)); \
                const bf16x8 va = (bf16x8){lo[0], lo[1], lo[2], lo[3], hi[0], hi[1], hi[2], hi[3]}; \
                if (dt == 0) o0 = __builtin_amdgcn_mfma_f32_32x32x16_bf16(va, pb[sk], o0, 0, 0, 0); else o1 = __builtin_amdgcn_mfma_f32_32x32x16_bf16(va, pb[sk], o1, 0, 0, 0); } } while (0)
            __syncthreads();
#pragma unroll 1
            for (int st = 0; st < nsteps; ++st) {
                const int kr = kmin + st, slot = ATT_RING_OFF + (st & 1) * 16384;
                u32x4 nk, nv; const bool more = st + 1 < nsteps;
                if (more) { const size_t row = (size_t)(b * SEQ + (kr + 1) * 64 + skey) * 512 + h * 64 + 8 * sch; nk = *(const u32x4*)(Kb + row); nv = *(const u32x4*)(Vb + row); }
                if (kr >= rs && kr < rs + 8) {
                    const LAS unsigned char* brow = (const LAS unsigned char*)(rpbL + (kr - r + 7) * 32);
                    f32x16 s;
#pragma unroll
                    for (int i = 0; i < 16; ++i) s[i] = *(const LAS float*)(brow + dco[i]);
                    const LAS unsigned char* kp = lds + slot + g * 4096 + ql * 128; const LAS unsigned char* vb = lds + slot + 8192 + g * 4096 + (4 * hl + vq) * 128 + vcol;
                    ATT_TILE(kp, vb, 2048, 1024, qrot);
                }
                if (more) { const int ns = ATT_RING_OFF + ((st + 1) & 1) * 16384; ATT_PUT(ns, st + 1, nk, nv); }
                __syncthreads();
            }
#pragma unroll 1
            for (int x = 0; x < 2; ++x) {
                const int cb = g == 0 ? 8 : 0, krel0 = rs + 4 * x - kmin;
                f32x16 s;
#pragma unroll
                for (int i = 0; i < 16; ++i) { const int kc = 24 + cb + (i & 3) + 4 * hl, dr = rs + 4 * x + (i >> 2) - r + 7; const bool ok = kc >= cstart && kc < cstart + 16;
                    s[i] = ok ? rpbL[dr * 32 + (kc - cq + 15)] : -1e30f; }
                const LAS unsigned char* kp = lds + ATT_SK_OFF + ((krel0 + (ql >> 3)) * 16 + cb + (ql & 7)) * 128;
                const LAS unsigned char* vb = lds + ATT_SV_OFF + (krel0 * 16 + cb + 4 * hl + vq) * 128 + vcol;
                ATT_TILE(kp, vb, 4096, 2048, qrot);
            }
            __syncthreads();
#pragma unroll 1
            for (int ct = 0; ct < 8; ++ct) { f32x16 s;
#pragma unroll
                for (int i = 0; i < 16; ++i) s[i] = 0.f;
                const LAS unsigned char* kp = lds + ATT_CK_OFF + ct * 4096 + ql * 128; const LAS unsigned char* vb = lds + ATT_CV_OFF + ct * 4096 + (4 * hl + vq) * 128 + vcol;
                ATT_TILE(kp, vb, 2048, 1024, qplain); }
#undef ATT_TILE
#undef ATT_PUT
            l = half_sum(l);
            const float il = 1.0f / l;
#pragma unroll
            for (int dt = 0; dt < 2; ++dt)
#pragma unroll
                for (int g4 = 0; g4 < 4; ++g4) { u32x2 w;
                    if (dt == 0) { w.x = pk2(o0[4 * g4] * il, o0[4 * g4 + 1] * il); w.y = pk2(o0[4 * g4 + 2] * il, o0[4 * g4 + 3] * il); }
                    else { w.x = pk2(o1[4 * g4] * il, o1[4 * g4 + 1] * il); w.y = pk2(o1[4 * g4 + 2] * il, o1[4 * g4 + 3] * il); }
                    *(u32x2*)(op + 32 * dt + 8 * g4 + 4 * hl) = w; }
        }
    }
}

constexpr int LRU_WLDS = 8192;
constexpr int LRU_TILES = 72;
__device__ __forceinline__ void lru_conv_frags(const bf16_t* LX, const float* conv_w, const float* conv_b, size_t rowbase, int L, int s0, int n, int lane, bf16x8 (&afr)[8], bf16_t* XC) {
    const int token = lane & 31, hl = lane >> 5, s = s0 + token;
    u32x4 xr[2][2][4];
#define LRU_LDPAIR(pp, buf) do { _Pragma("unroll") for (int q = 0; q < 2; ++q) _Pragma("unroll") for (int j = 0; j < 4; ++j) { const int sj = s + j - 2; xr[buf][q][j] = (u32x4){0u, 0u, 0u, 0u}; \
        if (sj >= 0 && sj < L) xr[buf][q][j] = *(const u32x4*)(LX + (rowbase + sj) * 1024 + n * 128 + 16 * (2 * (pp) + q) + 8 * hl); } } while (0)
    LRU_LDPAIR(0, 0);
#pragma unroll
    for (int pp = 0; pp < 4; ++pp) {
        if (pp < 3) LRU_LDPAIR(pp + 1, (pp + 1) & 1);
        __builtin_amdgcn_sched_barrier(0);
#pragma unroll
        for (int q = 0; q < 2; ++q) { const int ch0 = n * 128 + 16 * (2 * pp + q) + 8 * hl;
            float acc[8];
            { const f32x4 b0 = *(const f32x4*)(conv_b + ch0), b1 = *(const f32x4*)(conv_b + ch0 + 4); acc[0] = b0.x; acc[1] = b0.y; acc[2] = b0.z; acc[3] = b0.w; acc[4] = b1.x; acc[5] = b1.y; acc[6] = b1.z; acc[7] = b1.w; }
#pragma unroll
            for (int j = 0; j < 4; ++j) { float xv[8]; unpack8(xr[pp & 1][q][j], xv);
                const f32x4 w0 = *(const f32x4*)(conv_w + j * 1024 + ch0), w1 = *(const f32x4*)(conv_w + j * 1024 + ch0 + 4);
                acc[0] += w0.x * xv[0]; acc[1] += w0.y * xv[1]; acc[2] += w0.z * xv[2]; acc[3] += w0.w * xv[3]; acc[4] += w1.x * xv[4]; acc[5] += w1.y * xv[5]; acc[6] += w1.z * xv[6]; acc[7] += w1.w * xv[7]; }
            const u32x4 pk = pack8(acc); afr[2 * pp + q] = __builtin_bit_cast(bf16x8, pk);
            if (XC) *(u32x4*)(XC + (rowbase + s) * 1024 + ch0) = pk; }
        __builtin_amdgcn_sched_barrier(0);
    }
#undef LRU_LDPAIR
}
template <int DIR>
__device__ __forceinline__ void lru_group_dir(const f32x16& accr, const f32x16& acci, const f32x16& xv, float bav, float bxv, float sp, float hin0, int hl, float (&hloc)[16], float& At, float& Ht) {
    float aloc[16], As[4], Hs[4];
#pragma unroll
    for (int g = 0; g < 4; ++g) { float h = 0.f, A = 1.f;
#pragma unroll
        for (int ee = 0; ee < 4; ++ee) { const int e4 = DIR == 0 ? ee : 3 - ee, i = 4 * g + e4;
            const float rg = __builtin_amdgcn_rcpf(1.0f + __builtin_amdgcn_exp2f(accr[i] + bav)), ig = __builtin_amdgcn_rcpf(1.0f + __builtin_amdgcn_exp2f(acci[i] + bxv));
            const float a = __builtin_amdgcn_exp2f(rg * sp), u = __builtin_amdgcn_sqrtf(__builtin_fmaf(-a, a, 1.0f)) * (ig * xv[i]);
            h = a * h + u; A *= a; hloc[i] = h; aloc[i] = A; }
        As[g] = A; Hs[g] = h; }
    float Alo[4], Ahi[4], Hlo[4], Hhi[4];
#pragma unroll
    for (int g = 0; g < 4; ++g) { const auto ra = __builtin_amdgcn_permlane32_swap(__float_as_uint(As[g]), __float_as_uint(As[g]), false, false); Alo[g] = __uint_as_float(ra[0]); Ahi[g] = __uint_as_float(ra[1]);
        const auto rh = __builtin_amdgcn_permlane32_swap(__float_as_uint(Hs[g]), __float_as_uint(Hs[g]), false, false); Hlo[g] = __uint_as_float(rh[0]); Hhi[g] = __uint_as_float(rh[1]); }
    float hin[4]; float st = hin0, Ap = 1.f, st0 = 0.f;
#pragma unroll
    for (int gg = 0; gg < 4; ++gg) { const int g = DIR == 0 ? gg : 3 - gg;
        const float A1 = DIR == 0 ? Alo[g] : Ahi[g], H1 = DIR == 0 ? Hlo[g] : Hhi[g], A2 = DIR == 0 ? Ahi[g] : Alo[g], H2 = DIR == 0 ? Hhi[g] : Hlo[g];
        const float in1 = st; st = A1 * st + H1; st0 = A1 * st0 + H1; const float in2 = st; st = A2 * st + H2; st0 = A2 * st0 + H2; Ap *= A1 * A2;
        hin[g] = (DIR == 0) == (hl == 0) ? in1 : in2; }
    At = Ap; Ht = st0;
#pragma unroll
    for (int i = 0; i < 16; ++i) hloc[i] += aloc[i] * hin[i >> 2];
}
constexpr int LRU_CONST_OFF = 131072;
template <int MODE>
__device__ __forceinline__ void p_lru(const bf16_t* LX, const bf16_t* LW, const float* conv_w, const float* conv_b, const float* ba, const float* bx, const float* SP, f32x2* AGG, bf16_t* XC, const bf16_t* LG, bf16_t* OL,
                                      LAS unsigned char* lds, int wave, int lane) {
    constexpr int abl = 0;
    const int G = gridDim.x, n = blockIdx.x & 7, ql = lane & 31, hl = lane >> 5, tid = wave * 64 + lane;
    LAS float* cst = (LAS float*)(lds + LRU_CONST_OFF);
    {
        u32x4 t[16]; float cv[2];
#pragma unroll
        for (int it = 0; it < 16; ++it) { const int idx = tid + it * NTHREADS, dir = idx >> 12, j = (idx >> 4) & 255, c = idx & 15; t[it] = *(const u32x4*)(LW + ((size_t)(dir * 8 + n) * 256 + j) * 128 + 8 * c); }
#pragma unroll
        for (int it = 0; it < 2; ++it) { const int idx = tid + it * NTHREADS, dir = idx / 384, w = (idx / 128) % 3, c = idx & 127; const float* src = w == 0 ? ba : w == 1 ? bx : SP; cv[it] = 0.f;
            if (idx < 2 * 3 * 128) cv[it] = src[dir * 1024 + n * 128 + c] * (w == 2 ? -8.0f * 1.4426950408889634f : -1.4426950408889634f); }
#pragma unroll
        for (int it = 0; it < 16; ++it) { const int idx = tid + it * NTHREADS, dir = idx >> 12, j = (idx >> 4) & 255, c = idx & 15; *(LAS u32x4*)(lds + (dir * 256 + j) * 256 + ((c ^ (j & 15)) * 16)) = t[it]; }
#pragma unroll
        for (int it = 0; it < 2; ++it) { const int idx = tid + it * NTHREADS; if (idx < 2 * 3 * 128) cst[idx] = cv[it]; }
    }
    __syncthreads();
    const int tiles_per_b = MODE == 1 ? LRU_TILES : 64, nq = 16 * tiles_per_b, stride = (G >> 3) * NWAVES;
    for (int q = (blockIdx.x >> 3) * NWAVES + wave; q < nq; q += stride) {
        const int b = q / tiles_per_b, tile = MODE == 1 ? q % tiles_per_b : 8 + q % tiles_per_b;
        const size_t rowbase = tile < 8 ? (size_t)(TL + b * CTXL) : (size_t)b * SEQ; const int L = tile < 8 ? CTXL : SEQ, s0 = tile < 8 ? tile * 32 : (tile - 8) * 32;
        bf16x8 afr[8];
        if (MODE == 1) lru_conv_frags(LX, conv_w, conv_b, rowbase, L, s0, n, lane, afr, XC);
        else {
#pragma unroll
            for (int ks = 0; ks < 8; ++ks) afr[ks] = *(const bf16x8*)(XC + (abl == 4 ? (size_t)ql * 1024 : (rowbase + s0 + ql) * 1024 + n * 128) + 16 * ks + 8 * hl); }
#pragma unroll 1
        for (int cg = 0; cg < 4; ++cg) {
            const bf16x8 ax0 = cg == 0 ? afr[0] : cg == 1 ? afr[2] : cg == 2 ? afr[4] : afr[6], ax1 = cg == 0 ? afr[1] : cg == 1 ? afr[3] : cg == 2 ? afr[5] : afr[7];
            const int cl = cg * 32 + ql;
            float hinf = 0.f, hinb = 0.f;
            if (MODE == 2) { hinf = AGG[((size_t)b * LRU_TILES + tile) * 1024 + n * 128 + cl].x; hinb = AGG[((size_t)(16 + b) * LRU_TILES + tile) * 1024 + n * 128 + cl].x; }
            unsigned short gq[16];
            if (MODE == 2) {
#pragma unroll
                for (int i = 0; i < 16; ++i) gq[i] = LG[(rowbase + s0 + (i & 3) + 8 * (i >> 2) + 4 * hl) * 1024 + n * 128 + cl];
                __builtin_amdgcn_sched_barrier(0); }
            f32x16 xv;
#pragma unroll
            for (int i = 0; i < 16; ++i) xv[i] = 0.f;
            { bf16x8 idf[2];
#pragma unroll
              for (int kk = 0; kk < 2; ++kk)
#pragma unroll
                  for (int j = 0; j < 8; ++j) idf[kk][j] = (16 * kk + 8 * hl + j == ql) ? (short)0x3F80 : (short)0;
              xv = __builtin_amdgcn_mfma_f32_32x32x16_bf16(ax0, idf[0], xv, 0, 0, 0); xv = __builtin_amdgcn_mfma_f32_32x32x16_bf16(ax1, idf[1], xv, 0, 0, 0); }
            float hsum[16];
#pragma unroll
            for (int dir = 0; dir < 2; ++dir) {
                const LAS unsigned char* wr = lds + (dir * 256 + cl) * 256; const LAS unsigned char* wi = wr + 128 * 256;
                f32x16 accr, acci;
#pragma unroll
                for (int i = 0; i < 16; ++i) { accr[i] = 0.f; acci[i] = 0.f; }
                if (abl != 2) { bf16x8 bw[8];
#pragma unroll
                  for (int k = 0; k < 8; ++k) bw[k] = *(const LAS bf16x8*)(wr + (((2 * k + hl) ^ (cl & 15)) * 16));
#pragma unroll
                  for (int k = 0; k < 8; ++k) accr = __builtin_amdgcn_mfma_f32_32x32x16_bf16(afr[k], bw[k], accr, 0, 0, 0);
                  __builtin_amdgcn_sched_barrier(0);
#pragma unroll
                  for (int k = 0; k < 8; ++k) bw[k] = *(const LAS bf16x8*)(wi + (((2 * k + hl) ^ (cl & 15)) * 16));
#pragma unroll
                  for (int k = 0; k < 8; ++k) acci = __builtin_amdgcn_mfma_f32_32x32x16_bf16(afr[k], bw[k], acci, 0, 0, 0); }
                __builtin_amdgcn_sched_barrier(0);
                const float bav = cst[dir * 384 + cl], bxv = cst[dir * 384 + 128 + cl], sp = cst[dir * 384 + 256 + cl];
                const float hin0 = dir == 0 ? hinf : hinb;
                float hout[16], At, Ht;
                if (abl == 1) { _Pragma("unroll") for (int i = 0; i < 16; ++i) hout[i] = accr[i] + acci[i] * xv[i] + hin0 + bav + bxv + sp; At = 1.f; Ht = 0.f; }
                else if (dir == 0) lru_group_dir<0>(accr, acci, xv, bav, bxv, sp, hin0, hl, hout, At, Ht);
                else lru_group_dir<1>(accr, acci, xv, bav, bxv, sp, hin0, hl, hout, At, Ht);
                if (MODE == 1) { if (hl == 0) AGG[((size_t)(dir * 16 + b) * LRU_TILES + tile) * 1024 + n * 128 + cl] = (f32x2){At, Ht}; }
                else {
#pragma unroll
                    for (int i = 0; i < 16; ++i) hsum[i] = dir == 0 ? hout[i] : hsum[i] + hout[i]; }
            }
            if (MODE == 2) {
                if (abl == 3) { float t_ = 0.f; _Pragma("unroll") for (int i = 0; i < 16; ++i) t_ += hsum[i]; if (t_ == 123.456f) OL[0] = 0; }
                else {
#pragma unroll
                for (int i = 0; i < 16; ++i) OL[(rowbase + s0 + (i & 3) + 8 * (i >> 2) + 4 * hl) * 1024 + n * 128 + cl] = (bf16_t)f2bf(hsum[i] * bf2f(gq[i]));
                }
            }
        }
    }
}
__device__ __forceinline__ void p_lru_carry(f32x2* AGG, int tid) {
    const int gid = blockIdx.x * NTHREADS + tid;
    if (gid >= 2 * 16 * 1024) return;
    const int dir = gid >> 14, b = (gid >> 10) & 15, ch = gid & 1023;
    f32x2* base = AGG + (size_t)(dir * 16 + b) * LRU_TILES * 1024 + ch;
    float h = 0.f;
#pragma unroll 1
    for (int s0 = 0; s0 < LRU_TILES; s0 += 24) {
        f32x2 v[24];
#pragma unroll
        for (int s = 0; s < 24; ++s) { const int st = s0 + s, tile = dir == 0 ? st : (st < 8 ? 7 - st : 79 - st); v[s] = base[(size_t)tile * 1024]; }
#pragma unroll
        for (int s = 0; s < 24; ++s) { const int st = s0 + s, tile = dir == 0 ? st : (st < 8 ? 7 - st : 79 - st); base[(size_t)tile * 1024].x = h; h = v[s].x * h + v[s].y; }
    }
}

__device__ __forceinline__ unsigned char* lds_ptr(LAS unsigned char* ldsl, int i) {
    const LAS unsigned* t = (const LAS unsigned*)(ldsl + MISC_OFF + 1024) + 2 * i;
    const unsigned lo = __builtin_amdgcn_readfirstlane(t[0]), hi = __builtin_amdgcn_readfirstlane(t[1]);
    return (unsigned char*)(__attribute__((address_space(1))) unsigned char*)(((unsigned long long)hi << 32) | lo);
}
struct MArgs { const float* in[28]; float* out; unsigned char* ws; int ph_lo, ph_hi, li, extra; };
__global__ void __launch_bounds__(NTHREADS, 2) mega(MArgs a) {
    extern __shared__ __attribute__((aligned(16))) unsigned char lds[];
    const int wave = __builtin_amdgcn_readfirstlane(threadIdx.x >> 6);
#define LANE ((int)__builtin_amdgcn_mbcnt_hi(~0u, __builtin_amdgcn_mbcnt_lo(~0u, 0u)))
#define TID (wave * 64 + LANE)
    const int G = gridDim.x, gw = blockIdx.x * NWAVES + wave, ngw = G * NWAVES;
    LAS unsigned char* ldsl = (LAS unsigned char*)lds;
    volatile LAS unsigned* MISC = (volatile LAS unsigned*)(ldsl + MISC_OFF);
    for (int u = TID; u < (LDS_BYTES - MISC_OFF) / 4; u += NTHREADS) ((LAS unsigned*)(ldsl + MISC_OFF))[u] = 0u;
    __syncthreads();
    { LAS unsigned long long* pt = (LAS unsigned long long*)(ldsl + MISC_OFF + 1024);
      const int tid = TID;
      if (tid < 28) pt[tid] = (unsigned long long)a.in[tid];
      if (tid == 28) pt[28] = (unsigned long long)(a.extra ? (float*)(a.ws + WS_XB) : a.out);
      if (tid == 29) pt[29] = (unsigned long long)a.ws; }
    XcdBarrier bar = xcd_barrier_post((unsigned*)(a.ws + WS_CTL) + CW_BAR + a.li * XCD_BAR_WORDS, MISC + 8, wave == 0 && LANE == 0);
    const int lo = a.ph_lo, hi = a.ph_hi, extra = a.extra;
    __syncthreads();
#define PTR(i) ((const float*)lds_ptr(ldsl, (i)))
#define OUTP ((float*)lds_ptr(ldsl, 28))
#define WSP(off) (lds_ptr(ldsl, 29) + (off))
#define IN(k) (lo <= (k) && (k) < hi)
#define SEAM(k) do { if (IN(k) && IN((k) + 1)) xcd_barrier(bar, wave); } while (0)
    if (IN(0)) { unsigned char* ws = WSP(0); p0_prep(ws, ldsl, gw, ngw, LANE, wave); __syncthreads();
        p0_mod(PTR(1), PTR(3), PTR(4), PTR(5), PTR(20), PTR(22), (f32x4*)(ws + WS_MOD + 600 * 1024), PTR(16), (float*)(ws + WS_MOD + 760 * 1024), (float*)(ws + WS_MOD), (f32x2*)(ws + WS_MOD + 512 * 1024), (LAS float*)ldsl, TID); }
    SEAM(0);
    if (IN(1)) { unsigned char* ws = WSP(0); p1_router_tables(PTR(7), (const float*)(ws + WS_MOD), (const f32x4*)(ws + WS_MOD + 600 * 1024), PTR(21), PTR(23), (float*)(ws + WS_RWT), (float*)(ws + WS_RWT + 3 * MiB), gw, ngw, LANE);
        p1_adanorm(PTR(0), PTR(2), PTR(6), (const float*)(ws + WS_MOD), (bf16_t*)OUTP, gw, ngw, LANE); }
    SEAM(1);
    if (IN(2)) { unsigned char* ws = WSP(0); pg8::Gemm g{(const bf16_t*)OUTP, (const bf16_t*)(ws + WS_WIN), TALL, PROJ, 1024}; ProjOrder S; S.init(G, (int)blockIdx.x);
        EpiF<EpiProj> E{{(bf16_t*)(ws + WS_K), (bf16_t*)(ws + WS_V), (bf16_t*)(ws + WS_LX), (bf16_t*)(ws + WS_Q), (bf16_t*)(ws + WS_LG), ws + WS_GA, ws + WS_GB, (const f32x2*)(ws + WS_MOD + 512 * 1024)}};
        pg8::gemm_phase<EpiF<EpiProj>, ProjOrder, true, true>(ldsl, g, S, E, wave); }
    SEAM(2);
    if (IN(3)) { unsigned char* ws = WSP(0); bf16_t* LGb = (bf16_t*)(ws + WS_LG);
        p_lru<1>((const bf16_t*)(ws + WS_LX), (const bf16_t*)(ws + WS_LW), PTR(10), PTR(11), PTR(13), PTR(15), (const float*)(ws + WS_MOD + 760 * 1024), (f32x2*)OUTP, (bf16_t*)((unsigned char*)OUTP + 24 * MiB), LGb, LGb, ldsl, wave, LANE);
        __syncthreads(); }
    if (IN(3) || extra == 2) { unsigned char* ws = WSP(0); bf16_t* Qb = (bf16_t*)(ws + WS_Q);
        p3_attn(Qb, Qb, (const bf16_t*)(ws + WS_K), (const bf16_t*)(ws + WS_V), PTR(9), (const f32x2*)(ws + WS_MOD + 512 * 1024), ldsl, wave, LANE); }
    SEAM(3);
    if (IN(4)) p_lru_carry((f32x2*)OUTP, TID);
    if (IN(4)) { unsigned char* ws = WSP(0); pg8::Gemm g{(const bf16_t*)(ws + WS_Q), (const bf16_t*)(ws + WS_WA), TL, 1024, 512}; pg8::StaticOrder S; S.init(TL, 1024, G, (int)blockIdx.x); EpiF2<EpiUpAttn> E{{ws + WS_GA, (bf16_t*)(ws + WS_Y)}};
        pg8::gemm_phase<EpiF2<EpiUpAttn>, pg8::StaticOrder, true, true>(ldsl, g, S, E, wave); }
    SEAM(4);
    if (IN(5)) { unsigned char* ws = WSP(0); bf16_t* LGb = (bf16_t*)(ws + WS_LG);
        p_lru<2>((const bf16_t*)(ws + WS_LX), (const bf16_t*)(ws + WS_LW), PTR(10), PTR(11), PTR(13), PTR(15), (const float*)(ws + WS_MOD + 760 * 1024), (f32x2*)OUTP, (bf16_t*)((unsigned char*)OUTP + 24 * MiB), LGb, LGb, ldsl, wave, LANE); }
    SEAM(5);
    if (IN(6)) { unsigned char* ws = WSP(0); bf16_t* Yb = (bf16_t*)(ws + WS_Y); pg8::Gemm g{(const bf16_t*)(ws + WS_LG), (const bf16_t*)(ws + WS_WL), TL, 1024, 1024}; pg8::StaticOrder S; S.init(TL, 1024, G, (int)blockIdx.x);
        EpiF2<EpiUpLru> E{{Yb, ws + WS_GB, Yb}};
        pg8::gemm_phase<EpiF2<EpiUpLru>, pg8::StaticOrder, true, true>(ldsl, g, S, E, wave); }
    SEAM(6);
    if (IN(7)) { unsigned char* ws = WSP(0); pg8::Gemm g{(const bf16_t*)(ws + WS_Y), (const bf16_t*)(ws + WS_WO), TL, 1024, 1024}; pg8::StaticOrder S; S.init(TL, 1024, G, (int)blockIdx.x);
        EpiF2<EpiOut> E{{PTR(0), (const float*)(ws + WS_MOD), (bf16_t*)(ws + WS_X1B)}};
        pg8::gemm_phase<EpiF2<EpiOut>, pg8::StaticOrder, true, true>(ldsl, g, S, E, wave); }
    SEAM(7);
    if (IN(8)) { unsigned char* ws = WSP(0);
        p8_route((const bf16_t*)(ws + WS_X1B), (const float*)(ws + WS_RWT), (const float*)(ws + WS_RWT + 3 * MiB), (unsigned*)(ws + WS_CTL), (int*)(ws + WS_TOK), ldsl, LANE, TID, wave); }
    SEAM(8);
    if (IN(9)) { unsigned char* ws = WSP(0); p9_scatter((const bf16_t*)(ws + WS_X1B), PTR(7), (const float*)(ws + WS_MOD), (unsigned*)(ws + WS_CTL), (int*)(ws + WS_TOK), (bf16_t*)(ws + WS_XB), (LAS unsigned*)ldsl, gw, ngw, LANE, TID); }
    SEAM(9);
    if (IN(10)) { unsigned char* ws = WSP(0); pg8::Gemm g{(const bf16_t*)(ws + WS_XB), (const bf16_t*)(ws + WS_W13), MOE_ROWS, 1024, 1024}; MoeOrder S; S.init((const unsigned*)(ws + WS_CTL), G, (int)blockIdx.x, (size_t)1024 * 1024 * 2);
        EpiF<EpiMoe1> E{{(bf16_t*)OUTP}};
        pg8::gemm_phase<EpiF<EpiMoe1>, MoeOrder, true, true>(ldsl, g, S, E, wave); }
    SEAM(10);
    if (IN(11)) { unsigned char* ws = WSP(0); pg8::Gemm g{(const bf16_t*)OUTP, (const bf16_t*)(ws + WS_W2), MOE_ROWS, 1024, 512}; MoeOrder S; S.init((const unsigned*)(ws + WS_CTL), G, (int)blockIdx.x, (size_t)1024 * 512 * 2);
        EpiF<EpiMoe2> E{{(bf16_t*)(ws + WS_YB)}};
        pg8::gemm_phase<EpiF<EpiMoe2>, MoeOrder, true, true>(ldsl, g, S, E, wave); }
    SEAM(11);
    if (IN(12)) { unsigned char* ws = WSP(0); p12_final((const bf16_t*)(ws + WS_X1B), OUTP, (const float*)(ws + WS_MOD), (const int*)(ws + WS_TOK), (const bf16_t*)(ws + WS_YB), PTR(27), gw, ngw, LANE); }
#undef PTR
#undef OUTP
#undef WSP
#undef LANE
#undef TID
#undef IN
#undef SEAM
}

extern "C" void kernel_launch(void* const* d_in, const int* in_sizes, int n_in, void* d_out, int out_size, void* d_ws, size_t ws_size, hipStream_t stream) {
    static int grid = 0;
    if (grid == 0) {
        if (n_in != 28 || out_size != TL * D || ws_size < WS_END) { fprintf(stderr, "kernel_launch: unexpected problem (n_in %d, out %d, ws %zu < %zu)\n", n_in, out_size, ws_size, (size_t)WS_END); grid = -1; return; }
        int dev = 0, cus = 0, per_cu = 0;
        if (hipGetDevice(&dev) != hipSuccess || hipDeviceGetAttribute(&cus, hipDeviceAttributeMultiprocessorCount, dev) != hipSuccess) { grid = -1; return; }
        if (hipFuncSetAttribute((const void*)mega, hipFuncAttributeMaxDynamicSharedMemorySize, LDS_BYTES) != hipSuccess) { fprintf(stderr, "kernel_launch: hipFuncSetAttribute failed\n"); grid = -1; return; }
        if (hipOccupancyMaxActiveBlocksPerMultiprocessor(&per_cu, (const void*)mega, NTHREADS, LDS_BYTES) != hipSuccess || per_cu < 1) { fprintf(stderr, "kernel_launch: occupancy query says %d blocks per CU\n", per_cu); grid = -1; return; }
        (void)hipGetLastError();
        grid = cus;
    }
    if (grid < 0) return;
    const float* const* in = (const float* const*)d_in;
    unsigned char* ws = (unsigned char*)d_ws; float* out = (float*)d_out;
    (void)hipMemsetAsync(ws + WS_CTL, 0, CTL_ZERO_BYTES, stream);
    MArgs a{};
    for (int i = 0; i < 28; ++i) a.in[i] = in[i];
    a.out = out; a.ws = ws;
    auto launch = [&](int lo, int hi, int li, int extra) {
        a.ph_lo = lo; a.ph_hi = hi; a.li = li; a.extra = extra; void* args[] = {&a};
        const hipError_t e = hipLaunchCooperativeKernel((const void*)mega, dim3(grid), dim3(NTHREADS), args, LDS_BYTES, stream);
        if (e != hipSuccess) fprintf(stderr, "kernel_launch: cooperative launch failed: %s (grid %d)\n", hipGetErrorString(e), grid);
    };
    launch(0, 13, 0, 0);
    EXTRA_LAUNCHES
}
```

```cpp
#include <hip/hip_runtime.h>
#include <cstdio>
#include <cstdint>

typedef float f32x2 __attribute__((ext_vector_type(2)));
typedef unsigned u32x2 __attribute__((ext_vector_type(2)));
#define EXTRA_LAUNCHES
namespace pg8 {
#define PG8_LAS __attribute__((address_space(3)))
typedef unsigned short bf16_t;
typedef short bf16x8 __attribute__((ext_vector_type(8)));
typedef float f32x4 __attribute__((ext_vector_type(4)));
typedef unsigned u32x4 __attribute__((ext_vector_type(4)));
constexpr int BM = 256, BK = 64, HALF = 128, HTB = HALF * BK * 2  , STAGE_BYTES = 8 * HTB, NXCD = 8, WGM = 8;

__host__ __device__ __forceinline__ int lds_byte(int r, int c) { const int st = (r >> 4) * 2 + (c >> 5), rr = r & 15, cc = c & 31, ob = rr * 64 + cc * 2; return st * 1024 + (ob ^ (((ob >> 9) & 1) << 5)); }
__host__ __device__ __forceinline__ void stage_rc(int b, int& R, int& C) { const int st = b / 1024, sb = b % 1024, swz = sb ^ (((sb >> 9) & 1) << 5); R = (st >> 1) * 16 + swz / 64; C = (st & 1) * 32 + (swz % 64) / 2; }
__host__ __device__ __forceinline__ int perm32(int rho) { const int n = rho >> 4, i = rho & 15; return 8 * (i >> 2) + 4 * n + (i & 3); }

struct Unit { int pm, pn; size_t bofs; };
struct Gemm { const bf16_t* A; const bf16_t* Bt; int M, N, K; };

struct StaticOrder {
    int nM, nN, nwg, G, c;
    __host__ __device__ __forceinline__ void init(int M, int N, int G_, int c_) { nM = M / BM; nN = N / BM; nwg = nM * nN; G = G_; c = c_; }
    __host__ __device__ __forceinline__ bool next(int i, Unit& u) const {
        const long L = (long)i * G + c; if (L >= nwg) return false;
        int wgid = (int)L; { const int q = nwg / NXCD, r = nwg % NXCD, xcd = wgid % NXCD, off = wgid / NXCD; wgid = (xcd < r ? xcd * (q + 1) : r * (q + 1) + (xcd - r) * q) + off; }
        const int nig = WGM * nN, gid = wgid / nig, fm = gid * WGM, gsz = (nM - fm) < WGM ? (nM - fm) : WGM;
        u.pm = fm + ((wgid % nig) % gsz); u.pn = (wgid % nig) / gsz; u.bofs = 0; return true;
    }
    __device__ __forceinline__ void a_ready(const Unit&) const {}
    __device__ __forceinline__ void done(const Unit&) const {}
};


template <class Epi, class Sched, bool ALIGN_EPI = false, bool SP2 = false>
__device__ __forceinline__ void gemm_phase(PG8_LAS unsigned char* lds, const Gemm g, const Sched& S, const Epi& E, int wid) {
    const int lane = (int)__builtin_amdgcn_mbcnt_hi(~0u, __builtin_amdgcn_mbcnt_lo(~0u, 0u)), tid = wid * 64 + lane, wr = wid >> 2, wc = wid & 3, fr = lane & 15, fq = lane >> 4;
    const int K = g.K, nt = K / BK;
    unsigned voffA[2], voffB[2];
#pragma unroll
    for (int i = 0; i < 2; ++i) { int R, C; stage_rc(tid * 16 + i * 8192, R, C); const int Rb = Epi::PERM ? ((R & ~31) + perm32(R & 31)) : R;
        voffA[i] = (unsigned)(R * K + C) * 2u; voffB[i] = (unsigned)(Rb * K + C) * 2u; }
    const size_t kstep = (size_t)(BK * 2);
    const size_t hstep = (size_t)HALF * K * 2;
    const size_t tstep = 2 * hstep;
    const unsigned ldsw = (unsigned)wid * 1024u;
    const int aoff = lds_byte(wr * 64 + fr, fq * 8), boff = lds_byte(wc * 32 + fr, fq * 8);
#define PG8_SA(b, h) (((b) * 2 + (h)) * HTB)
#define PG8_SB(b, h) ((4 + (b) * 2 + (h)) * HTB)
#define PG8_STAGE(bufoff, gbase, voff) do { _Pragma("unroll") for (int _i = 0; _i < 2; ++_i) \
        __builtin_amdgcn_global_load_lds((const unsigned*)((const char*)(gbase) + (voff)[_i]), (PG8_LAS unsigned*)(lds + (bufoff) + ldsw + _i * 8192), 16, 0, 0); } while (0)
#define PG8_LDA(dst, b, h) do { _Pragma("unroll") for (int m = 0; m < 4; ++m) _Pragma("unroll") for (int k = 0; k < 2; ++k) dst[m][k] = *(const PG8_LAS bf16x8*)(lds + PG8_SA(b, h) + aoff + m * 2048 + k * 1024); } while (0)
#define PG8_LDB(dst, b, h) do { _Pragma("unroll") for (int n = 0; n < 2; ++n) _Pragma("unroll") for (int k = 0; k < 2; ++k) dst[n][k] = *(const PG8_LAS bf16x8*)(lds + PG8_SB(b, h) + boff + n * 2048 + k * 1024); } while (0)
#define PG8_MMA(ai, bj, At, Bt) do { __builtin_amdgcn_s_setprio(1); _Pragma("unroll") for (int m = 0; m < 4; ++m) _Pragma("unroll") for (int n = 0; n < 2; ++n) _Pragma("unroll") for (int k = 0; k < 2; ++k) \
        acc[ai][bj][m][n] = __builtin_amdgcn_mfma_f32_16x16x32_bf16(Bt[n][k], At[m][k], acc[ai][bj][m][n], 0, 0, 0); __builtin_amdgcn_s_setprio(0); } while (0)
#define PG8_WAIT_V(n) asm volatile("s_waitcnt vmcnt(" #n ")" ::: "memory")
#define PG8_WAIT_L(n) asm volatile("s_waitcnt lgkmcnt(" #n ")" ::: "memory")
#define PG8_BAR __builtin_amdgcn_s_barrier()
#define PG8_SCHED __builtin_amdgcn_sched_barrier(0)
    Unit cur, nxt; int ui = 0;
    if (!S.next(0, cur)) return;
    f32x4 acc[2][2][4][2];
#pragma unroll
    for (int a = 0; a < 2; ++a)
#pragma unroll
        for (int b = 0; b < 2; ++b)
#pragma unroll
            for (int m = 0; m < 4; ++m)
#pragma unroll
                for (int n = 0; n < 2; ++n) acc[a][b][m][n] = (f32x4){0.f, 0.f, 0.f, 0.f};
    bf16x8 At[4][2], B0[2][2], B1[2][2];
    const char* cA = (const char*)g.A + (size_t)cur.pm * tstep; const char* cB = (const char*)g.Bt + (size_t)cur.pn * tstep + cur.bofs;
    S.a_ready(cur);
    if constexpr (SP2) {
        PG8_STAGE(PG8_SB(0, 0), cB, voffB); PG8_STAGE(PG8_SB(0, 1), cB + hstep, voffB); PG8_STAGE(PG8_SA(0, 0), cA, voffA); PG8_STAGE(PG8_SA(0, 1), cA + hstep, voffA);
        if (wr == 1) PG8_BAR;
        PG8_WAIT_V(2); PG8_BAR;
        PG8_STAGE(PG8_SB(1, 0), cB + kstep, voffB); PG8_STAGE(PG8_SA(1, 0), cA + kstep, voffA); PG8_STAGE(PG8_SB(1, 1), cB + hstep + kstep, voffB);
        PG8_WAIT_V(6); PG8_BAR;
    } else {
        PG8_STAGE(PG8_SB(0, 0), cB, voffB); PG8_STAGE(PG8_SA(0, 0), cA, voffA); PG8_STAGE(PG8_SB(0, 1), cB + hstep, voffB); PG8_STAGE(PG8_SA(0, 1), cA + hstep, voffA);
        if (wr == 1) PG8_BAR;
        PG8_WAIT_V(4); PG8_BAR;
        PG8_STAGE(PG8_SB(1, 0), cB + kstep, voffB); PG8_STAGE(PG8_SA(1, 0), cA + kstep, voffA); PG8_STAGE(PG8_SB(1, 1), cB + hstep + kstep, voffB);
        PG8_WAIT_V(6); PG8_BAR;
    }
    for (;;) {
        const bool has_next = S.next(ui + 1, nxt);
        const char* nA = has_next ? (const char*)g.A + (size_t)nxt.pm * tstep : cA; const char* nB = has_next ? (const char*)g.Bt + (size_t)nxt.pn * tstep + nxt.bofs : cB;
        for (int t = 0; t < nt; t += 2) {
            const bool last = (t == nt - 2);
            const char* a1 = cA + (size_t)(t + 1) * kstep;
            const char* a2 = last ? nA : cA + (size_t)(t + 2) * kstep; const char* b2 = last ? nB : cB + (size_t)(t + 2) * kstep;
            const char* a3 = a2 + kstep; const char* b3 = b2 + kstep;
            if (last && has_next) S.a_ready(nxt);
            if constexpr (SP2) {
            PG8_LDB(B0, 0, 0); PG8_LDB(B1, 0, 1); PG8_SCHED; PG8_LDA(At, 0, 0); PG8_STAGE(PG8_SA(1, 1), a1 + hstep, voffA);
            PG8_WAIT_V(8); PG8_WAIT_L(0); PG8_BAR; PG8_MMA(0, 0, At, B0); PG8_MMA(0, 1, At, B1); PG8_BAR; PG8_SCHED;
            PG8_LDA(At, 0, 1); PG8_STAGE(PG8_SB(0, 0), b2, voffB); PG8_STAGE(PG8_SB(0, 1), b2 + hstep, voffB); PG8_STAGE(PG8_SA(0, 0), a2, voffA);
            PG8_WAIT_V(8); PG8_WAIT_L(0); PG8_BAR; PG8_MMA(1, 0, At, B0); PG8_MMA(1, 1, At, B1); PG8_BAR; PG8_SCHED;
            PG8_LDB(B0, 1, 0); PG8_LDB(B1, 1, 1); PG8_SCHED; PG8_LDA(At, 1, 0); PG8_STAGE(PG8_SA(0, 1), a2 + hstep, voffA);
            PG8_WAIT_V(8); PG8_WAIT_L(0); PG8_BAR; PG8_MMA(0, 0, At, B0); PG8_MMA(0, 1, At, B1); PG8_BAR; PG8_SCHED;
            PG8_LDA(At, 1, 1); PG8_STAGE(PG8_SB(1, 0), b3, voffB); PG8_STAGE(PG8_SB(1, 1), b3 + hstep, voffB); PG8_STAGE(PG8_SA(1, 0), a3, voffA);
            PG8_WAIT_V(8); PG8_WAIT_L(0); PG8_BAR; PG8_MMA(1, 0, At, B0); PG8_MMA(1, 1, At, B1); PG8_BAR; PG8_SCHED;
            } else {
            PG8_LDB(B0, 0, 0); PG8_SCHED; PG8_LDA(At, 0, 0); PG8_STAGE(PG8_SA(1, 1), a1 + hstep, voffA);
            PG8_WAIT_L(8); PG8_BAR; PG8_WAIT_L(0); PG8_MMA(0, 0, At, B0); PG8_BAR; PG8_SCHED;
            PG8_LDB(B1, 0, 1); PG8_STAGE(PG8_SB(0, 0), b2, voffB);
            PG8_BAR; PG8_WAIT_L(0); PG8_MMA(0, 1, At, B1); PG8_BAR;
            PG8_LDA(At, 0, 1); PG8_STAGE(PG8_SA(0, 0), a2, voffA);
            PG8_BAR; PG8_WAIT_L(0); PG8_MMA(1, 0, At, B0); PG8_BAR; PG8_SCHED;
            PG8_STAGE(PG8_SB(0, 1), b2 + hstep, voffB);
            PG8_WAIT_V(6); PG8_BAR; PG8_MMA(1, 1, At, B1); PG8_BAR;
            PG8_LDB(B0, 1, 0); PG8_SCHED; PG8_LDA(At, 1, 0); PG8_STAGE(PG8_SA(0, 1), a2 + hstep, voffA);
            PG8_WAIT_L(8); PG8_BAR; PG8_WAIT_L(0); PG8_MMA(0, 0, At, B0); PG8_BAR; PG8_SCHED;
            PG8_LDB(B1, 1, 1); PG8_STAGE(PG8_SB(1, 0), b3, voffB);
            PG8_BAR; PG8_WAIT_L(0); PG8_MMA(0, 1, At, B1); PG8_BAR;
            PG8_LDA(At, 1, 1); PG8_STAGE(PG8_SA(1, 0), a3, voffA);
            PG8_BAR; PG8_WAIT_L(0); PG8_MMA(1, 0, At, B0); PG8_BAR; PG8_SCHED;
            PG8_STAGE(PG8_SB(1, 1), b3 + hstep, voffB);
            PG8_WAIT_V(6); PG8_BAR; PG8_MMA(1, 1, At, B1); PG8_BAR;
            }
        }
        if constexpr (ALIGN_EPI) { if (wr == 0) PG8_BAR; }
        if constexpr (!Epi::AFTER_DRAIN) { E(acc, cur, wr, wc, fr, fq); S.done(cur); }
        if (!has_next) break;
#pragma unroll
        for (int a = 0; a < 2; ++a)
#pragma unroll
            for (int b = 0; b < 2; ++b)
#pragma unroll
                for (int m = 0; m < 4; ++m)
#pragma unroll
                    for (int n = 0; n < 2; ++n) acc[a][b][m][n] = (f32x4){0.f, 0.f, 0.f, 0.f};
        cur = nxt; cA = nA; cB = nB; ++ui;
        if constexpr (ALIGN_EPI) { if (wr == 1) PG8_BAR; }
    }
    PG8_WAIT_V(0);
    if constexpr (!ALIGN_EPI) { if (wr == 0) PG8_BAR; }
    PG8_BAR;
    if constexpr (Epi::AFTER_DRAIN) { E.fused(acc, cur, wr, wc, fr, fq, lds, wid, lane); S.done(cur); }
#undef PG8_SA
#undef PG8_SB
#undef PG8_STAGE
#undef PG8_LDA
#undef PG8_LDB
#undef PG8_MMA
#undef PG8_WAIT_V
#undef PG8_WAIT_L
#undef PG8_BAR
#undef PG8_SCHED
}
}
using pg8::bf16_t; using pg8::f32x4; using pg8::u32x4;
#define LAS __attribute__((address_space(3)))

constexpr int D = 1024, NBATCH = 16, SEQ = 2048, CTXL = 256;
constexpr int TL = NBATCH * SEQ;
constexpr int TC = NBATCH * CTXL;
constexpr int TALL = TL + TC;
constexpr int PROJ = 5632;
constexpr int NEXP = 32, DEXP = 512;
constexpr int MOE_ROWS = 288 * 256;
constexpr float EPS = 1e-6f;
constexpr int NWAVES = 8, NTHREADS = 512;

constexpr size_t MiB = 1u << 20;
constexpr size_t WS_CTL = 0;
constexpr size_t CTL_ZERO_BYTES = 256 * 1024;
constexpr size_t WS_MOD = 1 * MiB;
constexpr size_t WS_TOK = 2 * MiB;
constexpr size_t WS_RWT = 3 * MiB;
constexpr size_t WS_WIN = 13 * MiB;
constexpr size_t WS_WA = 24 * MiB;
constexpr size_t WS_WL = 25 * MiB;
constexpr size_t WS_WO = 27 * MiB;
constexpr size_t WS_LW = 29 * MiB;
constexpr size_t WS_W13 = 30 * MiB;
constexpr size_t WS_W2 = 94 * MiB;
constexpr size_t WS_K = 126 * MiB;
constexpr size_t WS_V = 162 * MiB;
constexpr size_t WS_LX = 198 * MiB;
constexpr size_t WS_XB = WS_K;
constexpr size_t WS_Q = 270 * MiB;
constexpr size_t WS_LG = 302 * MiB;
constexpr size_t WS_H2 = WS_Q;
constexpr size_t WS_X1B = WS_LG;
constexpr size_t WS_GA = 366 * MiB;
constexpr size_t WS_GB = 398 * MiB;
constexpr size_t WS_Y = 430 * MiB;
constexpr size_t WS_YB = WS_GA;
constexpr size_t WS_END = 510 * MiB;
constexpr int CW_COUNT = 0, CW_CURSOR = 64, CW_NBLK = 128, CW_BLKE = 192;
constexpr int CW_BCNT = 16384;
constexpr int CW_BAR = 1024;

constexpr int RING_BYTES = 131072;
constexpr int MISC_OFF = 147456;
constexpr int LDS_BYTES = 163840;

__device__ __forceinline__ unsigned f2bf(float f) { unsigned u = __float_as_uint(f); return (u + 0x7fffu + ((u >> 16) & 1u)) >> 16; }
__device__ __forceinline__ float bf2f(unsigned h) { return __uint_as_float(h << 16); }
typedef __bf16 bf16x2_t __attribute__((ext_vector_type(2)));
__device__ __forceinline__ unsigned pk2(float lo, float hi) { const f32x2 v = {lo, hi}; const bf16x2_t b = __builtin_convertvector(v, bf16x2_t); return __builtin_bit_cast(unsigned, b); }
__device__ __forceinline__ float bflo(unsigned w) { return __uint_as_float(w << 16); }
__device__ __forceinline__ float bfhi(unsigned w) { return __uint_as_float(w & 0xffff0000u); }
__device__ __forceinline__ void unpack8(u32x4 w, float (&v)[8]) { v[0] = bflo(w.x); v[1] = bfhi(w.x); v[2] = bflo(w.y); v[3] = bfhi(w.y); v[4] = bflo(w.z); v[5] = bfhi(w.z); v[6] = bflo(w.w); v[7] = bfhi(w.w); }
__device__ __forceinline__ u32x4 pack8(const float (&v)[8]) { u32x4 w; w.x = pk2(v[0], v[1]); w.y = pk2(v[2], v[3]); w.z = pk2(v[4], v[5]); w.w = pk2(v[6], v[7]); return w; }
__device__ __forceinline__ unsigned q8(float v) { return (unsigned)(v * 255.0f + 0.5f); }
__device__ __forceinline__ u32x2 packq8(const float (&v)[8]) { u32x2 w; w.x = q8(v[0]) | (q8(v[1]) << 8) | (q8(v[2]) << 16) | (q8(v[3]) << 24); w.y = q8(v[4]) | (q8(v[5]) << 8) | (q8(v[6]) << 16) | (q8(v[7]) << 24); return w; }
__device__ __forceinline__ void unpackq8(u32x2 w, float (&v)[8]) { const float s = 1.0f / 255.0f;
    v[0] = (float)(w.x & 255u) * s; v[1] = (float)((w.x >> 8) & 255u) * s; v[2] = (float)((w.x >> 16) & 255u) * s; v[3] = (float)(w.x >> 24) * s;
    v[4] = (float)(w.y & 255u) * s; v[5] = (float)((w.y >> 8) & 255u) * s; v[6] = (float)((w.y >> 16) & 255u) * s; v[7] = (float)(w.y >> 24) * s; }
__device__ __forceinline__ float fast_exp(float x) { return __builtin_amdgcn_exp2f(x * 1.4426950408889634f); }
__device__ __forceinline__ float sigmoid_fast(float x) { return __builtin_amdgcn_rcpf(1.0f + fast_exp(-x)); }
__device__ __forceinline__ float silu_fast(float x) { return x * sigmoid_fast(x); }
__device__ __forceinline__ float gelu_tanh_fast(float x) { const float u2 = 1.5957691216057308f * (x + 0.044715f * x * x * x); return x * sigmoid_fast(u2); }
__device__ __forceinline__ float sigmoidf_(float x) { return 1.0f / (1.0f + expf(-x)); }
__device__ __forceinline__ float siluf_(float x) { return x / (1.0f + expf(-x)); }
__device__ __forceinline__ float wave_sum(float v) {
#pragma unroll
    for (int o = 1; o < 64; o <<= 1) v += __shfl_xor(v, o);
    return v;
}

template <int CTRL> __device__ __forceinline__ float dpp_f(float v) { return __int_as_float(__builtin_amdgcn_update_dpp(0, __float_as_int(v), CTRL, 0xF, 0xF, true)); }
__device__ __forceinline__ float row16_sum(float v) { v += dpp_f<0xB1>(v); v += dpp_f<0x4E>(v); v += dpp_f<0x141>(v); v += dpp_f<0x140>(v); return v; }
__device__ __forceinline__ float comb32(float a, float b) { const auto r = __builtin_amdgcn_permlane32_swap(__float_as_uint(a), __float_as_uint(b), false, false); return __uint_as_float(r[0]) + __uint_as_float(r[1]); }
__device__ __forceinline__ float comb16(float a, float b) { const auto r = __builtin_amdgcn_permlane16_swap(__float_as_uint(a), __float_as_uint(b), false, false); return __uint_as_float(r[0]) + __uint_as_float(r[1]); }
__device__ __forceinline__ float lane_f(float v, int l) { return __int_as_float(__builtin_amdgcn_readlane(__float_as_int(v), l)); }
__device__ __forceinline__ float wave_sum_fast(float v) { v = row16_sum(v); return (lane_f(v, 0) + lane_f(v, 16)) + (lane_f(v, 32) + lane_f(v, 48)); }
__device__ __forceinline__ float half_max(float v) { const auto r = __builtin_amdgcn_permlane32_swap(__float_as_uint(v), __float_as_uint(v), false, false); return fmaxf(__uint_as_float(r[0]), __uint_as_float(r[1])); }
__device__ __forceinline__ float half_sum(float v) { const auto r = __builtin_amdgcn_permlane32_swap(__float_as_uint(v), __float_as_uint(v), false, false); return __uint_as_float(r[0]) + __uint_as_float(r[1]); }

struct EpiProj {
    bf16_t *Kb, *Vb, *LXb, *Qb, *LGb; unsigned char *GAq, *GBq; const f32x2* rope;
    __device__ __forceinline__ void operator()(int row, int col, const float (&v)[8]) const {
        float o[8];
        if (col < 512) {
            if (row < TL) { const int t = row & 2047, p = col & 63, pos = (p < 32) ? (t >> 6) : (t & 63), i0 = (p & 31) >> 1;
#pragma unroll
                for (int j = 0; j < 4; ++j) { const f32x2 cs = rope[pos * 16 + i0 + j]; o[2 * j] = v[2 * j] * cs.x - v[2 * j + 1] * cs.y; o[2 * j + 1] = v[2 * j] * cs.y + v[2 * j + 1] * cs.x; }
            } else {
#pragma unroll
                for (int j = 0; j < 8; ++j) o[j] = v[j]; }
            *(u32x4*)(Kb + (size_t)row * 512 + col) = pack8(o);
        } else if (col < 1024) { *(u32x4*)(Vb + (size_t)row * 512 + (col - 512)) = pack8(v);
        } else if (col < 2048) { *(u32x4*)(LXb + (size_t)row * 1024 + (col - 1024)) = pack8(v);
        } else if (col < 2560) { *(u32x4*)(Qb + (size_t)row * 512 + (col - 2048)) = pack8(v);
        } else if (col < 3584) {
#pragma unroll
            for (int j = 0; j < 8; ++j) o[j] = gelu_tanh_fast(v[j]);
            *(u32x4*)(LGb + (size_t)row * 1024 + (col - 2560)) = pack8(o);
        } else {
#pragma unroll
            for (int j = 0; j < 8; ++j) o[j] = sigmoid_fast(v[j]);
            unsigned char* dst = (col < 4608) ? GAq + (size_t)row * 1024 + (col - 3584) : GBq + (size_t)row * 1024 + (col - 4608);
            *(u32x2*)dst = packq8(o);
        }
    }
};
struct EpiUpAttn {
    const unsigned char* GA; bf16_t* OUT;
    struct P { u32x2 g; };
    __device__ __forceinline__ void load(int row, int col, P& p) const { p.g = *(const u32x2*)(GA + (size_t)row * 1024 + col); }
    __device__ __forceinline__ void apply(int row, int col, const float (&v)[8], const P& p) const {
        float g[8], o[8]; unpackq8(p.g, g);
#pragma unroll
        for (int j = 0; j < 8; ++j) o[j] = g[j] * v[j];
        *(u32x4*)(OUT + (size_t)row * 1024 + col) = pack8(o);
    }
};
struct EpiUpLru {
    const bf16_t* Y; const unsigned char* GB; bf16_t* OUT;
    struct P { u32x2 g; u32x4 y; };
    __device__ __forceinline__ void load(int row, int col, P& p) const { p.g = *(const u32x2*)(GB + (size_t)row * 1024 + col); p.y = *(const u32x4*)(Y + (size_t)row * 1024 + col); }
    __device__ __forceinline__ void apply(int row, int col, const float (&v)[8], const P& p) const {
        float g[8], y[8], o[8]; unpackq8(p.g, g); unpack8(p.y, y);
#pragma unroll
        for (int j = 0; j < 8; ++j) o[j] = y[j] + g[j] * v[j];
        *(u32x4*)(OUT + (size_t)row * 1024 + col) = pack8(o);
    }
};
struct EpiOut {
    const float* x; const float* mod; bf16_t* x1;
    struct P { f32x4 x0, x1v, g0, g1; };
    __device__ __forceinline__ void load(int row, int col, P& p) const { const float* ga1 = mod + (row >> 11) * 6144 + 2048 + col; const float* xr = x + (size_t)row * D + col;
        p.x0 = *(const f32x4*)xr; p.x1v = *(const f32x4*)(xr + 4); p.g0 = *(const f32x4*)ga1; p.g1 = *(const f32x4*)(ga1 + 4); }
    __device__ __forceinline__ void apply(int row, int col, const float (&v)[8], const P& p) const {
        const float o[8] = {p.x0.x + p.g0.x * v[0], p.x0.y + p.g0.y * v[1], p.x0.z + p.g0.z * v[2], p.x0.w + p.g0.w * v[3], p.x1v.x + p.g1.x * v[4], p.x1v.y + p.g1.y * v[5], p.x1v.z + p.g1.z * v[6], p.x1v.w + p.g1.w * v[7]};
        *(u32x4*)(x1 + (size_t)row * D + col) = pack8(o);
    }
};
struct EpiMoe1 {
    bf16_t* HM;
    __device__ __forceinline__ void operator()(int row, int col, const float (&v)[8]) const {
        u32x2 w; w.x = pk2(silu_fast(v[0]) * v[1], silu_fast(v[2]) * v[3]); w.y = pk2(silu_fast(v[4]) * v[5], silu_fast(v[6]) * v[7]);
        *(u32x2*)(HM + (size_t)row * DEXP + (col >> 1)) = w;
    }
};
struct EpiMoe2 {
    bf16_t* YB;
    __device__ __forceinline__ void operator()(int row, int col, const float (&v)[8]) const { *(u32x4*)(YB + (size_t)row * D + col) = pack8(v); }
};
template <class F> struct EpiF {
    static constexpr bool PERM = true, AFTER_DRAIN = false; F f;
    __device__ __forceinline__ void operator()(const f32x4 (&acc)[2][2][4][2], const pg8::Unit& u, int wr, int wc, int fr, int fq) const {
#pragma unroll
        for (int ai = 0; ai < 2; ++ai)
#pragma unroll
            for (int m = 0; m < 4; ++m) { const int row = u.pm * 256 + ai * 128 + wr * 64 + m * 16 + fr;
#pragma unroll
                for (int bj = 0; bj < 2; ++bj) { const int col = u.pn * 256 + bj * 128 + wc * 32 + 8 * fq; const f32x4 a = acc[ai][bj][m][0], b = acc[ai][bj][m][1];
                    const float v[8] = {a[0], a[1], a[2], a[3], b[0], b[1], b[2], b[3]}; f(row, col, v); } }
    }
};
template <class F> struct EpiF2 {
    static constexpr bool PERM = true, AFTER_DRAIN = false; F f;
    __device__ __forceinline__ void operator()(const f32x4 (&acc)[2][2][4][2], const pg8::Unit& u, int wr, int wc, int fr, int fq) const {
#pragma unroll
        for (int ai = 0; ai < 2; ++ai)
#pragma unroll
            for (int mp = 0; mp < 2; ++mp) {
                typename F::P pre[2][2];
#pragma unroll
                for (int mm = 0; mm < 2; ++mm)
#pragma unroll
                    for (int bj = 0; bj < 2; ++bj) f.load(u.pm * 256 + ai * 128 + wr * 64 + (2 * mp + mm) * 16 + fr, u.pn * 256 + bj * 128 + wc * 32 + 8 * fq, pre[mm][bj]);
#pragma unroll
                for (int mm = 0; mm < 2; ++mm)
#pragma unroll
                    for (int bj = 0; bj < 2; ++bj) { const int m = 2 * mp + mm; const f32x4 a = acc[ai][bj][m][0], b = acc[ai][bj][m][1];
                        const float v[8] = {a[0], a[1], a[2], a[3], b[0], b[1], b[2], b[3]};
                        f.apply(u.pm * 256 + ai * 128 + wr * 64 + m * 16 + fr, u.pn * 256 + bj * 128 + wc * 32 + 8 * fq, v, pre[mm][bj]); }
                asm volatile("" ::: "memory");
            }
    }
};

struct ProjOrder {
    pg8::StaticOrder so; int G, c;
    __device__ __forceinline__ void init(int G_, int c_) { so.init(TL, PROJ, G_, c_); G = G_; c = c_; }
    __device__ __forceinline__ bool next(int i, pg8::Unit& u) const {
        const int L = i * G + c;
        if (L < so.nwg) return so.next(i, u);
        const int j = L - so.nwg; if (j >= 128) return false;
        u.pm = 128 + (j >> 3); u.pn = j & 7; u.bofs = 0; return true;
    }
    __device__ __forceinline__ void a_ready(const pg8::Unit&) const {}
    __device__ __forceinline__ void done(const pg8::Unit&) const {}
};
struct MoeOrder {
    const unsigned* ctl; int G, vcu, nunits; size_t estride;
    __device__ __forceinline__ void init(const unsigned* ctl_, int G_, int bx, size_t es) { ctl = ctl_; G = G_; vcu = (G_ % 8 == 0) ? (bx % 8) * (G_ / 8) + bx / 8 : bx; nunits = (int)ctl_[CW_NBLK] * 4; estride = es; }
    __device__ __forceinline__ bool next(int i, pg8::Unit& u) const {
        const int L = i * G + vcu; if (L >= nunits) return false;
        u.pm = L >> 2; u.pn = L & 3; u.bofs = (size_t)ctl[CW_BLKE + u.pm] * estride; return true;
    }
    __device__ __forceinline__ void a_ready(const pg8::Unit&) const {}
    __device__ __forceinline__ void done(const pg8::Unit&) const {}
};

#define XB_TMO      128
#define XB_XCNT(j)  (256  + 64 * (j))
#define XB_XSUB(j)  (1280 + 64 * (j))
#define XB_XGEN(j)  (2304 + 64 * (j))
#define XB_TOP      3328
#define XB_TOPGEN   3392
#define XCD_BAR_WORDS 3456
#define XB_SPIN_CAP (1u << 18)

__device__ __forceinline__ unsigned xb_ld(unsigned* p)              { return __hip_atomic_load(p, __ATOMIC_RELAXED, __HIP_MEMORY_SCOPE_AGENT); }
__device__ __forceinline__ unsigned xb_add(unsigned* p, unsigned v) { return __hip_atomic_fetch_add(p, v, __ATOMIC_RELAXED, __HIP_MEMORY_SCOPE_AGENT); }
__device__ __forceinline__ unsigned xb_xcc_id() { return (unsigned)__builtin_amdgcn_s_getreg((3 << 11) | 20) & 0xFu; }
#define XB_SPIN(cond, bar) do { unsigned _sp = 0; while (cond) { __builtin_amdgcn_s_sleep(1); \
    if ((++_sp & 255u) == 0u) { if (xb_ld(&(bar)[XB_TMO])) break; if (_sp > XB_SPIN_CAP) { atomicAdd(&(bar)[XB_TMO], 1u); break; } } } } while (0)

struct XcdBarrier {
    unsigned* bar; unsigned x;
    volatile LAS unsigned* st;
};

__device__ __forceinline__ XcdBarrier xcd_barrier_post(unsigned* bar, volatile LAS unsigned* st, bool leader) {
    XcdBarrier b; b.bar = bar; b.x = xb_xcc_id(); b.st = st;
    if (leader) (void)xb_add(&bar[XB_XCNT(b.x)], 1u);
    return b;
}
__device__ __forceinline__ void xcd_barrier_complete(unsigned* bar, unsigned x, unsigned& nloc, unsigned& nx) {
    const unsigned G = gridDim.x * gridDim.y * gridDim.z;
    unsigned sum, cnt, mine, sp = 0u;
    for (;;) {
        sum = 0u; cnt = 0u; mine = 0u;
#pragma unroll
        for (unsigned j = 0; j < 16; ++j) { const unsigned c = xb_ld(&bar[XB_XCNT(j)]); sum += c; cnt += (c > 0u) ? 1u : 0u; mine = (j == x) ? c : mine; }
        if (sum == G) break;
        __builtin_amdgcn_s_sleep(1);
        if ((++sp & 255u) == 0u) { if (xb_ld(&bar[XB_TMO])) break; if (sp > XB_SPIN_CAP) { atomicAdd(&bar[XB_TMO], 1u); break; } }
    }
    nloc = mine > 0u ? mine : 1u; nx = cnt > 0u ? cnt : 1u;
}

__device__ __forceinline__ void xcd_barrier(const XcdBarrier& b, int wave) {
    const bool leader_ = wave == 0 && __builtin_amdgcn_mbcnt_hi(~0u, __builtin_amdgcn_mbcnt_lo(~0u, 0u)) == 0u;
    asm volatile("s_waitcnt vmcnt(0)" ::: "memory");
    __syncthreads();
    if (leader_) {
        unsigned* bar = b.bar;
        __builtin_amdgcn_s_waitcnt(0);
        unsigned nloc = b.st[0], nx = b.st[1];
        if (nloc == 0u) { xcd_barrier_complete(bar, b.x, nloc, nx); b.st[0] = nloc; b.st[1] = nx; }
        const unsigned old = xb_add(&bar[XB_XSUB(b.x)], 1u);
        const unsigned gen = old / nloc;
        if (old + 1u == (gen + 1u) * nloc) {
            __builtin_amdgcn_fence(__ATOMIC_RELEASE, "agent");
            asm volatile("s_waitcnt vmcnt(0)" ::: "memory");
            const unsigned og = xb_add(&bar[XB_TOP], 1u);
            const unsigned tg = og / nx;
            if (og + 1u == (tg + 1u) * nx) xb_add(&bar[XB_TOPGEN], 1u);
            else XB_SPIN(xb_ld(&bar[XB_TOPGEN]) == tg, bar);
            __builtin_amdgcn_fence(__ATOMIC_ACQUIRE, "agent");
            xb_add(&bar[XB_XGEN(b.x)], 1u);
            asm volatile("s_waitcnt vmcnt(0)" ::: "memory");
        } else {
            XB_SPIN(xb_ld(&bar[XB_XGEN(b.x)]) == gen, bar);
            __builtin_amdgcn_fence(__ATOMIC_ACQUIRE, "agent");
            asm volatile("s_waitcnt vmcnt(0)" ::: "memory");
        }
    }
    __syncthreads();
}

__device__ __forceinline__ int win_perm(int n) {
    const bool qk = (n < 512) || (n >= 2048 && n < 2560);
    if (!qk) return n;
    const int d = n & 63, base = n - d, half = d >> 5, dd = d & 31, i = dd & 15, comp = dd >> 4;
    return base + half * 32 + 2 * i + comp;
}
template <int K, int N, int MODE, int ROWMUL>
__device__ __forceinline__ void prep_item(const float* W, bf16_t* WT, int rowoff, unsigned dstride, LAS float* scr, int item, int lane, float wscale = 1.0f) {
    constexpr int nblk = N / 32, per = (K / 64) * nblk;
    const int bi = item / per, r = item % per, kb = r / nblk, nb = r % nblk, k0 = 64 * kb, n0 = 32 * nb;
    const float* src = W + (size_t)bi * K * N;
    { float t_[32];
#pragma unroll
      for (int i = 0; i < 32; ++i) t_[i] = __builtin_nontemporal_load(src + (size_t)(k0 + 2 * i + (lane >> 5)) * N + n0 + (lane & 31));
#pragma unroll
      for (int i = 0; i < 32; ++i) scr[(2 * i + (lane >> 5)) * 33 + (lane & 31)] = t_[i]; }
    asm volatile("s_waitcnt lgkmcnt(0)" ::: "memory");
    const int c = lane & 7;
#pragma unroll
    for (int j = 0; j < 4; ++j) { const int n = (lane >> 3) + 8 * j; const LAS float* s = scr + (8 * c) * 33 + n;
        u32x4 o; o.x = pk2(s[0 * 33] * wscale, s[1 * 33] * wscale); o.y = pk2(s[2 * 33] * wscale, s[3 * 33] * wscale); o.z = pk2(s[4 * 33] * wscale, s[5 * 33] * wscale); o.w = pk2(s[6 * 33] * wscale, s[7 * 33] * wscale);
        int ng = n0 + n; if (MODE == 1) ng = win_perm(ng);
        *(u32x4*)(WT + (size_t)bi * dstride + (size_t)(ROWMUL * ng + rowoff) * K + k0 + 8 * c) = o; }
    asm volatile("s_waitcnt lgkmcnt(0)" ::: "memory");
}
__device__ __forceinline__ unsigned char* lds_ptr(LAS unsigned char* ldsl, int i);
__device__ __forceinline__ void p0_prep(unsigned char* ws, LAS unsigned char* ldsl, int gw, int ngw, int lane, int wave) {
    LAS float* scr = (LAS float*)(ldsl + wave * 8448);
#define in_(i) ((const float*)lds_ptr(ldsl, (i)))
    constexpr int I0 = 16 * 176, I1 = 8 * 32, I2 = 16 * 32, I3 = 16 * 32, I4 = 16 * 2 * 4, I5 = I4, I6 = 32 * 16 * 16, I7 = I6, I8 = 32 * 8 * 32;
    constexpr int TOT = I0 + I1 + I2 + I3 + I4 + I5 + I6 + I7 + I8;
    for (int it = gw; it < TOT; it += ngw) {
        int r = it;
        if (r < I0) { prep_item<1024, PROJ, 1, 1>(in_(8), (bf16_t*)(ws + WS_WIN), 0, 0u, scr, r, lane); continue; } r -= I0;
        if (r < I1) { prep_item<512, 1024, 0, 1>(in_(17), (bf16_t*)(ws + WS_WA), 0, 0u, scr, r, lane); continue; } r -= I1;
        if (r < I2) { prep_item<1024, 1024, 0, 1>(in_(18), (bf16_t*)(ws + WS_WL), 0, 0u, scr, r, lane); continue; } r -= I2;
        if (r < I3) { prep_item<1024, 1024, 0, 1>(in_(19), (bf16_t*)(ws + WS_WO), 0, 0u, scr, r, lane); continue; } r -= I3;
        if (r < I4) { prep_item<128, 128, 0, 1>(in_(12), (bf16_t*)(ws + WS_LW), 0, 256u * 128u, scr, r, lane, -1.4426950408889634f); continue; } r -= I4;
        if (r < I5) { prep_item<128, 128, 0, 1>(in_(14), (bf16_t*)(ws + WS_LW), 128, 256u * 128u, scr, r, lane, -1.4426950408889634f); continue; } r -= I5;
        if (r < I6) { prep_item<1024, 512, 0, 2>(in_(24), (bf16_t*)(ws + WS_W13), 0, 1024u * 1024u, scr, r, lane); continue; } r -= I6;
        if (r < I7) { prep_item<1024, 512, 0, 2>(in_(25), (bf16_t*)(ws + WS_W13), 1, 1024u * 1024u, scr, r, lane); continue; } r -= I7;
        prep_item<512, 1024, 0, 1>(in_(26), (bf16_t*)(ws + WS_W2), 0, 1024u * 512u, scr, r, lane);
    }
#undef in_
}
__device__ __forceinline__ void p0_mod(const float* c, const float* c_ctx, const float* w_mod, const float* b_mod, const float* wg, const float* we, f32x4* W4g, const float* lam, float* SPt, float* mod, f32x2* rope, LAS float* lds_f, int tid) {
    LAS float* sc = lds_f;
    LAS float* red = lds_f + 17 * 1024;
    {
        float cv[34];
#pragma unroll
        for (int it = 0; it < 34; ++it) { const int i = tid + it * NTHREADS; cv[it] = (it < 32) ? c[i] : c_ctx[i - 16 * 1024]; }
#pragma unroll
        for (int it = 0; it < 34; ++it) sc[tid + it * NTHREADS] = siluf_(cv[it]);
    }
    for (int idx = blockIdx.x * NTHREADS + tid; idx < 36 * 256; idx += gridDim.x * NTHREADS) { const int cc = idx >> 8, kq = idx & 255; f32x4 w;
        if (cc < 4) { const float* s = wg + (size_t)(4 * kq) * 4 + cc; w.x = s[0]; w.y = s[4]; w.z = s[8]; w.w = s[12]; }
        else { const float* s = we + (size_t)(4 * kq) * 32 + (cc - 4); w.x = s[0]; w.y = s[32]; w.z = s[64]; w.w = s[96]; }
        W4g[idx] = w; }
    if (blockIdx.x >= 1 && blockIdx.x < 5) { const int i = (blockIdx.x - 1) * NTHREADS + tid; const float lm = lam[i]; SPt[i] = (-lm > 20.f) ? -lm : log1pf(expf(-lm)); }
    if (blockIdx.x == 0 || blockIdx.x == 5) for (int i = (blockIdx.x ? NTHREADS : 0) + tid; i < 64 * 16; i += 2 * NTHREADS) { const int pos = i >> 4, f = i & 15; const double inv = exp(-(double)f / 16.0 * log(10000.0)); const double ang = (double)pos * inv;
        rope[i] = (f32x2){(float)cos(ang), (float)sin(ang)}; }
    __syncthreads();
    for (int cb = blockIdx.x; cb < 256; cb += gridDim.x) {
        const int ks = tid / 24, col = tid % 24;
        if (ks < 21) {
            float acc[17];
#pragma unroll
            for (int b = 0; b < 17; ++b) acc[b] = 0.f;
            float w[49];
#pragma unroll
            for (int i = 0; i < 49; ++i) { const int k = ks + 21 * i; w[i] = (k < 1024) ? w_mod[(size_t)k * 6144 + cb * 24 + col] : 0.f; }
#pragma unroll
            for (int i = 0; i < 49; ++i) { const int k = min(ks + 21 * i, 1023);
#pragma unroll
                for (int b = 0; b < 17; ++b) acc[b] += sc[b * 1024 + k] * w[i]; }
#pragma unroll
            for (int b = 0; b < 17; ++b) red[(ks * 17 + b) * 24 + col] = acc[b];
        }
        __syncthreads();
        if (tid < 17 * 24) { const int b = tid / 24, cc = tid % 24; float s = b_mod[cb * 24 + cc];
            for (int q = 0; q < 21; ++q) s += red[(q * 17 + b) * 24 + cc];
            mod[b * 6144 + cb * 24 + cc] = s; }
        __syncthreads();
    }
}

__device__ __forceinline__ void p1_adanorm(const float* x, const float* ctx, const float* gain, const float* mod, bf16_t* H, int gw, int ngw, int lane) {
    f32x4 nA[4], nB[4];
#define AD_SRC(r_) ((r_) < TL ? x + (size_t)(r_) * D : ctx + (size_t)((r_) - TL) * D)
#define AD_LOAD(dst, r_) do { if ((r_) < TALL) { const float* s_ = AD_SRC(r_); _Pragma("unroll") for (int j = 0; j < 4; ++j) dst[j] = __builtin_nontemporal_load((const f32x4*)(s_ + lane * 4 + 256 * j)); } } while (0)
#define AD_ROW(src_, r_) do { const int row_ = (r_); const int mb = row_ < TL ? (row_ >> 11) : 16; const float* shift = mod + mb * 6144; const float* scale = shift + 1024; \
        f32x4 v[4]; float ss = 0.f; \
        _Pragma("unroll") for (int j = 0; j < 4; ++j) { v[j] = src_[j]; ss += v[j].x * v[j].x + v[j].y * v[j].y + v[j].z * v[j].z + v[j].w * v[j].w; } \
        AD_LOAD(src_, row_ + 2 * ngw); \
        const float rstd = rsqrtf(wave_sum_fast(ss) * (1.0f / D) + EPS); \
        _Pragma("unroll") for (int j = 0; j < 4; ++j) { const int k = lane * 4 + 256 * j; const f32x4 g = *(const f32x4*)(gain + k), sh = *(const f32x4*)(shift + k), sc = *(const f32x4*)(scale + k); \
            const f32x4 o = (v[j] * rstd * g) * (1.0f + sc) + sh; \
            u32x2 w; w.x = pk2(o.x, o.y); w.y = pk2(o.z, o.w); *(u32x2*)(H + (size_t)row_ * D + k) = w; } } while (0)
    AD_LOAD(nA, gw); AD_LOAD(nB, gw + ngw);
    for (int row = gw; row < TALL; row += 2 * ngw) { AD_ROW(nA, row); if (row + ngw < TALL) AD_ROW(nB, row + ngw); }
#undef AD_SRC
#undef AD_LOAD
#undef AD_ROW
}

__device__ __forceinline__ void p1_router_tables(const float* gain, const float* mod, const f32x4* W4g, const float* bg, const float* be, float* WT, float* biasb, int gw, int ngw, int lane) {
    for (int it = gw; it < 16 * 48; it += ngw) {
        const int b = it / 48, j = it % 48; const float* shift = mod + b * 6144 + 3072; const float* scale = shift + 1024;
        float part = 0.f;
#pragma unroll
        for (int i = 0; i < 4; ++i) { const int kq = lane + 64 * i; const f32x4 g = *(const f32x4*)(gain + 4 * kq), sc = *(const f32x4*)(scale + 4 * kq), sh = *(const f32x4*)(shift + 4 * kq);
            f32x4 w = (f32x4){0.f, 0.f, 0.f, 0.f}; if (j < 36) w = W4g[j * 256 + kq];
            *(f32x4*)(WT + (size_t)(b * 48 + j) * 1024 + 4 * kq) = g * (1.0f + sc) * w;
            part += sh.x * w.x + sh.y * w.y + sh.z * w.z + sh.w * w.w; }
        part = wave_sum_fast(part);
        if (lane == 0) biasb[b * 48 + j] = part + (j < 4 ? bg[j] : j < 36 ? be[j - 4] : 0.f);
    }
}
constexpr int RT_CHUNK_FLOATS = 48 * 132, RT_LG_OFF = 2 * RT_CHUNK_FLOATS * 4;
__device__ __forceinline__ void p8_route(const bf16_t* x1, const float* WT, const float* biasb, unsigned* ctl, int* tok, LAS unsigned char* lds, int lane, int tid, int wave) {
    LAS unsigned* hist = (LAS unsigned*)(lds + MISC_OFF + 256);
    if (tid < 32) hist[tid] = 0u;
    LAS float* Lg = (LAS float*)(lds + RT_LG_OFF + wave * 3072);
    const int i = lane & 15, kk = lane >> 4;
    for (int blk = blockIdx.x; blk < TL / 128; blk += gridDim.x) {
        const int R0 = 128 * blk + 16 * wave, b = (128 * blk) >> 11;
        const bf16_t* xr = x1 + (size_t)(R0 + i) * D + 4 * kk; const float* wtb = WT + (size_t)b * 48 * 1024;
        f32x4 a0 = (f32x4){0.f, 0.f, 0.f, 0.f}, a1 = a0, a2 = a0; float ss = 0.f;
        f32x4 stg[3];
#define RT_LOAD(c_) do { _Pragma("unroll") for (int q = 0; q < 3; ++q) { const int id = tid + NTHREADS * q, col = id >> 5, k4 = id & 31; stg[q] = *(const f32x4*)(wtb + (size_t)col * 1024 + 128 * (c_) + 4 * k4); } } while (0)
#define RT_STORE(buf_) do { _Pragma("unroll") for (int q = 0; q < 3; ++q) { const int id = tid + NTHREADS * q, col = id >> 5, k4 = id & 31; *(LAS f32x4*)((LAS float*)lds + (buf_) * RT_CHUNK_FLOATS + col * 132 + 4 * k4) = stg[q]; } } while (0)
        __syncthreads();
        RT_LOAD(0); RT_STORE(0);
        u32x2 cx[8];
#pragma unroll
        for (int u = 0; u < 8; ++u) cx[u] = *(const u32x2*)(xr + 16 * u);
        __syncthreads();
#pragma unroll 1
        for (int c = 0; c < 8; ++c) {
            if (c < 7) RT_LOAD(c + 1);
            u32x2 nx[8];
            if (c < 7) {
#pragma unroll
                for (int u = 0; u < 8; ++u) nx[u] = *(const u32x2*)(xr + 128 * (c + 1) + 16 * u); }
            const LAS float* wl = (const LAS float*)lds + (c & 1) * RT_CHUNK_FLOATS + i * 132 + 4 * kk;
#pragma unroll
            for (int u = 0; u < 8; ++u) { const f32x4 xa = (f32x4){bflo(cx[u].x), bfhi(cx[u].x), bflo(cx[u].y), bfhi(cx[u].y)}, b0 = *(const LAS f32x4*)(wl + 16 * u), b1 = *(const LAS f32x4*)(wl + 16 * 132 + 16 * u), b2 = *(const LAS f32x4*)(wl + 32 * 132 + 16 * u);
                ss += xa.x * xa.x + xa.y * xa.y + xa.z * xa.z + xa.w * xa.w;
                a0 = __builtin_amdgcn_mfma_f32_16x16x4f32(xa.x, b0.x, a0, 0, 0, 0); a1 = __builtin_amdgcn_mfma_f32_16x16x4f32(xa.x, b1.x, a1, 0, 0, 0); a2 = __builtin_amdgcn_mfma_f32_16x16x4f32(xa.x, b2.x, a2, 0, 0, 0);
                a0 = __builtin_amdgcn_mfma_f32_16x16x4f32(xa.y, b0.y, a0, 0, 0, 0); a1 = __builtin_amdgcn_mfma_f32_16x16x4f32(xa.y, b1.y, a1, 0, 0, 0); a2 = __builtin_amdgcn_mfma_f32_16x16x4f32(xa.y, b2.y, a2, 0, 0, 0);
                a0 = __builtin_amdgcn_mfma_f32_16x16x4f32(xa.z, b0.z, a0, 0, 0, 0); a1 = __builtin_amdgcn_mfma_f32_16x16x4f32(xa.z, b1.z, a1, 0, 0, 0); a2 = __builtin_amdgcn_mfma_f32_16x16x4f32(xa.z, b2.z, a2, 0, 0, 0);
                a0 = __builtin_amdgcn_mfma_f32_16x16x4f32(xa.w, b0.w, a0, 0, 0, 0); a1 = __builtin_amdgcn_mfma_f32_16x16x4f32(xa.w, b1.w, a1, 0, 0, 0); a2 = __builtin_amdgcn_mfma_f32_16x16x4f32(xa.w, b2.w, a2, 0, 0, 0); }
            if (c < 7) { RT_STORE((c + 1) & 1);
#pragma unroll
                for (int u = 0; u < 8; ++u) cx[u] = nx[u]; }
            __syncthreads();
        }
#undef RT_LOAD
#undef RT_STORE
        ss = half_sum(ss); { const auto r = __builtin_amdgcn_permlane16_swap(__float_as_uint(ss), __float_as_uint(ss), false, false); ss = __uint_as_float(r[0]) + __uint_as_float(r[1]); }
        const float rstd = rsqrtf(ss * (1.0f / D) + EPS);
#pragma unroll
        for (int rg = 0; rg < 4; ++rg) { Lg[(4 * kk + rg) * 48 + i] = a0[rg]; Lg[(4 * kk + rg) * 48 + 16 + i] = a1[rg]; Lg[(4 * kk + rg) * 48 + 32 + i] = a2[rg]; }
        if (lane < 16) {
            const int row = R0 + lane; const float* bb = biasb + b * 48; const LAS float* lr = Lg + lane * 48;
            float acc[36];
#pragma unroll
            for (int c4 = 0; c4 < 9; ++c4) { const f32x4 v = *(const LAS f32x4*)(lr + 4 * c4), bv = *(const f32x4*)(bb + 4 * c4);
                acc[4 * c4] = rstd * v.x + bv.x; acc[4 * c4 + 1] = rstd * v.y + bv.y; acc[4 * c4 + 2] = rstd * v.z + bv.z; acc[4 * c4 + 3] = rstd * v.w + bv.w; }
            int gi = 0; float gm = -1e30f;
#pragma unroll
            for (int g = 0; g < 4; ++g) if (acc[g] > gm) { gm = acc[g]; gi = g; }
            float gs = 0.f;
#pragma unroll
            for (int g = 0; g < 4; ++g) gs += expf(acc[g] - gm);
            const float p_top = 1.0f / gs;
            float le[8];
#pragma unroll
            for (int j = 0; j < 8; ++j) le[j] = gi == 0 ? acc[4 + j] : gi == 1 ? acc[12 + j] : gi == 2 ? acc[20 + j] : acc[28 + j];
            int e1 = 0; float v1 = -1e30f;
#pragma unroll
            for (int j = 0; j < 8; ++j) if (le[j] > v1) { v1 = le[j]; e1 = j; }
            int e2 = 0; float v2 = -1e30f;
#pragma unroll
            for (int j = 0; j < 8; ++j) if (j != e1 && le[j] > v2) { v2 = le[j]; e2 = j; }
            const float p2 = expf(v2 - v1), inv = 1.0f / (1.0f + p2);
            const int eid0 = gi * 8 + e1, eid1 = gi * 8 + e2;
            const int s0 = (int)__hip_atomic_fetch_add(&hist[eid0], 1u, __ATOMIC_RELAXED, __HIP_MEMORY_SCOPE_WORKGROUP), s1 = (int)__hip_atomic_fetch_add(&hist[eid1], 1u, __ATOMIC_RELAXED, __HIP_MEMORY_SCOPE_WORKGROUP);
            int* tr = tok + row * 8; tr[0] = eid0; tr[1] = eid1; ((float*)tr)[2] = p_top * inv; ((float*)tr)[3] = p_top * p2 * inv; tr[4] = s0; tr[5] = s1; ((float*)tr)[6] = rstd;
        }
    }
    __syncthreads();
    if (tid < 32) ctl[CW_BCNT + blockIdx.x * 32 + tid] = hist[tid];
}

__device__ __forceinline__ void p9_scatter(const bf16_t* x1, const float* gain, const float* mod, unsigned* ctl, int* tok, bf16_t* XB, LAS unsigned* sl, int gw, int ngw, int lane, int tid) {
    const int G = gridDim.x;
    { const int e = tid & 31, part = tid >> 5; unsigned sall = 0, sbef = 0;
      for (int bb = part; bb < G; bb += 16) { const unsigned v = ctl[CW_BCNT + bb * 32 + e]; sall += v; if (bb < (int)blockIdx.x) sbef += v; }
      sl[part * 32 + e] = sall; sl[512 + part * 32 + e] = sbef; }
    __syncthreads();
    if (tid < 64) {
        unsigned cnt = 0, bef = 0;
        if (lane < 32) for (int q = 0; q < 16; ++q) { cnt += sl[q * 32 + lane]; bef += sl[512 + q * 32 + lane]; }
        const unsigned padded = (cnt + 255u) & ~255u; unsigned incl = padded;
#pragma unroll
        for (int o = 1; o < 32; o <<= 1) { const unsigned t = __shfl_up(incl, o); if ((lane & 31) >= o) incl += t; }
        const unsigned excl = incl - padded;
        if (lane < 32) sl[1024 + lane] = excl + bef;
        if (blockIdx.x == 0) {
            const unsigned total = __shfl(incl, 31);
            if (lane == 0) ctl[CW_NBLK] = total >> 8;
            if (lane < 32) for (unsigned i = excl >> 8; i < (incl >> 8); ++i) ctl[CW_BLKE + i] = (unsigned)lane;
        }
    }
    __syncthreads();
    for (int blk = blockIdx.x; blk < TL / 128; blk += gridDim.x) {
        const int R0 = 128 * blk + 16 * (tid >> 6); const float* shift = mod + (R0 >> 11) * 6144 + 3072; const float* scale = shift + 1024;
        f32x4 G[4], S[4];
#pragma unroll
        for (int j = 0; j < 4; ++j) { const int k = lane * 4 + 256 * j; G[j] = *(const f32x4*)(gain + k) * (1.0f + *(const f32x4*)(scale + k)); S[j] = *(const f32x4*)(shift + k); }
#pragma unroll 4
        for (int rr = 0; rr < 16; ++rr) { const int row = R0 + rr; const int* tr = tok + row * 8;
            const int e0 = tr[0], e1 = tr[1]; const float rstd = ((const float*)tr)[6];
            const unsigned d0 = sl[1024 + e0] + (unsigned)tr[4], d1 = sl[1024 + e1] + (unsigned)tr[5];
            u32x2 w[4];
#pragma unroll
            for (int j = 0; j < 4; ++j) { const u32x2 xb = *(const u32x2*)(x1 + (size_t)row * D + lane * 4 + 256 * j); const f32x4 o = (f32x4){bflo(xb.x), bfhi(xb.x), bflo(xb.y), bfhi(xb.y)} * rstd * G[j] + S[j]; w[j].x = pk2(o.x, o.y); w[j].y = pk2(o.z, o.w); }
#pragma unroll
            for (int j = 0; j < 4; ++j) { *(u32x2*)(XB + (size_t)d0 * D + lane * 4 + 256 * j) = w[j]; *(u32x2*)(XB + (size_t)d1 * D + lane * 4 + 256 * j) = w[j]; }
            if (lane == 0) { tok[row * 8 + 4] = (int)d0; tok[row * 8 + 5] = (int)d1; } }
    }
}

__device__ __forceinline__ void p12_final(const bf16_t* x1, float* outp, const float* mod, const int* tok, const bf16_t* YB, const float* gfin, int gw, int ngw, int lane) {
    u32x2 nxv[4]; u32x2 nya[4], nyb[4]; float nw0 = 0.f, nw1 = 0.f; int t2d0 = 0, t2d1 = 0; float t2w0 = 0.f, t2w1 = 0.f;
    if (gw < TL) { const int d0 = tok[gw * 8 + 4], d1 = tok[gw * 8 + 5]; nw0 = ((const float*)tok)[gw * 8 + 2]; nw1 = ((const float*)tok)[gw * 8 + 3];
#pragma unroll
        for (int j = 0; j < 4; ++j) { const int k = lane * 4 + 256 * j; nxv[j] = *(const u32x2*)(x1 + (size_t)gw * D + k); nya[j] = *(const u32x2*)(YB + (size_t)d0 * D + k); nyb[j] = *(const u32x2*)(YB + (size_t)d1 * D + k); } }
    if (gw + ngw < TL) { const int r2 = gw + ngw; t2d0 = tok[r2 * 8 + 4]; t2d1 = tok[r2 * 8 + 5]; t2w0 = ((const float*)tok)[r2 * 8 + 2]; t2w1 = ((const float*)tok)[r2 * 8 + 3]; }
    for (int row = gw; row < TL; row += ngw) {
        const float* ga2 = mod + (row >> 11) * 6144 + 5120; float* dst = outp + (size_t)row * D;
        const float w0 = nw0, w1 = nw1;
        f32x4 xv[4]; u32x2 ya[4], yb[4];
#pragma unroll
        for (int j = 0; j < 4; ++j) { xv[j] = (f32x4){bflo(nxv[j].x), bfhi(nxv[j].x), bflo(nxv[j].y), bfhi(nxv[j].y)}; ya[j] = nya[j]; yb[j] = nyb[j]; }
        const int nrow = row + ngw;
        if (nrow < TL) { nw0 = t2w0; nw1 = t2w1;
#pragma unroll
            for (int j = 0; j < 4; ++j) { const int k = lane * 4 + 256 * j; nxv[j] = *(const u32x2*)(x1 + (size_t)nrow * D + k); nya[j] = *(const u32x2*)(YB + (size_t)t2d0 * D + k); nyb[j] = *(const u32x2*)(YB + (size_t)t2d1 * D + k); }
            const int r2 = nrow + ngw;
            if (r2 < TL) { t2d0 = tok[r2 * 8 + 4]; t2d1 = tok[r2 * 8 + 5]; t2w0 = ((const float*)tok)[r2 * 8 + 2]; t2w1 = ((const float*)tok)[r2 * 8 + 3]; } }
        f32x4 v[4]; float ss = 0.f;
#pragma unroll
        for (int j = 0; j < 4; ++j) { const int k = lane * 4 + 256 * j; const f32x4 g = *(const f32x4*)(ga2 + k); const u32x2 a = ya[j], bq = yb[j];
            f32x4 y; y.x = w0 * bflo(a.x) + w1 * bflo(bq.x); y.y = w0 * bfhi(a.x) + w1 * bfhi(bq.x); y.z = w0 * bflo(a.y) + w1 * bflo(bq.y); y.w = w0 * bfhi(a.y) + w1 * bfhi(bq.y);
            v[j] = xv[j] + g * y; ss += v[j].x * v[j].x + v[j].y * v[j].y + v[j].z * v[j].z + v[j].w * v[j].w; }
        const float rstd = rsqrtf(wave_sum_fast(ss) * (1.0f / D) + EPS);
#pragma unroll
        for (int j = 0; j < 4; ++j) { const int k = lane * 4 + 256 * j; const f32x4 g = *(const f32x4*)(gfin + k); *(f32x4*)(dst + k) = v[j] * rstd * g; }
    }
}

typedef float f32x16 __attribute__((ext_vector_type(16)));
typedef short v4i16_t __attribute__((ext_vector_type(4)));
using pg8::bf16x8;
constexpr int ATT_CK_OFF = 2048, ATT_CV_OFF = ATT_CK_OFF + 32768, ATT_RING_OFF = ATT_CV_OFF + 32768, ATT_SK_OFF = ATT_RING_OFF + 32768, ATT_SV_OFF = ATT_SK_OFF + 11 * 2048;
static_assert(ATT_SV_OFF + 11 * 2048 <= MISC_OFF, "attention LDS map");
__device__ __forceinline__ void p3_attn(const bf16_t* Qb, bf16_t* Ob, const bf16_t* Kb, const bf16_t* Vb, const float* rpb, const f32x2* rope, LAS unsigned char* lds, int wave, int lane) {
    constexpr float L2E = 1.4426950408889634f, SC = 0.125f * L2E;
    const int tid = wave * 64 + lane, ql = lane & 31, hl = lane >> 5, skey = tid >> 3, sch = tid & 7;
    LAS float* rpbL = (LAS float*)lds;
    const int vq = (lane & 15) >> 2, vcol = (16 * ((lane >> 4) & 1) + 4 * (lane & 3)) * 2;
    const int g = wave & 1, sside = skey >= 24 && skey < 40;
    for (int it = blockIdx.x; it < NBATCH * 8 * 2; it += gridDim.x) {
        const int rh = it & 1, h = (it >> 1) & 7, b = it >> 4;
        __syncthreads();
        if (tid < 15 * 32) { const int c = tid & 31, dr = tid >> 5; rpbL[tid] = c < 31 ? rpb[(h * 15 + dr) * 31 + c] * L2E : -1e30f; }
#pragma unroll
        for (int i = 0; i < 4; ++i) { const int key = skey + 64 * i; const size_t row = (size_t)(TL + b * CTXL + key) * 512 + h * 64 + 8 * sch;
            *(LAS u32x4*)(lds + ATT_CK_OFF + key * 128 + ((sch ^ (key & 7)) * 16)) = *(const u32x4*)(Kb + row);
            *(LAS u32x4*)(lds + ATT_CV_OFF + key * 128 + sch * 16) = *(const u32x4*)(Vb + row); }
#pragma unroll 1
        for (int pass = 0; pass < 4; ++pass) {
            const int R0 = 16 * rh + 4 * pass, r = R0 + (wave >> 1);
            const int cq = 32 * g + ql, rs = min(max(r - 4, 0), 24), cstart = min(max(cq - 8, 0), 48);
            const int kmin = min(max(R0 - 4, 0), 24), kmax = min(max(R0 - 1, 0), 24) + 7, nsteps = kmax - kmin + 1;
            const bf16_t* qp = Qb + (size_t)(b * SEQ + r * 64 + cq) * 512 + h * 64; bf16_t* op = Ob + (size_t)(b * SEQ + r * 64 + cq) * 512 + h * 64;
#define ATT_PUT(slot_, krel_, kv_, vv_) do { *(LAS u32x4*)(lds + (slot_) + skey * 128 + ((sch ^ (skey & 7)) * 16)) = (kv_); *(LAS u32x4*)(lds + (slot_) + 8192 + skey * 128 + sch * 16) = (vv_); \
                if (sside) { *(LAS u32x4*)(lds + ATT_SK_OFF + ((krel_) * 16 + skey - 24) * 128 + ((sch ^ (skey & 7)) * 16)) = (kv_); *(LAS u32x4*)(lds + ATT_SV_OFF + ((krel_) * 16 + skey - 24) * 128 + sch * 16) = (vv_); } } while (0)
            { const size_t row = (size_t)(b * SEQ + kmin * 64 + skey) * 512 + h * 64 + 8 * sch; const u32x4 kv = *(const u32x4*)(Kb + row), vv = *(const u32x4*)(Vb + row); ATT_PUT(ATT_RING_OFF, 0, kv, vv); }
            bf16x8 qplain[4], qrot[4];
#pragma unroll
            for (int d0 = 0; d0 < 4; ++d0) { float v[8], o[8], pl[8]; unpack8(*(const u32x4*)(qp + 16 * d0 + 8 * hl), v);
                const int pos = d0 < 2 ? r : cq, i0 = ((16 * d0 + 8 * hl) & 31) >> 1;
#pragma unroll
                for (int j = 0; j < 4; ++j) { const f32x2 cs = rope[pos * 16 + i0 + j]; o[2 * j] = (v[2 * j] * cs.x - v[2 * j + 1] * cs.y) * SC; o[2 * j + 1] = (v[2 * j] * cs.y + v[2 * j + 1] * cs.x) * SC; }
#pragma unroll
                for (int j = 0; j < 8; ++j) pl[j] = v[j] * SC;
                qrot[d0] = __builtin_bit_cast(bf16x8, pack8(o)); qplain[d0] = __builtin_bit_cast(bf16x8, pack8(pl)); }
            int dco[16];
#pragma unroll
            for (int i = 0; i < 16; ++i) { const int kc = 32 * g + (i & 3) + 8 * (i >> 2) + 4 * hl; const bool ok = kc >= cstart && kc < cstart + 16; dco[i] = ok ? (kc - cq + 15) * 4 : 31 * 4; }
            f32x16 o0, o1;
#pragma unroll
            for (int i = 0; i < 16; ++i) { o0[i] = 0.f; o1[i] = 0.f; }
            float m = -1e30f, l = 0.f;
#define ATT_TILE(kp_, vb_, vsk_, ve_, qf) do { \
            _Pragma("unroll") for (int d0 = 0; d0 < 4; ++d0) s = __builtin_amdgcn_mfma_f32_32x32x16_bf16(*(const LAS bf16x8*)((kp_) + (((2 * d0 + hl) ^ (ql & 7)) * 16)), qf[d0], s, 0, 0, 0); \
            float mt = fmaxf(fmaxf(s[0], s[1]), s[2]); \
            _Pragma("unroll") for (int i = 3; i < 15; i += 2) mt = fmaxf(fmaxf(mt, s[i]), s[i + 1]); \
            mt = half_max(fmaxf(mt, s[15])); \
            if (__any(mt > m)) { const float mn = fmaxf(m, mt), alpha = __builtin_amdgcn_exp2f(m - mn); m = mn; l *= alpha; \
                _Pragma("unroll") for (int i = 0; i < 16; ++i) { o0[i] *= alpha; o1[i] *= alpha; } } \
            float ps = 0.f; \
            _Pragma("unroll") for (int i = 0; i < 16; ++i) { s[i] = __builtin_amdgcn_exp2f(s[i] - m); ps += s[i]; } \
            l += ps; \
            bf16x8 pb[2]; \
            _Pragma("unroll") for (int sk = 0; sk < 2; ++sk) { u32x4 w; w.x = pk2(s[8 * sk], s[8 * sk + 1]); w.y = pk2(s[8 * sk + 2], s[8 * sk + 3]); w.z = pk2(s[8 * sk + 4], s[8 * sk + 5]); w.w = pk2(s[8 * sk + 6], s[8 * sk + 7]); \
                pb[sk] = __builtin_bit_cast(bf16x8, w); } \
            _Pragma("unroll") for (int dt = 0; dt < 2; ++dt) _Pragma("unroll") for (int sk = 0; sk < 2; ++sk) { \
                const v4i16_t lo = __builtin_amdgcn_ds_read_tr16_b64_v4i16((LAS v4i16_t*)((vb_) + sk * (vsk_) + dt * 64)); \
                const v4i16_t hi = __builtin_amdgcn_ds_read_tr16_b64_v4i16((LAS v4i16_t*)((vb_) + sk * (vsk_) + (ve_) + dt * 64)); \
                const bf16x8 va = (bf16x8){lo[0], lo[1], lo[2], lo[3], hi[0], hi[1], hi[2], hi[3]}; \
                if (dt == 0) o0 = __builtin_amdgcn_mfma_f32_32x32x16_bf16(va, pb[sk], o0, 0, 0, 0); else o1 = __builtin_amdgcn_mfma_f32_32x32x16_bf16(va, pb[sk], o1, 0, 0, 0); } } while (0)
            __syncthreads();
#pragma unroll 1
            for (int st = 0; st < nsteps; ++st) {
                const int kr = kmin + st, slot = ATT_RING_OFF + (st & 1) * 16384;
                u32x4 nk, nv; const bool more = st + 1 < nsteps;
                if (more) { const size_t row = (size_t)(b * SEQ + (kr + 1) * 64 + skey) * 512 + h * 64 + 8 * sch; nk = *(const u32x4*)(Kb + row); nv = *(const u32x4*)(Vb + row); }
                if (kr >= rs && kr < rs + 8) {
                    const LAS unsigned char* brow = (const LAS unsigned char*)(rpbL + (kr - r + 7) * 32);
                    f32x16 s;
#pragma unroll
                    for (int i = 0; i < 16; ++i) s[i] = *(const LAS float*)(brow + dco[i]);
                    const LAS unsigned char* kp = lds + slot + g * 4096 + ql * 128; const LAS unsigned char* vb = lds + slot + 8192 + g * 4096 + (4 * hl + vq) * 128 + vcol;
                    ATT_TILE(kp, vb, 2048, 1024, qrot);
                }
                if (more) { const int ns = ATT_RING_OFF + ((st + 1) & 1) * 16384; ATT_PUT(ns, st + 1, nk, nv); }
                __syncthreads();
            }
#pragma unroll 1
            for (int x = 0; x < 2; ++x) {
                const int cb = g == 0 ? 8 : 0, krel0 = rs + 4 * x - kmin;
                f32x16 s;
#pragma unroll
                for (int i = 0; i < 16; ++i) { const int kc = 24 + cb + (i & 3) + 4 * hl, dr = rs + 4 * x + (i >> 2) - r + 7; const bool ok = kc >= cstart && kc < cstart + 16;
                    s[i] = ok ? rpbL[dr * 32 + (kc - cq + 15)] : -1e30f; }
                const LAS unsigned char* kp = lds + ATT_SK_OFF + ((krel0 + (ql >> 3)) * 16 + cb + (ql & 7)) * 128;
                const LAS unsigned char* vb = lds + ATT_SV_OFF + (krel0 * 16 + cb + 4 * hl + vq) * 128 + vcol;
                ATT_TILE(kp, vb, 4096, 2048, qrot);
            }
            __syncthreads();
#pragma unroll 1
            for (int ct = 0; ct < 8; ++ct) { f32x16 s;
#pragma unroll
                for (int i = 0; i < 16; ++i) s[i] = 0.f;
                const LAS unsigned char* kp = lds + ATT_CK_OFF + ct * 4096 + ql * 128; const LAS unsigned char* vb = lds + ATT_CV_OFF + ct * 4096 + (4 * hl + vq) * 128 + vcol;
                ATT_TILE(kp, vb, 2048, 1024, qplain); }
#undef ATT_TILE
#undef ATT_PUT
            l = half_sum(l);
            const float il = 1.0f / l;
#pragma unroll
            for (int dt = 0; dt < 2; ++dt)
#pragma unroll
                for (int g4 = 0; g4 < 4; ++g4) { u32x2 w;
                    if (dt == 0) { w.x = pk2(o0[4 * g4] * il, o0[4 * g4 + 1] * il); w.y = pk2(o0[4 * g4 + 2] * il, o0[4 * g4 + 3] * il); }
                    else { w.x = pk2(o1[4 * g4] * il, o1[4 * g4 + 1] * il); w.y = pk2(o1[4 * g4 + 2] * il, o1[4 * g4 + 3] * il); }
                    *(u32x2*)(op + 32 * dt + 8 * g4 + 4 * hl) = w; }
        }
    }
}

constexpr int LRU_WLDS = 8192;
constexpr int LRU_TILES = 72;
__device__ __forceinline__ void lru_conv_frags(const bf16_t* LX, const LAS float* cw, size_t rowbase, int L, int s0, int n, int lane, bf16x8 (&afr)[8], bf16_t* XC) {
    const int token = lane & 31, hl = lane >> 5, s = s0 + token;
    const bool v0 = s >= 2, v1 = s >= 1, v3 = s + 1 < L;
    const bf16_t* rp = LX + (rowbase + s) * 1024 + n * 128 + 8 * hl;
    const bf16_t* r0 = v0 ? rp - 2048 : rp; const bf16_t* r1 = v1 ? rp - 1024 : rp; const bf16_t* r3 = v3 ? rp + 1024 : rp;
    u32x4 xr[2][2][4];
#define LRU_LDPAIR(pp, buf) do { _Pragma("unroll") for (int q = 0; q < 2; ++q) { const int co = 16 * (2 * (pp) + q); \
        xr[buf][q][0] = *(const u32x4*)(r0 + co); xr[buf][q][1] = *(const u32x4*)(r1 + co); xr[buf][q][2] = *(const u32x4*)(rp + co); xr[buf][q][3] = *(const u32x4*)(r3 + co); } } while (0)
    LRU_LDPAIR(0, 0);
#pragma unroll
    for (int pp = 0; pp < 4; ++pp) {
        if (pp < 3) LRU_LDPAIR(pp + 1, (pp + 1) & 1);
        __builtin_amdgcn_sched_barrier(0);
#pragma unroll
        for (int q = 0; q < 2; ++q) { const int chl = 16 * (2 * pp + q) + 8 * hl;
            float acc[8];
            { const f32x4 b0 = *(const LAS f32x4*)(cw + 512 + chl), b1 = *(const LAS f32x4*)(cw + 512 + chl + 4); acc[0] = b0.x; acc[1] = b0.y; acc[2] = b0.z; acc[3] = b0.w; acc[4] = b1.x; acc[5] = b1.y; acc[6] = b1.z; acc[7] = b1.w; }
#pragma unroll
            for (int j = 0; j < 4; ++j) { u32x4 raw = xr[pp & 1][q][j]; const bool ok = j == 0 ? v0 : j == 1 ? v1 : j == 3 ? v3 : true;
                if (j != 2) { raw.x = ok ? raw.x : 0u; raw.y = ok ? raw.y : 0u; raw.z = ok ? raw.z : 0u; raw.w = ok ? raw.w : 0u; }
                float xv[8]; unpack8(raw, xv);
                const f32x4 w0 = *(const LAS f32x4*)(cw + j * 128 + chl), w1 = *(const LAS f32x4*)(cw + j * 128 + chl + 4);
                acc[0] += w0.x * xv[0]; acc[1] += w0.y * xv[1]; acc[2] += w0.z * xv[2]; acc[3] += w0.w * xv[3]; acc[4] += w1.x * xv[4]; acc[5] += w1.y * xv[5]; acc[6] += w1.z * xv[6]; acc[7] += w1.w * xv[7]; }
            const u32x4 pk = pack8(acc); afr[2 * pp + q] = __builtin_bit_cast(bf16x8, pk);
            if (XC) *(u32x4*)(XC + (rowbase + s) * 1024 + n * 128 + chl) = pk; }
        __builtin_amdgcn_sched_barrier(0);
    }
#undef LRU_LDPAIR
}
template <int DIR>
__device__ __forceinline__ void lru_group_dir(const f32x16& accr, const f32x16& acci, const f32x16& xv, float bav, float bxv, float sp, float hin0, int hl, float (&hloc)[16], float& At, float& Ht) {
    float aloc[16], As[4], Hs[4];
#pragma unroll
    for (int g = 0; g < 4; ++g) { float h = 0.f, A = 1.f;
#pragma unroll
        for (int ee = 0; ee < 4; ++ee) { const int e4 = DIR == 0 ? ee : 3 - ee, i = 4 * g + e4;
            const float rg = __builtin_amdgcn_rcpf(1.0f + __builtin_amdgcn_exp2f(accr[i] + bav)), ig = __builtin_amdgcn_rcpf(1.0f + __builtin_amdgcn_exp2f(acci[i] + bxv));
            const float a = __builtin_amdgcn_exp2f(rg * sp), u = __builtin_amdgcn_sqrtf(__builtin_fmaf(-a, a, 1.0f)) * (ig * xv[i]);
            h = a * h + u; A *= a; hloc[i] = h; aloc[i] = A; }
        As[g] = A; Hs[g] = h; }
    float Alo[4], Ahi[4], Hlo[4], Hhi[4];
#pragma unroll
    for (int g = 0; g < 4; ++g) { const auto ra = __builtin_amdgcn_permlane32_swap(__float_as_uint(As[g]), __float_as_uint(As[g]), false, false); Alo[g] = __uint_as_float(ra[0]); Ahi[g] = __uint_as_float(ra[1]);
        const auto rh = __builtin_amdgcn_permlane32_swap(__float_as_uint(Hs[g]), __float_as_uint(Hs[g]), false, false); Hlo[g] = __uint_as_float(rh[0]); Hhi[g] = __uint_as_float(rh[1]); }
    float hin[4]; float st = hin0, Ap = 1.f, st0 = 0.f;
#pragma unroll
    for (int gg = 0; gg < 4; ++gg) { const int g = DIR == 0 ? gg : 3 - gg;
        const float A1 = DIR == 0 ? Alo[g] : Ahi[g], H1 = DIR == 0 ? Hlo[g] : Hhi[g], A2 = DIR == 0 ? Ahi[g] : Alo[g], H2 = DIR == 0 ? Hhi[g] : Hlo[g];
        const float in1 = st; st = A1 * st + H1; st0 = A1 * st0 + H1; const float in2 = st; st = A2 * st + H2; st0 = A2 * st0 + H2; Ap *= A1 * A2;
        hin[g] = (DIR == 0) == (hl == 0) ? in1 : in2; }
    At = Ap; Ht = st0;
#pragma unroll
    for (int i = 0; i < 16; ++i) hloc[i] += aloc[i] * hin[i >> 2];
}
constexpr int LRU_CONST_OFF = 131072;
template <int MODE>
__device__ __forceinline__ void p_lru(const bf16_t* LX, const bf16_t* LW, const float* conv_w, const float* conv_b, const float* ba, const float* bx, const float* SP, f32x2* AGG, bf16_t* XC, const bf16_t* LG, bf16_t* OL,
                                      LAS unsigned char* lds, int wave, int lane) {
    constexpr int abl = 0;
    const int G = gridDim.x, n = blockIdx.x & 7, ql = lane & 31, hl = lane >> 5, tid = wave * 64 + lane;
    LAS float* cst = (LAS float*)(lds + LRU_CONST_OFF);
    {
        u32x4 t[16]; float cv[2], cq[2];
#pragma unroll
        for (int it = 0; it < 16; ++it) { const int idx = tid + it * NTHREADS, dir = idx >> 12, j = (idx >> 4) & 255, c = idx & 15; t[it] = *(const u32x4*)(LW + ((size_t)(dir * 8 + n) * 256 + j) * 128 + 8 * c); }
#pragma unroll
        for (int it = 0; it < 2; ++it) { const int idx = tid + it * NTHREADS, dir = idx / 384, w = (idx / 128) % 3, c = idx & 127; const float* src = w == 0 ? ba : w == 1 ? bx : SP; cv[it] = 0.f;
            if (idx < 2 * 3 * 128) cv[it] = src[dir * 1024 + n * 128 + c] * (w == 2 ? -8.0f * 1.4426950408889634f : -1.4426950408889634f); }
#pragma unroll
        for (int it = 0; it < 2; ++it) { const int idx = tid + it * NTHREADS; cq[it] = 0.f; if (MODE == 1 && idx < 640) cq[it] = idx < 512 ? conv_w[(idx >> 7) * 1024 + n * 128 + (idx & 127)] : conv_b[n * 128 + (idx & 127)]; }
#pragma unroll
        for (int it = 0; it < 16; ++it) { const int idx = tid + it * NTHREADS, dir = idx >> 12, j = (idx >> 4) & 255, c = idx & 15; *(LAS u32x4*)(lds + (dir * 256 + j) * 256 + ((c ^ (j & 15)) * 16)) = t[it]; }
#pragma unroll
        for (int it = 0; it < 2; ++it) { const int idx = tid + it * NTHREADS; if (MODE == 1 && idx < 640) cst[768 + idx] = cq[it]; }
#pragma unroll
        for (int it = 0; it < 2; ++it) { const int idx = tid + it * NTHREADS; if (idx < 2 * 3 * 128) cst[idx] = cv[it]; }
    }
    __syncthreads();
    const int tiles_per_b = MODE == 1 ? LRU_TILES : 64, nq = 16 * tiles_per_b, stride = (G >> 3) * NWAVES;
    for (int q = (blockIdx.x >> 3) * NWAVES + wave; q < nq; q += stride) {
        const int b = q / tiles_per_b, tile = MODE == 1 ? q % tiles_per_b : 8 + q % tiles_per_b;
        const size_t rowbase = tile < 8 ? (size_t)(TL + b * CTXL) : (size_t)b * SEQ; const int L = tile < 8 ? CTXL : SEQ, s0 = tile < 8 ? tile * 32 : (tile - 8) * 32;
        bf16x8 afr[8];
        if (MODE == 1) lru_conv_frags(LX, cst + 768, rowbase, L, s0, n, lane, afr, XC);
        else {
#pragma unroll
            for (int ks = 0; ks < 8; ++ks) afr[ks] = *(const bf16x8*)(XC + (abl == 4 ? (size_t)ql * 1024 : (rowbase + s0 + ql) * 1024 + n * 128) + 16 * ks + 8 * hl); }
#pragma unroll 1
        for (int cg = 0; cg < 4; ++cg) {
            const bf16x8 ax0 = cg == 0 ? afr[0] : cg == 1 ? afr[2] : cg == 2 ? afr[4] : afr[6], ax1 = cg == 0 ? afr[1] : cg == 1 ? afr[3] : cg == 2 ? afr[5] : afr[7];
            const int cl = cg * 32 + ql;
            float hinf = 0.f, hinb = 0.f;
            if (MODE == 2) { hinf = AGG[((size_t)b * LRU_TILES + tile) * 1024 + n * 128 + cl].x; hinb = AGG[((size_t)(16 + b) * LRU_TILES + tile) * 1024 + n * 128 + cl].x; }
            unsigned short gq[16];
            if (MODE == 2) {
#pragma unroll
                for (int i = 0; i < 16; ++i) gq[i] = LG[(rowbase + s0 + (i & 3) + 8 * (i >> 2) + 4 * hl) * 1024 + n * 128 + cl];
                __builtin_amdgcn_sched_barrier(0); }
            f32x16 xv;
#pragma unroll
            for (int i = 0; i < 16; ++i) xv[i] = 0.f;
            { bf16x8 idf[2];
#pragma unroll
              for (int kk = 0; kk < 2; ++kk)
#pragma unroll
                  for (int j = 0; j < 8; ++j) idf[kk][j] = (16 * kk + 8 * hl + j == ql) ? (short)0x3F80 : (short)0;
              xv = __builtin_amdgcn_mfma_f32_32x32x16_bf16(ax0, idf[0], xv, 0, 0, 0); xv = __builtin_amdgcn_mfma_f32_32x32x16_bf16(ax1, idf[1], xv, 0, 0, 0); }
            float hsum[16];
#pragma unroll
            for (int dir = 0; dir < 2; ++dir) {
                const LAS unsigned char* wr = lds + (dir * 256 + cl) * 256; const LAS unsigned char* wi = wr + 128 * 256;
                f32x16 accr, acci;
#pragma unroll
                for (int i = 0; i < 16; ++i) { accr[i] = 0.f; acci[i] = 0.f; }
                if (abl != 2) { bf16x8 bw[8];
#pragma unroll
                  for (int k = 0; k < 8; ++k) bw[k] = *(const LAS bf16x8*)(wr + (((2 * k + hl) ^ (cl & 15)) * 16));
#pragma unroll
                  for (int k = 0; k < 8; ++k) accr = __builtin_amdgcn_mfma_f32_32x32x16_bf16(afr[k], bw[k], accr, 0, 0, 0);
                  __builtin_amdgcn_sched_barrier(0);
#pragma unroll
                  for (int k = 0; k < 8; ++k) bw[k] = *(const LAS bf16x8*)(wi + (((2 * k + hl) ^ (cl & 15)) * 16));
#pragma unroll
                  for (int k = 0; k < 8; ++k) acci = __builtin_amdgcn_mfma_f32_32x32x16_bf16(afr[k], bw[k], acci, 0, 0, 0); }
                __builtin_amdgcn_sched_barrier(0);
                const float bav = cst[dir * 384 + cl], bxv = cst[dir * 384 + 128 + cl], sp = cst[dir * 384 + 256 + cl];
                const float hin0 = dir == 0 ? hinf : hinb;
                float hout[16], At, Ht;
                if (abl == 1) { _Pragma("unroll") for (int i = 0; i < 16; ++i) hout[i] = accr[i] + acci[i] * xv[i] + hin0 + bav + bxv + sp; At = 1.f; Ht = 0.f; }
                else if (dir == 0) lru_group_dir<0>(accr, acci, xv, bav, bxv, sp, hin0, hl, hout, At, Ht);
                else lru_group_dir<1>(accr, acci, xv, bav, bxv, sp, hin0, hl, hout, At, Ht);
                if (MODE == 1) { if (hl == 0) AGG[((size_t)(dir * 16 + b) * LRU_TILES + tile) * 1024 + n * 128 + cl] = (f32x2){At, Ht}; }
                else {
#pragma unroll
                    for (int i = 0; i < 16; ++i) hsum[i] = dir == 0 ? hout[i] : hsum[i] + hout[i]; }
            }
            if (MODE == 2) {
                if (abl == 3) { float t_ = 0.f; _Pragma("unroll") for (int i = 0; i < 16; ++i) t_ += hsum[i]; if (t_ == 123.456f) OL[0] = 0; }
                else {
#pragma unroll
                for (int i = 0; i < 16; ++i) OL[(rowbase + s0 + (i & 3) + 8 * (i >> 2) + 4 * hl) * 1024 + n * 128 + cl] = (bf16_t)f2bf(hsum[i] * bf2f(gq[i]));
                }
            }
        }
    }
}
__device__ __forceinline__ void p_lru_carry(f32x2* AGG, int tid) {
    const int gid = blockIdx.x * NTHREADS + tid;
    if (gid >= 2 * 16 * 1024) return;
    const int dir = gid >> 14, b = (gid >> 10) & 15, ch = gid & 1023;
    f32x2* base = AGG + (size_t)(dir * 16 + b) * LRU_TILES * 1024 + ch;
    float h = 0.f;
#pragma unroll 1
    for (int s0 = 0; s0 < LRU_TILES; s0 += 24) {
        f32x2 v[24];
#pragma unroll
        for (int s = 0; s < 24; ++s) { const int st = s0 + s, tile = dir == 0 ? st : (st < 8 ? 7 - st : 79 - st); v[s] = base[(size_t)tile * 1024]; }
#pragma unroll
        for (int s = 0; s < 24; ++s) { const int st = s0 + s, tile = dir == 0 ? st : (st < 8 ? 7 - st : 79 - st); base[(size_t)tile * 1024].x = h; h = v[s].x * h + v[s].y; }
    }
}

__device__ __forceinline__ unsigned char* lds_ptr(LAS unsigned char* ldsl, int i) {
    const LAS unsigned* t = (const LAS unsigned*)(ldsl + MISC_OFF + 1024) + 2 * i;
    const unsigned lo = __builtin_amdgcn_readfirstlane(t[0]), hi = __builtin_amdgcn_readfirstlane(t[1]);
    return (unsigned char*)(__attribute__((address_space(1))) unsigned char*)(((unsigned long long)hi << 32) | lo);
}
struct MArgs { const float* in[28]; float* out; unsigned char* ws; int ph_lo, ph_hi, li, extra; };
__global__ void __launch_bounds__(NTHREADS, 2) mega(MArgs a) {
    extern __shared__ __attribute__((aligned(16))) unsigned char lds[];
    const int wave = __builtin_amdgcn_readfirstlane(threadIdx.x >> 6);
#define LANE ((int)__builtin_amdgcn_mbcnt_hi(~0u, __builtin_amdgcn_mbcnt_lo(~0u, 0u)))
#define TID (wave * 64 + LANE)
    const int G = gridDim.x, gw = blockIdx.x * NWAVES + wave, ngw = G * NWAVES;
    LAS unsigned char* ldsl = (LAS unsigned char*)lds;
    volatile LAS unsigned* MISC = (volatile LAS unsigned*)(ldsl + MISC_OFF);
    for (int u = TID; u < (LDS_BYTES - MISC_OFF) / 4; u += NTHREADS) ((LAS unsigned*)(ldsl + MISC_OFF))[u] = 0u;
    __syncthreads();
    { LAS unsigned long long* pt = (LAS unsigned long long*)(ldsl + MISC_OFF + 1024);
      const int tid = TID;
      if (tid < 28) pt[tid] = (unsigned long long)a.in[tid];
      if (tid == 28) pt[28] = (unsigned long long)(a.extra ? (float*)(a.ws + WS_XB) : a.out);
      if (tid == 29) pt[29] = (unsigned long long)a.ws; }
    XcdBarrier bar = xcd_barrier_post((unsigned*)(a.ws + WS_CTL) + CW_BAR + a.li * XCD_BAR_WORDS, MISC + 8, wave == 0 && LANE == 0);
    const int lo = a.ph_lo, hi = a.ph_hi, extra = a.extra;
    __syncthreads();
#define PTR(i) ((const float*)lds_ptr(ldsl, (i)))
#define OUTP ((float*)lds_ptr(ldsl, 28))
#define WSP(off) (lds_ptr(ldsl, 29) + (off))
#define IN(k) (lo <= (k) && (k) < hi)
#define SEAM(k) do { if (IN(k) && IN((k) + 1)) xcd_barrier(bar, wave); } while (0)
    if (IN(0)) { unsigned char* ws = WSP(0); p0_prep(ws, ldsl, gw, ngw, LANE, wave); __syncthreads();
        p0_mod(PTR(1), PTR(3), PTR(4), PTR(5), PTR(20), PTR(22), (f32x4*)(ws + WS_MOD + 600 * 1024), PTR(16), (float*)(ws + WS_MOD + 760 * 1024), (float*)(ws + WS_MOD), (f32x2*)(ws + WS_MOD + 512 * 1024), (LAS float*)ldsl, TID); }
    SEAM(0);
    if (IN(1)) { unsigned char* ws = WSP(0); p1_router_tables(PTR(7), (const float*)(ws + WS_MOD), (const f32x4*)(ws + WS_MOD + 600 * 1024), PTR(21), PTR(23), (float*)(ws + WS_RWT), (float*)(ws + WS_RWT + 3 * MiB), gw, ngw, LANE);
        p1_adanorm(PTR(0), PTR(2), PTR(6), (const float*)(ws + WS_MOD), (bf16_t*)OUTP, gw, ngw, LANE); }
    SEAM(1);
    if (IN(2)) { unsigned char* ws = WSP(0); pg8::Gemm g{(const bf16_t*)OUTP, (const bf16_t*)(ws + WS_WIN), TALL, PROJ, 1024}; ProjOrder S; S.init(G, (int)blockIdx.x);
        EpiF<EpiProj> E{{(bf16_t*)(ws + WS_K), (bf16_t*)(ws + WS_V), (bf16_t*)(ws + WS_LX), (bf16_t*)(ws + WS_Q), (bf16_t*)(ws + WS_LG), ws + WS_GA, ws + WS_GB, (const f32x2*)(ws + WS_MOD + 512 * 1024)}};
        pg8::gemm_phase<EpiF<EpiProj>, ProjOrder, true, true>(ldsl, g, S, E, wave); }
    SEAM(2);
    if (IN(3)) { unsigned char* ws = WSP(0); bf16_t* LGb = (bf16_t*)(ws + WS_LG);
        p_lru<1>((const bf16_t*)(ws + WS_LX), (const bf16_t*)(ws + WS_LW), PTR(10), PTR(11), PTR(13), PTR(15), (const float*)(ws + WS_MOD + 760 * 1024), (f32x2*)OUTP, (bf16_t*)((unsigned char*)OUTP + 24 * MiB), LGb, LGb, ldsl, wave, LANE);
        __syncthreads(); }
    if (IN(3) || extra == 2) { unsigned char* ws = WSP(0); bf16_t* Qb = (bf16_t*)(ws + WS_Q);
        p3_attn(Qb, Qb, (const bf16_t*)(ws + WS_K), (const bf16_t*)(ws + WS_V), PTR(9), (const f32x2*)(ws + WS_MOD + 512 * 1024), ldsl, wave, LANE); }
    SEAM(3);
    if (IN(4)) p_lru_carry((f32x2*)OUTP, TID);
    if (IN(4)) { unsigned char* ws = WSP(0); pg8::Gemm g{(const bf16_t*)(ws + WS_Q), (const bf16_t*)(ws + WS_WA), TL, 1024, 512}; pg8::StaticOrder S; S.init(TL, 1024, G, (int)blockIdx.x); EpiF2<EpiUpAttn> E{{ws + WS_GA, (bf16_t*)(ws + WS_Y)}};
        pg8::gemm_phase<EpiF2<EpiUpAttn>, pg8::StaticOrder, true, true>(ldsl, g, S, E, wave); }
    SEAM(4);
    if (IN(5)) { unsigned char* ws = WSP(0); bf16_t* LGb = (bf16_t*)(ws + WS_LG);
        p_lru<2>((const bf16_t*)(ws + WS_LX), (const bf16_t*)(ws + WS_LW), PTR(10), PTR(11), PTR(13), PTR(15), (const float*)(ws + WS_MOD + 760 * 1024), (f32x2*)OUTP, (bf16_t*)((unsigned char*)OUTP + 24 * MiB), LGb, LGb, ldsl, wave, LANE); }
    SEAM(5);
    if (IN(6)) { unsigned char* ws = WSP(0); bf16_t* Yb = (bf16_t*)(ws + WS_Y); pg8::Gemm g{(const bf16_t*)(ws + WS_LG), (const bf16_t*)(ws + WS_WL), TL, 1024, 1024}; pg8::StaticOrder S; S.init(TL, 1024, G, (int)blockIdx.x);
        EpiF2<EpiUpLru> E{{Yb, ws + WS_GB, Yb}};
        pg8::gemm_phase<EpiF2<EpiUpLru>, pg8::StaticOrder, true, true>(ldsl, g, S, E, wave); }
    SEAM(6);
    if (IN(7)) { unsigned char* ws = WSP(0); pg8::Gemm g{(const bf16_t*)(ws + WS_Y), (const bf16_t*)(ws + WS_WO), TL, 1024, 1024}; pg8::StaticOrder S; S.init(TL, 1024, G, (int)blockIdx.x);
        EpiF2<EpiOut> E{{PTR(0), (const float*)(ws + WS_MOD), (bf16_t*)(ws + WS_X1B)}};
        pg8::gemm_phase<EpiF2<EpiOut>, pg8::StaticOrder, true, true>(ldsl, g, S, E, wave); }
    SEAM(7);
    if (IN(8)) { unsigned char* ws = WSP(0);
        p8_route((const bf16_t*)(ws + WS_X1B), (const float*)(ws + WS_RWT), (const float*)(ws + WS_RWT + 3 * MiB), (unsigned*)(ws + WS_CTL), (int*)(ws + WS_TOK), ldsl, LANE, TID, wave); }
    SEAM(8);
    if (IN(9)) { unsigned char* ws = WSP(0); p9_scatter((const bf16_t*)(ws + WS_X1B), PTR(7), (const float*)(ws + WS_MOD), (unsigned*)(ws + WS_CTL), (int*)(ws + WS_TOK), (bf16_t*)(ws + WS_XB), (LAS unsigned*)ldsl, gw, ngw, LANE, TID); }
    SEAM(9);
    if (IN(10)) { unsigned char* ws = WSP(0); pg8::Gemm g{(const bf16_t*)(ws + WS_XB), (const bf16_t*)(ws + WS_W13), MOE_ROWS, 1024, 1024}; MoeOrder S; S.init((const unsigned*)(ws + WS_CTL), G, (int)blockIdx.x, (size_t)1024 * 1024 * 2);
        EpiF<EpiMoe1> E{{(bf16_t*)OUTP}};
        pg8::gemm_phase<EpiF<EpiMoe1>, MoeOrder, true, true>(ldsl, g, S, E, wave); }
    SEAM(10);
    if (IN(11)) { unsigned char* ws = WSP(0); pg8::Gemm g{(const bf16_t*)OUTP, (const bf16_t*)(ws + WS_W2), MOE_ROWS, 1024, 512}; MoeOrder S; S.init((const unsigned*)(ws + WS_CTL), G, (int)blockIdx.x, (size_t)1024 * 512 * 2);
        EpiF<EpiMoe2> E{{(bf16_t*)(ws + WS_YB)}};
        pg8::gemm_phase<EpiF<EpiMoe2>, MoeOrder, true, true>(ldsl, g, S, E, wave); }
    SEAM(11);
    if (IN(12)) { unsigned char* ws = WSP(0); p12_final((const bf16_t*)(ws + WS_X1B), OUTP, (const float*)(ws + WS_MOD), (const int*)(ws + WS_TOK), (const bf16_t*)(ws + WS_YB), PTR(27), gw, ngw, LANE); }
#undef PTR
#undef OUTP
#undef WSP
#undef LANE
#undef TID
#undef IN
#undef SEAM
}

extern "C" void kernel_launch(void* const* d_in, const int* in_sizes, int n_in, void* d_out, int out_size, void* d_ws, size_t ws_size, hipStream_t stream) {
    static int grid = 0;
    if (grid == 0) {
        if (n_in != 28 || out_size != TL * D || ws_size < WS_END) { fprintf(stderr, "kernel_launch: unexpected problem (n_in %d, out %d, ws %zu < %zu)\n", n_in, out_size, ws_size, (size_t)WS_END); grid = -1; return; }
        int dev = 0, cus = 0, per_cu = 0;
        if (hipGetDevice(&dev) != hipSuccess || hipDeviceGetAttribute(&cus, hipDeviceAttributeMultiprocessorCount, dev) != hipSuccess) { grid = -1; return; }
        if (hipFuncSetAttribute((const void*)mega, hipFuncAttributeMaxDynamicSharedMemorySize, LDS_BYTES) != hipSuccess) { fprintf(stderr, "kernel_launch: hipFuncSetAttribute failed\n"); grid = -1; return; }
        if (hipOccupancyMaxActiveBlocksPerMultiprocessor(&per_cu, (const void*)mega, NTHREADS, LDS_BYTES) != hipSuccess || per_cu < 1) { fprintf(stderr, "kernel_launch: occupancy query says %d blocks per CU\n", per_cu); grid = -1; return; }
        (void)hipGetLastError();
        grid = cus;
    }
    if (grid < 0) return;
    const float* const* in = (const float* const*)d_in;
    unsigned char* ws = (unsigned char*)d_ws; float* out = (float*)d_out;
    (void)hipMemsetAsync(ws + WS_CTL, 0, CTL_ZERO_BYTES, stream);
    MArgs a{};
    for (int i = 0; i < 28; ++i) a.in[i] = in[i];
    a.out = out; a.ws = ws;
    auto launch = [&](int lo, int hi, int li, int extra) {
        a.ph_lo = lo; a.ph_hi = hi; a.li = li; a.extra = extra; void* args[] = {&a};
        const hipError_t e = hipLaunchCooperativeKernel((const void*)mega, dim3(grid), dim3(NTHREADS), args, LDS_BYTES, stream);
        if (e != hipSuccess) fprintf(stderr, "kernel_launch: cooperative launch failed: %s (grid %d)\n", hipGetErrorString(e), grid);
    };
    launch(0, 13, 0, 0);
    EXTRA_LAUNCHES
}
```

```cpp
#include <hip/hip_runtime.h>
#include <cstdio>
#include <cstdint>

typedef float f32x2 __attribute__((ext_vector_type(2)));
typedef unsigned u32x2 __attribute__((ext_vector_type(2)));
#define EXTRA_LAUNCHES
namespace pg8 {
#define PG8_LAS __attribute__((address_space(3)))
typedef unsigned short bf16_t;
typedef short bf16x8 __attribute__((ext_vector_type(8)));
typedef float f32x4 __attribute__((ext_vector_type(4)));
typedef unsigned u32x4 __attribute__((ext_vector_type(4)));
constexpr int BM = 256, BK = 64, HALF = 128, HTB = HALF * BK * 2  , STAGE_BYTES = 8 * HTB, NXCD = 8, WGM = 8;

__host__ __device__ __forceinline__ int lds_byte(int r, int c) { const int st = (r >> 4) * 2 + (c >> 5), rr = r & 15, cc = c & 31, ob = rr * 64 + cc * 2; return st * 1024 + (ob ^ (((ob >> 9) & 1) << 5)); }
__host__ __device__ __forceinline__ void stage_rc(int b, int& R, int& C) { const int st = b / 1024, sb = b % 1024, swz = sb ^ (((sb >> 9) & 1) << 5); R = (st >> 1) * 16 + swz / 64; C = (st & 1) * 32 + (swz % 64) / 2; }
__host__ __device__ __forceinline__ int perm32(int rho) { const int n = rho >> 4, i = rho & 15; return 8 * (i >> 2) + 4 * n + (i & 3); }

struct Unit { int pm, pn; size_t bofs; };
struct Gemm { const bf16_t* A; const bf16_t* Bt; int M, N, K; };

struct StaticOrder {
    int nM, nN, nwg, G, c;
    __host__ __device__ __forceinline__ void init(int M, int N, int G_, int c_) { nM = M / BM; nN = N / BM; nwg = nM * nN; G = G_; c = c_; }
    __host__ __device__ __forceinline__ bool next(int i, Unit& u) const {
        const long L = (long)i * G + c; if (L >= nwg) return false;
        int wgid = (int)L; { const int q = nwg / NXCD, r = nwg % NXCD, xcd = wgid % NXCD, off = wgid / NXCD; wgid = (xcd < r ? xcd * (q + 1) : r * (q + 1) + (xcd - r) * q) + off; }
        const int nig = WGM * nN, gid = wgid / nig, fm = gid * WGM, gsz = (nM - fm) < WGM ? (nM - fm) : WGM;
        u.pm = fm + ((wgid % nig) % gsz); u.pn = (wgid % nig) / gsz; u.bofs = 0; return true;
    }
    __device__ __forceinline__ void a_ready(const Unit&) const {}
    __device__ __forceinline__ void done(const Unit&) const {}
};


template <class Epi, class Sched, bool ALIGN_EPI = false, bool SP2 = false>
__device__ __forceinline__ void gemm_phase(PG8_LAS unsigned char* lds, const Gemm g, const Sched& S, const Epi& E, int wid) {
    const int lane = (int)__builtin_amdgcn_mbcnt_hi(~0u, __builtin_amdgcn_mbcnt_lo(~0u, 0u)), tid = wid * 64 + lane, wr = wid >> 2, wc = wid & 3, fr = lane & 15, fq = lane >> 4;
    const int K = g.K, nt = K / BK;
    unsigned voffA[2], voffB[2];
#pragma unroll
    for (int i = 0; i < 2; ++i) { int R, C; stage_rc(tid * 16 + i * 8192, R, C); const int Rb = Epi::PERM ? ((R & ~31) + perm32(R & 31)) : R;
        voffA[i] = (unsigned)(R * K + C) * 2u; voffB[i] = (unsigned)(Rb * K + C) * 2u; }
    const size_t kstep = (size_t)(BK * 2);
    const size_t hstep = (size_t)HALF * K * 2;
    const size_t tstep = 2 * hstep;
    const unsigned ldsw = (unsigned)wid * 1024u;
    const int aoff = lds_byte(wr * 64 + fr, fq * 8), boff = lds_byte(wc * 32 + fr, fq * 8);
#define PG8_SA(b, h) (((b) * 2 + (h)) * HTB)
#define PG8_SB(b, h) ((4 + (b) * 2 + (h)) * HTB)
#define PG8_STAGE(bufoff, gbase, voff) do { _Pragma("unroll") for (int _i = 0; _i < 2; ++_i) \
        __builtin_amdgcn_global_load_lds((const unsigned*)((const char*)(gbase) + (voff)[_i]), (PG8_LAS unsigned*)(lds + (bufoff) + ldsw + _i * 8192), 16, 0, 0); } while (0)
#define PG8_LDA(dst, b, h) do { _Pragma("unroll") for (int m = 0; m < 4; ++m) _Pragma("unroll") for (int k = 0; k < 2; ++k) dst[m][k] = *(const PG8_LAS bf16x8*)(lds + PG8_SA(b, h) + aoff + m * 2048 + k * 1024); } while (0)
#define PG8_LDB(dst, b, h) do { _Pragma("unroll") for (int n = 0; n < 2; ++n) _Pragma("unroll") for (int k = 0; k < 2; ++k) dst[n][k] = *(const PG8_LAS bf16x8*)(lds + PG8_SB(b, h) + boff + n * 2048 + k * 1024); } while (0)
#define PG8_MMA(ai, bj, At, Bt) do { __builtin_amdgcn_s_setprio(1); _Pragma("unroll") for (int m = 0; m < 4; ++m) _Pragma("unroll") for (int n = 0; n < 2; ++n) _Pragma("unroll") for (int k = 0; k < 2; ++k) \
        acc[ai][bj][m][n] = __builtin_amdgcn_mfma_f32_16x16x32_bf16(Bt[n][k], At[m][k], acc[ai][bj][m][n], 0, 0, 0); __builtin_amdgcn_s_setprio(0); } while (0)
#define PG8_WAIT_V(n) asm volatile("s_waitcnt vmcnt(" #n ")" ::: "memory")
#define PG8_WAIT_L(n) asm volatile("s_waitcnt lgkmcnt(" #n ")" ::: "memory")
#define PG8_BAR __builtin_amdgcn_s_barrier()
#define PG8_SCHED __builtin_amdgcn_sched_barrier(0)
    Unit cur, nxt; int ui = 0;
    if (!S.next(0, cur)) return;
    f32x4 acc[2][2][4][2];
#pragma unroll
    for (int a = 0; a < 2; ++a)
#pragma unroll
        for (int b = 0; b < 2; ++b)
#pragma unroll
            for (int m = 0; m < 4; ++m)
#pragma unroll
                for (int n = 0; n < 2; ++n) acc[a][b][m][n] = (f32x4){0.f, 0.f, 0.f, 0.f};
    bf16x8 At[4][2], B0[2][2], B1[2][2];
    const char* cA = (const char*)g.A + (size_t)cur.pm * tstep; const char* cB = (const char*)g.Bt + (size_t)cur.pn * tstep + cur.bofs;
    S.a_ready(cur);
    if constexpr (SP2) {
        PG8_STAGE(PG8_SB(0, 0), cB, voffB); PG8_STAGE(PG8_SB(0, 1), cB + hstep, voffB); PG8_STAGE(PG8_SA(0, 0), cA, voffA); PG8_STAGE(PG8_SA(0, 1), cA + hstep, voffA);
        if (wr == 1) PG8_BAR;
        PG8_WAIT_V(2); PG8_BAR;
        PG8_STAGE(PG8_SB(1, 0), cB + kstep, voffB); PG8_STAGE(PG8_SA(1, 0), cA + kstep, voffA); PG8_STAGE(PG8_SB(1, 1), cB + hstep + kstep, voffB);
        PG8_WAIT_V(6); PG8_BAR;
    } else {
        PG8_STAGE(PG8_SB(0, 0), cB, voffB); PG8_STAGE(PG8_SA(0, 0), cA, voffA); PG8_STAGE(PG8_SB(0, 1), cB + hstep, voffB); PG8_STAGE(PG8_SA(0, 1), cA + hstep, voffA);
        if (wr == 1) PG8_BAR;
        PG8_WAIT_V(4); PG8_BAR;
        PG8_STAGE(PG8_SB(1, 0), cB + kstep, voffB); PG8_STAGE(PG8_SA(1, 0), cA + kstep, voffA); PG8_STAGE(PG8_SB(1, 1), cB + hstep + kstep, voffB);
        PG8_WAIT_V(6); PG8_BAR;
    }
    for (;;) {
        const bool has_next = S.next(ui + 1, nxt);
        const char* nA = has_next ? (const char*)g.A + (size_t)nxt.pm * tstep : cA; const char* nB = has_next ? (const char*)g.Bt + (size_t)nxt.pn * tstep + nxt.bofs : cB;
        for (int t = 0; t < nt; t += 2) {
            const bool last = (t == nt - 2);
            const char* a1 = cA + (size_t)(t + 1) * kstep;
            const char* a2 = last ? nA : cA + (size_t)(t + 2) * kstep; const char* b2 = last ? nB : cB + (size_t)(t + 2) * kstep;
            const char* a3 = a2 + kstep; const char* b3 = b2 + kstep;
            if (last && has_next) S.a_ready(nxt);
            if constexpr (SP2) {
            PG8_LDB(B0, 0, 0); PG8_LDB(B1, 0, 1); PG8_SCHED; PG8_LDA(At, 0, 0); PG8_STAGE(PG8_SA(1, 1), a1 + hstep, voffA);
            PG8_WAIT_V(8); PG8_WAIT_L(0); PG8_BAR; PG8_MMA(0, 0, At, B0); PG8_MMA(0, 1, At, B1); PG8_BAR; PG8_SCHED;
            PG8_LDA(At, 0, 1); PG8_STAGE(PG8_SB(0, 0), b2, voffB); PG8_STAGE(PG8_SB(0, 1), b2 + hstep, voffB); PG8_STAGE(PG8_SA(0, 0), a2, voffA);
            PG8_WAIT_V(8); PG8_WAIT_L(0); PG8_BAR; PG8_MMA(1, 0, At, B0); PG8_MMA(1, 1, At, B1); PG8_BAR; PG8_SCHED;
            PG8_LDB(B0, 1, 0); PG8_LDB(B1, 1, 1); PG8_SCHED; PG8_LDA(At, 1, 0); PG8_STAGE(PG8_SA(0, 1), a2 + hstep, voffA);
            PG8_WAIT_V(8); PG8_WAIT_L(0); PG8_BAR; PG8_MMA(0, 0, At, B0); PG8_MMA(0, 1, At, B1); PG8_BAR; PG8_SCHED;
            PG8_LDA(At, 1, 1); PG8_STAGE(PG8_SB(1, 0), b3, voffB); PG8_STAGE(PG8_SB(1, 1), b3 + hstep, voffB); PG8_STAGE(PG8_SA(1, 0), a3, voffA);
            PG8_WAIT_V(8); PG8_WAIT_L(0); PG8_BAR; PG8_MMA(1, 0, At, B0); PG8_MMA(1, 1, At, B1); PG8_BAR; PG8_SCHED;
            } else {
            PG8_LDB(B0, 0, 0); PG8_SCHED; PG8_LDA(At, 0, 0); PG8_STAGE(PG8_SA(1, 1), a1 + hstep, voffA);
            PG8_WAIT_L(8); PG8_BAR; PG8_WAIT_L(0); PG8_MMA(0, 0, At, B0); PG8_BAR; PG8_SCHED;
            PG8_LDB(B1, 0, 1); PG8_STAGE(PG8_SB(0, 0), b2, voffB);
            PG8_BAR; PG8_WAIT_L(0); PG8_MMA(0, 1, At, B1); PG8_BAR;
            PG8_LDA(At, 0, 1); PG8_STAGE(PG8_SA(0, 0), a2, voffA);
            PG8_BAR; PG8_WAIT_L(0); PG8_MMA(1, 0, At, B0); PG8_BAR; PG8_SCHED;
            PG8_STAGE(PG8_SB(0, 1), b2 + hstep, voffB);
            PG8_WAIT_V(6); PG8_BAR; PG8_MMA(1, 1, At, B1); PG8_BAR;
            PG8_LDB(B0, 1, 0); PG8_SCHED; PG8_LDA(At, 1, 0); PG8_STAGE(PG8_SA(0, 1), a2 + hstep, voffA);
            PG8_WAIT_L(8); PG8_BAR; PG8_WAIT_L(0); PG8_MMA(0, 0, At, B0); PG8_BAR; PG8_SCHED;
            PG8_LDB(B1, 1, 1); PG8_STAGE(PG8_SB(1, 0), b3, voffB);
            PG8_BAR; PG8_WAIT_L(0); PG8_MMA(0, 1, At, B1); PG8_BAR;
            PG8_LDA(At, 1, 1); PG8_STAGE(PG8_SA(1, 0), a3, voffA);
            PG8_BAR; PG8_WAIT_L(0); PG8_MMA(1, 0, At, B0); PG8_BAR; PG8_SCHED;
            PG8_STAGE(PG8_SB(1, 1), b3 + hstep, voffB);
            PG8_WAIT_V(6); PG8_BAR; PG8_MMA(1, 1, At, B1); PG8_BAR;
            }
        }
        if constexpr (ALIGN_EPI) { if (wr == 0) PG8_BAR; }
        if constexpr (!Epi::AFTER_DRAIN) { E(acc, cur, wr, wc, fr, fq); S.done(cur); }
        if (!has_next) break;
#pragma unroll
        for (int a = 0; a < 2; ++a)
#pragma unroll
            for (int b = 0; b < 2; ++b)
#pragma unroll
                for (int m = 0; m < 4; ++m)
#pragma unroll
                    for (int n = 0; n < 2; ++n) acc[a][b][m][n] = (f32x4){0.f, 0.f, 0.f, 0.f};
        cur = nxt; cA = nA; cB = nB; ++ui;
        if constexpr (ALIGN_EPI) { if (wr == 1) PG8_BAR; }
    }
    PG8_WAIT_V(0);
    if constexpr (!ALIGN_EPI) { if (wr == 0) PG8_BAR; }
    PG8_BAR;
    if constexpr (Epi::AFTER_DRAIN) { E.fused(acc, cur, wr, wc, fr, fq, lds, wid, lane); S.done(cur); }
#undef PG8_SA
#undef PG8_SB
#undef PG8_STAGE
#undef PG8_LDA
#undef PG8_LDB
#undef PG8_MMA
#undef PG8_WAIT_V
#undef PG8_WAIT_L
#undef PG8_BAR
#undef PG8_SCHED
}
}
using pg8::bf16_t; using pg8::f32x4; using pg8::u32x4;
#define LAS __attribute__((address_space(3)))

constexpr int D = 1024, NBATCH = 16, SEQ = 2048, CTXL = 256;
constexpr int TL = NBATCH * SEQ;
constexpr int TC = NBATCH * CTXL;
constexpr int TALL = TL + TC;
constexpr int PROJ = 5632;
constexpr int NEXP = 32, DEXP = 512;
constexpr int MOE_ROWS = 288 * 256;
constexpr float EPS = 1e-6f;
constexpr int NWAVES = 8, NTHREADS = 512;

constexpr size_t MiB = 1u << 20;
constexpr size_t WS_CTL = 0;
constexpr size_t CTL_ZERO_BYTES = 256 * 1024;
constexpr size_t WS_MOD = 1 * MiB;
constexpr size_t WS_TOK = 2 * MiB;
constexpr size_t WS_RWT = 3 * MiB;
constexpr size_t WS_WIN = 13 * MiB;
constexpr size_t WS_WA = 24 * MiB;
constexpr size_t WS_WL = 25 * MiB;
constexpr size_t WS_WO = 27 * MiB;
constexpr size_t WS_LW = 29 * MiB;
constexpr size_t WS_W13 = 30 * MiB;
constexpr size_t WS_W2 = 94 * MiB;
constexpr size_t WS_K = 126 * MiB;
constexpr size_t WS_V = 162 * MiB;
constexpr size_t WS_LX = 198 * MiB;
constexpr size_t WS_XB = WS_K;
constexpr size_t WS_Q = 270 * MiB;
constexpr size_t WS_LG = 302 * MiB;
constexpr size_t WS_H2 = WS_Q;
constexpr size_t WS_X1B = WS_LG;
constexpr size_t WS_GA = 366 * MiB;
constexpr size_t WS_GB = 398 * MiB;
constexpr size_t WS_Y = 430 * MiB;
constexpr size_t WS_YB = WS_GA;
constexpr size_t WS_END = 510 * MiB;
constexpr int CW_COUNT = 0, CW_CURSOR = 64, CW_NBLK = 128, CW_BLKE = 192;
constexpr int CW_BCNT = 16384;
constexpr int CW_BAR = 1024;

constexpr int RING_BYTES = 131072;
constexpr int MISC_OFF = 147456;
constexpr int LDS_BYTES = 163840;

__device__ __forceinline__ unsigned f2bf(float f) { unsigned u = __float_as_uint(f); return (u + 0x7fffu + ((u >> 16) & 1u)) >> 16; }
__device__ __forceinline__ float bf2f(unsigned h) { return __uint_as_float(h << 16); }
typedef __bf16 bf16x2_t __attribute__((ext_vector_type(2)));
__device__ __forceinline__ unsigned pk2(float lo, float hi) { const f32x2 v = {lo, hi}; const bf16x2_t b = __builtin_convertvector(v, bf16x2_t); return __builtin_bit_cast(unsigned, b); }
__device__ __forceinline__ float bflo(unsigned w) { return __uint_as_float(w << 16); }
__device__ __forceinline__ float bfhi(unsigned w) { return __uint_as_float(w & 0xffff0000u); }
__device__ __forceinline__ void unpack8(u32x4 w, float (&v)[8]) { v[0] = bflo(w.x); v[1] = bfhi(w.x); v[2] = bflo(w.y); v[3] = bfhi(w.y); v[4] = bflo(w.z); v[5] = bfhi(w.z); v[6] = bflo(w.w); v[7] = bfhi(w.w); }
__device__ __forceinline__ u32x4 pack8(const float (&v)[8]) { u32x4 w; w.x = pk2(v[0], v[1]); w.y = pk2(v[2], v[3]); w.z = pk2(v[4], v[5]); w.w = pk2(v[6], v[7]); return w; }
__device__ __forceinline__ unsigned q8(float v) { return (unsigned)(v * 255.0f + 0.5f); }
__device__ __forceinline__ u32x2 packq8(const float (&v)[8]) { u32x2 w; w.x = q8(v[0]) | (q8(v[1]) << 8) | (q8(v[2]) << 16) | (q8(v[3]) << 24); w.y = q8(v[4]) | (q8(v[5]) << 8) | (q8(v[6]) << 16) | (q8(v[7]) << 24); return w; }
__device__ __forceinline__ void unpackq8(u32x2 w, float (&v)[8]) { const float s = 1.0f / 255.0f;
    v[0] = (float)(w.x & 255u) * s; v[1] = (float)((w.x >> 8) & 255u) * s; v[2] = (float)((w.x >> 16) & 255u) * s; v[3] = (float)(w.x >> 24) * s;
    v[4] = (float)(w.y & 255u) * s; v[5] = (float)((w.y >> 8) & 255u) * s; v[6] = (float)((w.y >> 16) & 255u) * s; v[7] = (float)(w.y >> 24) * s; }
__device__ __forceinline__ float fast_exp(float x) { return __builtin_amdgcn_exp2f(x * 1.4426950408889634f); }
__device__ __forceinline__ float sigmoid_fast(float x) { return __builtin_amdgcn_rcpf(1.0f + fast_exp(-x)); }
__device__ __forceinline__ float silu_fast(float x) { return x * sigmoid_fast(x); }
__device__ __forceinline__ float gelu_tanh_fast(float x) { const float u2 = 1.5957691216057308f * (x + 0.044715f * x * x * x); return x * sigmoid_fast(u2); }
__device__ __forceinline__ float sigmoidf_(float x) { return 1.0f / (1.0f + expf(-x)); }
__device__ __forceinline__ float siluf_(float x) { return x / (1.0f + expf(-x)); }
__device__ __forceinline__ float wave_sum(float v) {
#pragma unroll
    for (int o = 1; o < 64; o <<= 1) v += __shfl_xor(v, o);
    return v;
}

template <int CTRL> __device__ __forceinline__ float dpp_f(float v) { return __int_as_float(__builtin_amdgcn_update_dpp(0, __float_as_int(v), CTRL, 0xF, 0xF, true)); }
__device__ __forceinline__ float row16_sum(float v) { v += dpp_f<0xB1>(v); v += dpp_f<0x4E>(v); v += dpp_f<0x141>(v); v += dpp_f<0x140>(v); return v; }
__device__ __forceinline__ float comb32(float a, float b) { const auto r = __builtin_amdgcn_permlane32_swap(__float_as_uint(a), __float_as_uint(b), false, false); return __uint_as_float(r[0]) + __uint_as_float(r[1]); }
__device__ __forceinline__ float comb16(float a, float b) { const auto r = __builtin_amdgcn_permlane16_swap(__float_as_uint(a), __float_as_uint(b), false, false); return __uint_as_float(r[0]) + __uint_as_float(r[1]); }
__device__ __forceinline__ float lane_f(float v, int l) { return __int_as_float(__builtin_amdgcn_readlane(__float_as_int(v), l)); }
__device__ __forceinline__ float wave_sum_fast(float v) { v = row16_sum(v); return (lane_f(v, 0) + lane_f(v, 16)) + (lane_f(v, 32) + lane_f(v, 48)); }
__device__ __forceinline__ float half_max(float v) { const auto r = __builtin_amdgcn_permlane32_swap(__float_as_uint(v), __float_as_uint(v), false, false); return fmaxf(__uint_as_float(r[0]), __uint_as_float(r[1])); }
__device__ __forceinline__ float half_sum(float v) { const auto r = __builtin_amdgcn_permlane32_swap(__float_as_uint(v), __float_as_uint(v), false, false); return __uint_as_float(r[0]) + __uint_as_float(r[1]); }

struct EpiProj {
    bf16_t *Kb, *Vb, *LXb, *Qb, *LGb; unsigned char *GAq, *GBq; const f32x2* rope;
    __device__ __forceinline__ void operator()(int row, int col, const float (&v)[8]) const {
        float o[8];
        if (col < 512) {
            if (row < TL) { const int t = row & 2047, p = col & 63, pos = (p < 32) ? (t >> 6) : (t & 63), i0 = (p & 31) >> 1;
#pragma unroll
                for (int j = 0; j < 4; ++j) { const f32x2 cs = rope[pos * 16 + i0 + j]; o[2 * j] = v[2 * j] * cs.x - v[2 * j + 1] * cs.y; o[2 * j + 1] = v[2 * j] * cs.y + v[2 * j + 1] * cs.x; }
            } else {
#pragma unroll
                for (int j = 0; j < 8; ++j) o[j] = v[j]; }
            *(u32x4*)(Kb + (size_t)row * 512 + col) = pack8(o);
        } else if (col < 1024) { *(u32x4*)(Vb + (size_t)row * 512 + (col - 512)) = pack8(v);
        } else if (col < 2048) { *(u32x4*)(LXb + (size_t)row * 1024 + (col - 1024)) = pack8(v);
        } else if (col < 2560) { *(u32x4*)(Qb + (size_t)row * 512 + (col - 2048)) = pack8(v);
        } else if (col < 3584) {
#pragma unroll
            for (int j = 0; j < 8; ++j) o[j] = gelu_tanh_fast(v[j]);
            *(u32x4*)(LGb + (size_t)row * 1024 + (col - 2560)) = pack8(o);
        } else {
#pragma unroll
            for (int j = 0; j < 8; ++j) o[j] = sigmoid_fast(v[j]);
            unsigned char* dst = (col < 4608) ? GAq + (size_t)row * 1024 + (col - 3584) : GBq + (size_t)row * 1024 + (col - 4608);
            *(u32x2*)dst = packq8(o);
        }
    }
};
struct EpiUpAttn {
    const unsigned char* GA; bf16_t* OUT;
    struct P { u32x2 g; };
    __device__ __forceinline__ void load(int row, int col, P& p) const { p.g = *(const u32x2*)(GA + (size_t)row * 1024 + col); }
    __device__ __forceinline__ void apply(int row, int col, const float (&v)[8], const P& p) const {
        float g[8], o[8]; unpackq8(p.g, g);
#pragma unroll
        for (int j = 0; j < 8; ++j) o[j] = g[j] * v[j];
        *(u32x4*)(OUT + (size_t)row * 1024 + col) = pack8(o);
    }
};
struct EpiUpLru {
    const bf16_t* Y; const unsigned char* GB; bf16_t* OUT;
    struct P { u32x2 g; u32x4 y; };
    __device__ __forceinline__ void load(int row, int col, P& p) const { p.g = *(const u32x2*)(GB + (size_t)row * 1024 + col); p.y = *(const u32x4*)(Y + (size_t)row * 1024 + col); }
    __device__ __forceinline__ void apply(int row, int col, const float (&v)[8], const P& p) const {
        float g[8], y[8], o[8]; unpackq8(p.g, g); unpack8(p.y, y);
#pragma unroll
        for (int j = 0; j < 8; ++j) o[j] = y[j] + g[j] * v[j];
        *(u32x4*)(OUT + (size_t)row * 1024 + col) = pack8(o);
    }
};
struct EpiOut {
    const float* x; const float* mod; bf16_t* x1;
    struct P { f32x4 x0, x1v, g0, g1; };
    __device__ __forceinline__ void load(int row, int col, P& p) const { const float* ga1 = mod + (row >> 11) * 6144 + 2048 + col; const float* xr = x + (size_t)row * D + col;
        p.x0 = *(const f32x4*)xr; p.x1v = *(const f32x4*)(xr + 4); p.g0 = *(const f32x4*)ga1; p.g1 = *(const f32x4*)(ga1 + 4); }
    __device__ __forceinline__ void apply(int row, int col, const float (&v)[8], const P& p) const {
        const float o[8] = {p.x0.x + p.g0.x * v[0], p.x0.y + p.g0.y * v[1], p.x0.z + p.g0.z * v[2], p.x0.w + p.g0.w * v[3], p.x1v.x + p.g1.x * v[4], p.x1v.y + p.g1.y * v[5], p.x1v.z + p.g1.z * v[6], p.x1v.w + p.g1.w * v[7]};
        *(u32x4*)(x1 + (size_t)row * D + col) = pack8(o);
    }
};
struct EpiMoe1 {
    bf16_t* HM;
    __device__ __forceinline__ void operator()(int row, int col, const float (&v)[8]) const {
        u32x2 w; w.x = pk2(silu_fast(v[0]) * v[1], silu_fast(v[2]) * v[3]); w.y = pk2(silu_fast(v[4]) * v[5], silu_fast(v[6]) * v[7]);
        *(u32x2*)(HM + (size_t)row * DEXP + (col >> 1)) = w;
    }
};
struct EpiMoe2 {
    bf16_t* YB;
    __device__ __forceinline__ void operator()(int row, int col, const float (&v)[8]) const { *(u32x4*)(YB + (size_t)row * D + col) = pack8(v); }
};
template <class F> struct EpiF {
    static constexpr bool PERM = true, AFTER_DRAIN = false; F f;
    __device__ __forceinline__ void operator()(const f32x4 (&acc)[2][2][4][2], const pg8::Unit& u, int wr, int wc, int fr, int fq) const {
#pragma unroll
        for (int ai = 0; ai < 2; ++ai)
#pragma unroll
            for (int m = 0; m < 4; ++m) { const int row = u.pm * 256 + ai * 128 + wr * 64 + m * 16 + fr;
#pragma unroll
                for (int bj = 0; bj < 2; ++bj) { const int col = u.pn * 256 + bj * 128 + wc * 32 + 8 * fq; const f32x4 a = acc[ai][bj][m][0], b = acc[ai][bj][m][1];
                    const float v[8] = {a[0], a[1], a[2], a[3], b[0], b[1], b[2], b[3]}; f(row, col, v); } }
    }
};
template <class F> struct EpiF2 {
    static constexpr bool PERM = true, AFTER_DRAIN = false; F f;
    __device__ __forceinline__ void operator()(const f32x4 (&acc)[2][2][4][2], const pg8::Unit& u, int wr, int wc, int fr, int fq) const {
#pragma unroll
        for (int ai = 0; ai < 2; ++ai)
#pragma unroll
            for (int mp = 0; mp < 2; ++mp) {
                typename F::P pre[2][2];
#pragma unroll
                for (int mm = 0; mm < 2; ++mm)
#pragma unroll
                    for (int bj = 0; bj < 2; ++bj) f.load(u.pm * 256 + ai * 128 + wr * 64 + (2 * mp + mm) * 16 + fr, u.pn * 256 + bj * 128 + wc * 32 + 8 * fq, pre[mm][bj]);
#pragma unroll
                for (int mm = 0; mm < 2; ++mm)
#pragma unroll
                    for (int bj = 0; bj < 2; ++bj) { const int m = 2 * mp + mm; const f32x4 a = acc[ai][bj][m][0], b = acc[ai][bj][m][1];
                        const float v[8] = {a[0], a[1], a[2], a[3], b[0], b[1], b[2], b[3]};
                        f.apply(u.pm * 256 + ai * 128 + wr * 64 + m * 16 + fr, u.pn * 256 + bj * 128 + wc * 32 + 8 * fq, v, pre[mm][bj]); }
                asm volatile("" ::: "memory");
            }
    }
};

struct ProjOrder {
    pg8::StaticOrder so; int G, c;
    __device__ __forceinline__ void init(int G_, int c_) { so.init(TL, PROJ, G_, c_); G = G_; c = c_; }
    __device__ __forceinline__ bool next(int i, pg8::Unit& u) const {
        const int L = i * G + c;
        if (L < so.nwg) return so.next(i, u);
        const int j = L - so.nwg; if (j >= 128) return false;
        u.pm = 128 + (j >> 3); u.pn = j & 7; u.bofs = 0; return true;
    }
    __device__ __forceinline__ void a_ready(const pg8::Unit&) const {}
    __device__ __forceinline__ void done(const pg8::Unit&) const {}
};
struct MoeOrder {
    const unsigned* ctl; int G, vcu, nunits; size_t estride;
    __device__ __forceinline__ void init(const unsigned* ctl_, int G_, int bx, size_t es) { ctl = ctl_; G = G_; vcu = (G_ % 8 == 0) ? (bx % 8) * (G_ / 8) + bx / 8 : bx; nunits = (int)ctl_[CW_NBLK] * 4; estride = es; }
    __device__ __forceinline__ bool next(int i, pg8::Unit& u) const {
        const int L = i * G + vcu; if (L >= nunits) return false;
        u.pm = L >> 2; u.pn = L & 3; u.bofs = (size_t)ctl[CW_BLKE + u.pm] * estride; return true;
    }
    __device__ __forceinline__ void a_ready(const pg8::Unit&) const {}
    __device__ __forceinline__ void done(const pg8::Unit&) const {}
};

#define XB_TMO      128
#define XB_XCNT(j)  (256  + 64 * (j))
#define XB_XSUB(j)  (1280 + 64 * (j))
#define XB_XGEN(j)  (2304 + 64 * (j))
#define XB_TOP      3328
#define XB_TOPGEN   3392
#define XCD_BAR_WORDS 3456
#define XB_SPIN_CAP (1u << 18)

__device__ __forceinline__ unsigned xb_ld(unsigned* p)              { return __hip_atomic_load(p, __ATOMIC_RELAXED, __HIP_MEMORY_SCOPE_AGENT); }
__device__ __forceinline__ unsigned xb_add(unsigned* p, unsigned v) { return __hip_atomic_fetch_add(p, v, __ATOMIC_RELAXED, __HIP_MEMORY_SCOPE_AGENT); }
__device__ __forceinline__ unsigned xb_xcc_id() { return (unsigned)__builtin_amdgcn_s_getreg((3 << 11) | 20) & 0xFu; }
#define XB_SPIN(cond, bar) do { unsigned _sp = 0; while (cond) { __builtin_amdgcn_s_sleep(1); \
    if ((++_sp & 255u) == 0u) { if (xb_ld(&(bar)[XB_TMO])) break; if (_sp > XB_SPIN_CAP) { atomicAdd(&(bar)[XB_TMO], 1u); break; } } } } while (0)

struct XcdBarrier {
    unsigned* bar; unsigned x;
    volatile LAS unsigned* st;
};

__device__ __forceinline__ XcdBarrier xcd_barrier_post(unsigned* bar, volatile LAS unsigned* st, bool leader) {
    XcdBarrier b; b.bar = bar; b.x = xb_xcc_id(); b.st = st;
    if (leader) (void)xb_add(&bar[XB_XCNT(b.x)], 1u);
    return b;
}
__device__ __forceinline__ void xcd_barrier_complete(unsigned* bar, unsigned x, unsigned& nloc, unsigned& nx) {
    const unsigned G = gridDim.x * gridDim.y * gridDim.z;
    unsigned sum, cnt, mine, sp = 0u;
    for (;;) {
        sum = 0u; cnt = 0u; mine = 0u;
#pragma unroll
        for (unsigned j = 0; j < 16; ++j) { const unsigned c = xb_ld(&bar[XB_XCNT(j)]); sum += c; cnt += (c > 0u) ? 1u : 0u; mine = (j == x) ? c : mine; }
        if (sum == G) break;
        __builtin_amdgcn_s_sleep(1);
        if ((++sp & 255u) == 0u) { if (xb_ld(&bar[XB_TMO])) break; if (sp > XB_SPIN_CAP) { atomicAdd(&bar[XB_TMO], 1u); break; } }
    }
    nloc = mine > 0u ? mine : 1u; nx = cnt > 0u ? cnt : 1u;
}

__device__ __forceinline__ void xcd_barrier(const XcdBarrier& b, int wave) {
    const bool leader_ = wave == 0 && __builtin_amdgcn_mbcnt_hi(~0u, __builtin_amdgcn_mbcnt_lo(~0u, 0u)) == 0u;
    asm volatile("s_waitcnt vmcnt(0)" ::: "memory");
    __syncthreads();
    if (leader_) {
        unsigned* bar = b.bar;
        __builtin_amdgcn_s_waitcnt(0);
        unsigned nloc = b.st[0], nx = b.st[1];
        if (nloc == 0u) { xcd_barrier_complete(bar, b.x, nloc, nx); b.st[0] = nloc; b.st[1] = nx; }
        const unsigned old = xb_add(&bar[XB_XSUB(b.x)], 1u);
        const unsigned gen = old / nloc;
        if (old + 1u == (gen + 1u) * nloc) {
            __builtin_amdgcn_fence(__ATOMIC_RELEASE, "agent");
            asm volatile("s_waitcnt vmcnt(0)" ::: "memory");
            const unsigned og = xb_add(&bar[XB_TOP], 1u);
            const unsigned tg = og / nx;
            if (og + 1u == (tg + 1u) * nx) xb_add(&bar[XB_TOPGEN], 1u);
            else XB_SPIN(xb_ld(&bar[XB_TOPGEN]) == tg, bar);
            __builtin_amdgcn_fence(__ATOMIC_ACQUIRE, "agent");
            xb_add(&bar[XB_XGEN(b.x)], 1u);
            asm volatile("s_waitcnt vmcnt(0)" ::: "memory");
        } else {
            XB_SPIN(xb_ld(&bar[XB_XGEN(b.x)]) == gen, bar);
            __builtin_amdgcn_fence(__ATOMIC_ACQUIRE, "agent");
            asm volatile("s_waitcnt vmcnt(0)" ::: "memory");
        }
    }
    __syncthreads();
}

__device__ __forceinline__ int win_perm(int n) {
    const bool qk = (n < 512) || (n >= 2048 && n < 2560);
    if (!qk) return n;
    const int d = n & 63, base = n - d, half = d >> 5, dd = d & 31, i = dd & 15, comp = dd >> 4;
    return base + half * 32 + 2 * i + comp;
}
template <int K, int N, int MODE, int ROWMUL>
__device__ __forceinline__ void prep_item(const float* W, bf16_t* WT, int rowoff, unsigned dstride, LAS float* scr, int item, int lane, float wscale = 1.0f) {
    constexpr int nblk = N / 32, per = (K / 64) * nblk;
    const int bi = item / per, r = item % per, kb = r / nblk, nb = r % nblk, k0 = 64 * kb, n0 = 32 * nb;
    const float* src = W + (size_t)bi * K * N;
    { float t_[32];
#pragma unroll
      for (int i = 0; i < 32; ++i) t_[i] = __builtin_nontemporal_load(src + (size_t)(k0 + 2 * i + (lane >> 5)) * N + n0 + (lane & 31));
#pragma unroll
      for (int i = 0; i < 32; ++i) scr[(2 * i + (lane >> 5)) * 33 + (lane & 31)] = t_[i]; }
    asm volatile("s_waitcnt lgkmcnt(0)" ::: "memory");
    const int c = lane & 7;
#pragma unroll
    for (int j = 0; j < 4; ++j) { const int n = (lane >> 3) + 8 * j; const LAS float* s = scr + (8 * c) * 33 + n;
        u32x4 o; o.x = pk2(s[0 * 33] * wscale, s[1 * 33] * wscale); o.y = pk2(s[2 * 33] * wscale, s[3 * 33] * wscale); o.z = pk2(s[4 * 33] * wscale, s[5 * 33] * wscale); o.w = pk2(s[6 * 33] * wscale, s[7 * 33] * wscale);
        int ng = n0 + n; if (MODE == 1) ng = win_perm(ng);
        *(u32x4*)(WT + (size_t)bi * dstride + (size_t)(ROWMUL * ng + rowoff) * K + k0 + 8 * c) = o; }
    asm volatile("s_waitcnt lgkmcnt(0)" ::: "memory");
}
__device__ __forceinline__ unsigned char* lds_ptr(LAS unsigned char* ldsl, int i);
__device__ __forceinline__ void p0_prep(unsigned char* ws, LAS unsigned char* ldsl, int gw, int ngw, int lane, int wave) {
    LAS float* scr = (LAS float*)(ldsl + wave * 8448);
#define in_(i) ((const float*)lds_ptr(ldsl, (i)))
    constexpr int I0 = 16 * 176, I1 = 8 * 32, I2 = 16 * 32, I3 = 16 * 32, I4 = 16 * 2 * 4, I5 = I4, I6 = 32 * 16 * 16, I7 = I6, I8 = 32 * 8 * 32;
    constexpr int TOT = I0 + I1 + I2 + I3 + I4 + I5 + I6 + I7 + I8;
    for (int it = gw; it < TOT; it += ngw) {
        int r = it;
        if (r < I0) { prep_item<1024, PROJ, 1, 1>(in_(8), (bf16_t*)(ws + WS_WIN), 0, 0u, scr, r, lane); continue; } r -= I0;
        if (r < I1) { prep_item<512, 1024, 0, 1>(in_(17), (bf16_t*)(ws + WS_WA), 0, 0u, scr, r, lane); continue; } r -= I1;
        if (r < I2) { prep_item<1024, 1024, 0, 1>(in_(18), (bf16_t*)(ws + WS_WL), 0, 0u, scr, r, lane); continue; } r -= I2;
        if (r < I3) { prep_item<1024, 1024, 0, 1>(in_(19), (bf16_t*)(ws + WS_WO), 0, 0u, scr, r, lane); continue; } r -= I3;
        if (r < I4) { prep_item<128, 128, 0, 1>(in_(12), (bf16_t*)(ws + WS_LW), 0, 256u * 128u, scr, r, lane, -1.4426950408889634f); continue; } r -= I4;
        if (r < I5) { prep_item<128, 128, 0, 1>(in_(14), (bf16_t*)(ws + WS_LW), 128, 256u * 128u, scr, r, lane, -1.4426950408889634f); continue; } r -= I5;
        if (r < I6) { prep_item<1024, 512, 0, 2>(in_(24), (bf16_t*)(ws + WS_W13), 0, 1024u * 1024u, scr, r, lane); continue; } r -= I6;
        if (r < I7) { prep_item<1024, 512, 0, 2>(in_(25), (bf16_t*)(ws + WS_W13), 1, 1024u * 1024u, scr, r, lane); continue; } r -= I7;
        prep_item<512, 1024, 0, 1>(in_(26), (bf16_t*)(ws + WS_W2), 0, 1024u * 512u, scr, r, lane);
    }
#undef in_
}
__device__ __forceinline__ void p0_mod(const float* c, const float* c_ctx, const float* w_mod, const float* b_mod, const float* wg, const float* we, f32x4* W4g, const float* lam, float* SPt, float* mod, f32x2* rope, LAS float* lds_f, int tid) {
    LAS float* sc = lds_f;
    LAS float* red = lds_f + 17 * 1024;
    {
        float cv[34];
#pragma unroll
        for (int it = 0; it < 34; ++it) { const int i = tid + it * NTHREADS; cv[it] = (it < 32) ? c[i] : c_ctx[i - 16 * 1024]; }
#pragma unroll
        for (int it = 0; it < 34; ++it) sc[tid + it * NTHREADS] = siluf_(cv[it]);
    }
    for (int idx = blockIdx.x * NTHREADS + tid; idx < 36 * 256; idx += gridDim.x * NTHREADS) { const int cc = idx >> 8, kq = idx & 255; f32x4 w;
        if (cc < 4) { const float* s = wg + (size_t)(4 * kq) * 4 + cc; w.x = s[0]; w.y = s[4]; w.z = s[8]; w.w = s[12]; }
        else { const float* s = we + (size_t)(4 * kq) * 32 + (cc - 4); w.x = s[0]; w.y = s[32]; w.z = s[64]; w.w = s[96]; }
        W4g[idx] = w; }
    if (blockIdx.x >= 1 && blockIdx.x < 5) { const int i = (blockIdx.x - 1) * NTHREADS + tid; const float lm = lam[i]; SPt[i] = (-lm > 20.f) ? -lm : log1pf(expf(-lm)); }
    if (blockIdx.x == 0 || blockIdx.x == 5) for (int i = (blockIdx.x ? NTHREADS : 0) + tid; i < 64 * 16; i += 2 * NTHREADS) { const int pos = i >> 4, f = i & 15; const double inv = exp(-(double)f / 16.0 * log(10000.0)); const double ang = (double)pos * inv;
        rope[i] = (f32x2){(float)cos(ang), (float)sin(ang)}; }
    __syncthreads();
    for (int cb = blockIdx.x; cb < 256; cb += gridDim.x) {
        const int ks = tid / 24, col = tid % 24;
        if (ks < 21) {
            float acc[17];
#pragma unroll
            for (int b = 0; b < 17; ++b) acc[b] = 0.f;
            float w[49];
#pragma unroll
            for (int i = 0; i < 49; ++i) { const int k = ks + 21 * i; w[i] = (k < 1024) ? w_mod[(size_t)k * 6144 + cb * 24 + col] : 0.f; }
#pragma unroll
            for (int i = 0; i < 49; ++i) { const int k = min(ks + 21 * i, 1023);
#pragma unroll
                for (int b = 0; b < 17; ++b) acc[b] += sc[b * 1024 + k] * w[i]; }
#pragma unroll
            for (int b = 0; b < 17; ++b) red[(ks * 17 + b) * 24 + col] = acc[b];
        }
        __syncthreads();
        if (tid < 17 * 24) { const int b = tid / 24, cc = tid % 24; float s = b_mod[cb * 24 + cc];
            for (int q = 0; q < 21; ++q) s += red[(q * 17 + b) * 24 + cc];
            mod[b * 6144 + cb * 24 + cc] = s; }
        __syncthreads();
    }
}

__device__ __forceinline__ void p1_adanorm(const float* x, const float* ctx, const float* gain, const float* mod, bf16_t* H, int gw, int ngw, int lane) {
    f32x4 nA[4], nB[4];
#define AD_SRC(r_) ((r_) < TL ? x + (size_t)(r_) * D : ctx + (size_t)((r_) - TL) * D)
#define AD_LOAD(dst, r_) do { if ((r_) < TALL) { const float* s_ = AD_SRC(r_); _Pragma("unroll") for (int j = 0; j < 4; ++j) dst[j] = __builtin_nontemporal_load((const f32x4*)(s_ + lane * 4 + 256 * j)); } } while (0)
#define AD_ROW(src_, r_) do { const int row_ = (r_); const int mb = row_ < TL ? (row_ >> 11) : 16; const float* shift = mod + mb * 6144; const float* scale = shift + 1024; \
        f32x4 v[4]; float ss = 0.f; \
        _Pragma("unroll") for (int j = 0; j < 4; ++j) { v[j] = src_[j]; ss += v[j].x * v[j].x + v[j].y * v[j].y + v[j].z * v[j].z + v[j].w * v[j].w; } \
        AD_LOAD(src_, row_ + 2 * ngw); \
        const float rstd = rsqrtf(wave_sum_fast(ss) * (1.0f / D) + EPS); \
        _Pragma("unroll") for (int j = 0; j < 4; ++j) { const int k = lane * 4 + 256 * j; const f32x4 g = *(const f32x4*)(gain + k), sh = *(const f32x4*)(shift + k), sc = *(const f32x4*)(scale + k); \
            const f32x4 o = (v[j] * rstd * g) * (1.0f + sc) + sh; \
            u32x2 w; w.x = pk2(o.x, o.y); w.y = pk2(o.z, o.w); *(u32x2*)(H + (size_t)row_ * D + k) = w; } } while (0)
    AD_LOAD(nA, gw); AD_LOAD(nB, gw + ngw);
    for (int row = gw; row < TALL; row += 2 * ngw) { AD_ROW(nA, row); if (row + ngw < TALL) AD_ROW(nB, row + ngw); }
#undef AD_SRC
#undef AD_LOAD
#undef AD_ROW
}

__device__ __forceinline__ void p1_router_tables(const float* gain, const float* mod, const f32x4* W4g, const float* bg, const float* be, float* WT, float* biasb, int gw, int ngw, int lane) {
    for (int it = gw; it < 16 * 48; it += ngw) {
        const int b = it / 48, j = it % 48; const float* shift = mod + b * 6144 + 3072; const float* scale = shift + 1024;
        float part = 0.f;
#pragma unroll
        for (int i = 0; i < 4; ++i) { const int kq = lane + 64 * i; const f32x4 g = *(const f32x4*)(gain + 4 * kq), sc = *(const f32x4*)(scale + 4 * kq), sh = *(const f32x4*)(shift + 4 * kq);
            f32x4 w = (f32x4){0.f, 0.f, 0.f, 0.f}; if (j < 36) w = W4g[j * 256 + kq];
            *(f32x4*)(WT + (size_t)(b * 48 + j) * 1024 + 4 * kq) = g * (1.0f + sc) * w;
            part += sh.x * w.x + sh.y * w.y + sh.z * w.z + sh.w * w.w; }
        part = wave_sum_fast(part);
        if (lane == 0) biasb[b * 48 + j] = part + (j < 4 ? bg[j] : j < 36 ? be[j - 4] : 0.f);
    }
}
constexpr int RT_CHUNK_FLOATS = 48 * 132, RT_LG_OFF = 2 * RT_CHUNK_FLOATS * 4;
__device__ __forceinline__ void p8_route(const bf16_t* x1, const float* WT, const float* biasb, unsigned* ctl, int* tok, LAS unsigned char* lds, int lane, int tid, int wave) {
    LAS unsigned* hist = (LAS unsigned*)(lds + MISC_OFF + 256);
    if (tid < 32) hist[tid] = 0u;
    LAS float* Lg = (LAS float*)(lds + RT_LG_OFF + wave * 3072);
    const int i = lane & 15, kk = lane >> 4;
    for (int blk = blockIdx.x; blk < TL / 128; blk += gridDim.x) {
        const int R0 = 128 * blk + 16 * wave, b = (128 * blk) >> 11;
        const bf16_t* xr = x1 + (size_t)(R0 + i) * D + 4 * kk; const float* wtb = WT + (size_t)b * 48 * 1024;
        f32x4 a0 = (f32x4){0.f, 0.f, 0.f, 0.f}, a1 = a0, a2 = a0; float ss = 0.f;
        f32x4 stg[3];
#define RT_LOAD(c_) do { _Pragma("unroll") for (int q = 0; q < 3; ++q) { const int id = tid + NTHREADS * q, col = id >> 5, k4 = id & 31; stg[q] = *(const f32x4*)(wtb + (size_t)col * 1024 + 128 * (c_) + 4 * k4); } } while (0)
#define RT_STORE(buf_) do { _Pragma("unroll") for (int q = 0; q < 3; ++q) { const int id = tid + NTHREADS * q, col = id >> 5, k4 = id & 31; *(LAS f32x4*)((LAS float*)lds + (buf_) * RT_CHUNK_FLOATS + col * 132 + 4 * k4) = stg[q]; } } while (0)
        __syncthreads();
        RT_LOAD(0); RT_STORE(0);
        u32x2 cx[8];
#pragma unroll
        for (int u = 0; u < 8; ++u) cx[u] = *(const u32x2*)(xr + 16 * u);
        __syncthreads();
#pragma unroll 1
        for (int c = 0; c < 8; ++c) {
            if (c < 7) RT_LOAD(c + 1);
            u32x2 nx[8];
            if (c < 7) {
#pragma unroll
                for (int u = 0; u < 8; ++u) nx[u] = *(const u32x2*)(xr + 128 * (c + 1) + 16 * u); }
            const LAS float* wl = (const LAS float*)lds + (c & 1) * RT_CHUNK_FLOATS + i * 132 + 4 * kk;
#pragma unroll
            for (int u = 0; u < 8; ++u) { const f32x4 xa = (f32x4){bflo(cx[u].x), bfhi(cx[u].x), bflo(cx[u].y), bfhi(cx[u].y)}, b0 = *(const LAS f32x4*)(wl + 16 * u), b1 = *(const LAS f32x4*)(wl + 16 * 132 + 16 * u), b2 = *(const LAS f32x4*)(wl + 32 * 132 + 16 * u);
                ss += xa.x * xa.x + xa.y * xa.y + xa.z * xa.z + xa.w * xa.w;
                a0 = __builtin_amdgcn_mfma_f32_16x16x4f32(xa.x, b0.x, a0, 0, 0, 0); a1 = __builtin_amdgcn_mfma_f32_16x16x4f32(xa.x, b1.x, a1, 0, 0, 0); a2 = __builtin_amdgcn_mfma_f32_16x16x4f32(xa.x, b2.x, a2, 0, 0, 0);
                a0 = __builtin_amdgcn_mfma_f32_16x16x4f32(xa.y, b0.y, a0, 0, 0, 0); a1 = __builtin_amdgcn_mfma_f32_16x16x4f32(xa.y, b1.y, a1, 0, 0, 0); a2 = __builtin_amdgcn_mfma_f32_16x16x4f32(xa.y, b2.y, a2, 0, 0, 0);
                a0 = __builtin_amdgcn_mfma_f32_16x16x4f32(xa.z, b0.z, a0, 0, 0, 0); a1 = __builtin_amdgcn_mfma_f32_16x16x4f32(xa.z, b1.z, a1, 0, 0, 0); a2 = __builtin_amdgcn_mfma_f32_16x16x4f32(xa.z, b2.z, a2, 0, 0, 0);
                a0 = __builtin_amdgcn_mfma_f32_16x16x4f32(xa.w, b0.w, a0, 0, 0, 0); a1 = __builtin_amdgcn_mfma_f32_16x16x4f32(xa.w, b1.w, a1, 0, 0, 0); a2 = __builtin_amdgcn_mfma_f32_16x16x4f32(xa.w, b2.w, a2, 0, 0, 0); }
            if (c < 7) { RT_STORE((c + 1) & 1);
#pragma unroll
                for (int u = 0; u < 8; ++u) cx[u] = nx[u]; }
            __syncthreads();
        }
#undef RT_LOAD
#undef RT_STORE
        ss = half_sum(ss); { const auto r = __builtin_amdgcn_permlane16_swap(__float_as_uint(ss), __float_as_uint(ss), false, false); ss = __uint_as_float(r[0]) + __uint_as_float(r[1]); }
        const float rstd = rsqrtf(ss * (1.0f / D) + EPS);
#pragma unroll
        for (int rg = 0; rg < 4; ++rg) { Lg[(4 * kk + rg) * 48 + i] = a0[rg]; Lg[(4 * kk + rg) * 48 + 16 + i] = a1[rg]; Lg[(4 * kk + rg) * 48 + 32 + i] = a2[rg]; }
        if (lane < 16) {
            const int row = R0 + lane; const float* bb = biasb + b * 48; const LAS float* lr = Lg + lane * 48;
            float acc[36];
#pragma unroll
            for (int c4 = 0; c4 < 9; ++c4) { const f32x4 v = *(const LAS f32x4*)(lr + 4 * c4), bv = *(const f32x4*)(bb + 4 * c4);
                acc[4 * c4] = rstd * v.x + bv.x; acc[4 * c4 + 1] = rstd * v.y + bv.y; acc[4 * c4 + 2] = rstd * v.z + bv.z; acc[4 * c4 + 3] = rstd * v.w + bv.w; }
            int gi = 0; float gm = -1e30f;
#pragma unroll
            for (int g = 0; g < 4; ++g) if (acc[g] > gm) { gm = acc[g]; gi = g; }
            float gs = 0.f;
#pragma unroll
            for (int g = 0; g < 4; ++g) gs += expf(acc[g] - gm);
            const float p_top = 1.0f / gs;
            float le[8];
#pragma unroll
            for (int j = 0; j < 8; ++j) le[j] = gi == 0 ? acc[4 + j] : gi == 1 ? acc[12 + j] : gi == 2 ? acc[20 + j] : acc[28 + j];
            int e1 = 0; float v1 = -1e30f;
#pragma unroll
            for (int j = 0; j < 8; ++j) if (le[j] > v1) { v1 = le[j]; e1 = j; }
            int e2 = 0; float v2 = -1e30f;
#pragma unroll
            for (int j = 0; j < 8; ++j) if (j != e1 && le[j] > v2) { v2 = le[j]; e2 = j; }
            const float p2 = expf(v2 - v1), inv = 1.0f / (1.0f + p2);
            const int eid0 = gi * 8 + e1, eid1 = gi * 8 + e2;
            const int s0 = (int)__hip_atomic_fetch_add(&hist[eid0], 1u, __ATOMIC_RELAXED, __HIP_MEMORY_SCOPE_WORKGROUP), s1 = (int)__hip_atomic_fetch_add(&hist[eid1], 1u, __ATOMIC_RELAXED, __HIP_MEMORY_SCOPE_WORKGROUP);
            int* tr = tok + row * 8; tr[0] = eid0; tr[1] = eid1; ((float*)tr)[2] = p_top * inv; ((float*)tr)[3] = p_top * p2 * inv; tr[4] = s0; tr[5] = s1; ((float*)tr)[6] = rstd;
        }
    }
    __syncthreads();
    if (tid < 32) ctl[CW_BCNT + blockIdx.x * 32 + tid] = hist[tid];
}

__device__ __forceinline__ void p9_scatter(const bf16_t* x1, const float* gain, const float* mod, unsigned* ctl, int* tok, bf16_t* XB, LAS unsigned* sl, int gw, int ngw, int lane, int tid) {
    const int G = gridDim.x;
    { const int e = tid & 31, part = tid >> 5; unsigned sall = 0, sbef = 0;
      for (int bb = part; bb < G; bb += 16) { const unsigned v = ctl[CW_BCNT + bb * 32 + e]; sall += v; if (bb < (int)blockIdx.x) sbef += v; }
      sl[part * 32 + e] = sall; sl[512 + part * 32 + e] = sbef; }
    __syncthreads();
    if (tid < 64) {
        unsigned cnt = 0, bef = 0;
        if (lane < 32) for (int q = 0; q < 16; ++q) { cnt += sl[q * 32 + lane]; bef += sl[512 + q * 32 + lane]; }
        const unsigned padded = (cnt + 255u) & ~255u; unsigned incl = padded;
#pragma unroll
        for (int o = 1; o < 32; o <<= 1) { const unsigned t = __shfl_up(incl, o); if ((lane & 31) >= o) incl += t; }
        const unsigned excl = incl - padded;
        if (lane < 32) sl[1024 + lane] = excl + bef;
        if (blockIdx.x == 0) {
            const unsigned total = __shfl(incl, 31);
            if (lane == 0) ctl[CW_NBLK] = total >> 8;
            if (lane < 32) for (unsigned i = excl >> 8; i < (incl >> 8); ++i) ctl[CW_BLKE + i] = (unsigned)lane;
        }
    }
    __syncthreads();
    for (int blk = blockIdx.x; blk < TL / 128; blk += gridDim.x) {
        const int R0 = 128 * blk + 16 * (tid >> 6); const float* shift = mod + (R0 >> 11) * 6144 + 3072; const float* scale = shift + 1024;
        f32x4 G[4], S[4];
#pragma unroll
        for (int j = 0; j < 4; ++j) { const int k = lane * 4 + 256 * j; G[j] = *(const f32x4*)(gain + k) * (1.0f + *(const f32x4*)(scale + k)); S[j] = *(const f32x4*)(shift + k); }
#pragma unroll 4
        for (int rr = 0; rr < 16; ++rr) { const int row = R0 + rr; const int* tr = tok + row * 8;
            const int e0 = tr[0], e1 = tr[1]; const float rstd = ((const float*)tr)[6];
            const unsigned d0 = sl[1024 + e0] + (unsigned)tr[4], d1 = sl[1024 + e1] + (unsigned)tr[5];
            u32x2 w[4];
#pragma unroll
            for (int j = 0; j < 4; ++j) { const u32x2 xb = *(const u32x2*)(x1 + (size_t)row * D + lane * 4 + 256 * j); const f32x4 o = (f32x4){bflo(xb.x), bfhi(xb.x), bflo(xb.y), bfhi(xb.y)} * rstd * G[j] + S[j]; w[j].x = pk2(o.x, o.y); w[j].y = pk2(o.z, o.w); }
#pragma unroll
            for (int j = 0; j < 4; ++j) { *(u32x2*)(XB + (size_t)d0 * D + lane * 4 + 256 * j) = w[j]; *(u32x2*)(XB + (size_t)d1 * D + lane * 4 + 256 * j) = w[j]; }
            if (lane == 0) { tok[row * 8 + 4] = (int)d0; tok[row * 8 + 5] = (int)d1; } }
    }
}

__device__ __forceinline__ void p12_final(const bf16_t* x1, float* outp, const float* mod, const int* tok, const bf16_t* YB, const float* gfin, int gw, int ngw, int lane) {
    u32x2 nxv[4]; u32x2 nya[4], nyb[4]; float nw0 = 0.f, nw1 = 0.f; int t2d0 = 0, t2d1 = 0; float t2w0 = 0.f, t2w1 = 0.f;
    if (gw < TL) { const int d0 = tok[gw * 8 + 4], d1 = tok[gw * 8 + 5]; nw0 = ((const float*)tok)[gw * 8 + 2]; nw1 = ((const float*)tok)[gw * 8 + 3];
#pragma unroll
        for (int j = 0; j < 4; ++j) { const int k = lane * 4 + 256 * j; nxv[j] = *(const u32x2*)(x1 + (size_t)gw * D + k); nya[j] = *(const u32x2*)(YB + (size_t)d0 * D + k); nyb[j] = *(const u32x2*)(YB + (size_t)d1 * D + k); } }
    if (gw + ngw < TL) { const int r2 = gw + ngw; t2d0 = tok[r2 * 8 + 4]; t2d1 = tok[r2 * 8 + 5]; t2w0 = ((const float*)tok)[r2 * 8 + 2]; t2w1 = ((const float*)tok)[r2 * 8 + 3]; }
    for (int row = gw; row < TL; row += ngw) {
        const float* ga2 = mod + (row >> 11) * 6144 + 5120; float* dst = outp + (size_t)row * D;
        const float w0 = nw0, w1 = nw1;
        f32x4 xv[4]; u32x2 ya[4], yb[4];
#pragma unroll
        for (int j = 0; j < 4; ++j) { xv[j] = (f32x4){bflo(nxv[j].x), bfhi(nxv[j].x), bflo(nxv[j].y), bfhi(nxv[j].y)}; ya[j] = nya[j]; yb[j] = nyb[j]; }
        const int nrow = row + ngw;
        if (nrow < TL) { nw0 = t2w0; nw1 = t2w1;
#pragma unroll
            for (int j = 0; j < 4; ++j) { const int k = lane * 4 + 256 * j; nxv[j] = *(const u32x2*)(x1 + (size_t)nrow * D + k); nya[j] = *(const u32x2*)(YB + (size_t)t2d0 * D + k); nyb[j] = *(const u32x2*)(YB + (size_t)t2d1 * D + k); }
            const int r2 = nrow + ngw;
            if (r2 < TL) { t2d0 = tok[r2 * 8 + 4]; t2d1 = tok[r2 * 8 + 5]; t2w0 = ((const float*)tok)[r2 * 8 + 2]; t2w1 = ((const float*)tok)[r2 * 8 + 3]; } }
        f32x4 v[4]; float ss = 0.f;
#pragma unroll
        for (int j = 0; j < 4; ++j) { const int k = lane * 4 + 256 * j; const f32x4 g = *(const f32x4*)(ga2 + k); const u32x2 a = ya[j], bq = yb[j];
            f32x4 y; y.x = w0 * bflo(a.x) + w1 * bflo(bq.x); y.y = w0 * bfhi(a.x) + w1 * bfhi(bq.x); y.z = w0 * bflo(a.y) + w1 * bflo(bq.y); y.w = w0 * bfhi(a.y) + w1 * bfhi(bq.y);
            v[j] = xv[j] + g * y; ss += v[j].x * v[j].x + v[j].y * v[j].y + v[j].z * v[j].z + v[j].w * v[j].w; }
        const float rstd = rsqrtf(wave_sum_fast(ss) * (1.0f / D) + EPS);
#pragma unroll
        for (int j = 0; j < 4; ++j) { const int k = lane * 4 + 256 * j; const f32x4 g = *(const f32x4*)(gfin + k); *(f32x4*)(dst + k) = v[j] * rstd * g; }
    }
}

typedef float f32x16 __attribute__((ext_vector_type(16)));
typedef short v4i16_t __attribute__((ext_vector_type(4)));
using pg8::bf16x8;
constexpr int ATT_CK_OFF = 2048, ATT_CV_OFF = ATT_CK_OFF + 32768, ATT_RING_OFF = ATT_CV_OFF + 32768, ATT_SK_OFF = ATT_RING_OFF + 32768, ATT_SV_OFF = ATT_SK_OFF + 11 * 2048;
static_assert(ATT_SV_OFF + 11 * 2048 <= MISC_OFF, "attention LDS map");
__device__ __forceinline__ void p3_attn(const bf16_t* Qb, bf16_t* Ob, const bf16_t* Kb, const bf16_t* Vb, const float* rpb, const f32x2* rope, LAS unsigned char* lds, int wave, int lane) {
    constexpr float L2E = 1.4426950408889634f, SC = 0.125f * L2E;
    const int tid = wave * 64 + lane, ql = lane & 31, hl = lane >> 5, skey = tid >> 3, sch = tid & 7;
    LAS float* rpbL = (LAS float*)lds;
    const int vq = (lane & 15) >> 2, vcol = (16 * ((lane >> 4) & 1) + 4 * (lane & 3)) * 2;
    const int g = wave & 1, sside = skey >= 24 && skey < 40;
    for (int it = blockIdx.x; it < NBATCH * 8 * 2; it += gridDim.x) {
        const int rh = it & 1, h = (it >> 1) & 7, b = it >> 4;
        __syncthreads();
        if (tid < 15 * 32) { const int c = tid & 31, dr = tid >> 5; rpbL[tid] = c < 31 ? rpb[(h * 15 + dr) * 31 + c] * L2E : -1e30f; }
#pragma unroll
        for (int i = 0; i < 4; ++i) { const int key = skey + 64 * i; const size_t row = (size_t)(TL + b * CTXL + key) * 512 + h * 64 + 8 * sch;
            *(LAS u32x4*)(lds + ATT_CK_OFF + key * 128 + ((sch ^ (key & 7)) * 16)) = *(const u32x4*)(Kb + row);
            *(LAS u32x4*)(lds + ATT_CV_OFF + key * 128 + sch * 16) = *(const u32x4*)(Vb + row); }
#pragma unroll 1
        for (int pass = 0; pass < 4; ++pass) {
            const int R0 = 16 * rh + 4 * pass, r = R0 + (wave >> 1);
            const int cq = 32 * g + ql, rs = min(max(r - 4, 0), 24), cstart = min(max(cq - 8, 0), 48);
            const int kmin = min(max(R0 - 4, 0), 24), kmax = min(max(R0 - 1, 0), 24) + 7, nsteps = kmax - kmin + 1;
            const bf16_t* qp = Qb + (size_t)(b * SEQ + r * 64 + cq) * 512 + h * 64; bf16_t* op = Ob + (size_t)(b * SEQ + r * 64 + cq) * 512 + h * 64;
#define ATT_PUT(slot_, krel_, kv_, vv_) do { *(LAS u32x4*)(lds + (slot_) + skey * 128 + ((sch ^ (skey & 7)) * 16)) = (kv_); *(LAS u32x4*)(lds + (slot_) + 8192 + skey * 128 + sch * 16) = (vv_); \
                if (sside) { *(LAS u32x4*)(lds + ATT_SK_OFF + ((krel_) * 16 + skey - 24) * 128 + ((sch ^ (skey & 7)) * 16)) = (kv_); *(LAS u32x4*)(lds + ATT_SV_OFF + ((krel_) * 16 + skey - 24) * 128 + sch * 16) = (vv_); } } while (0)
            { const size_t row = (size_t)(b * SEQ + kmin * 64 + skey) * 512 + h * 64 + 8 * sch; const u32x4 kv = *(const u32x4*)(Kb + row), vv = *(const u32x4*)(Vb + row); ATT_PUT(ATT_RING_OFF, 0, kv, vv); }
            bf16x8 qplain[4], qrot[4];
#pragma unroll
            for (int d0 = 0; d0 < 4; ++d0) { float v[8], o[8], pl[8]; unpack8(*(const u32x4*)(qp + 16 * d0 + 8 * hl), v);
                const int pos = d0 < 2 ? r : cq, i0 = ((16 * d0 + 8 * hl) & 31) >> 1;
#pragma unroll
                for (int j = 0; j < 4; ++j) { const f32x2 cs = rope[pos * 16 + i0 + j]; o[2 * j] = (v[2 * j] * cs.x - v[2 * j + 1] * cs.y) * SC; o[2 * j + 1] = (v[2 * j] * cs.y + v[2 * j + 1] * cs.x) * SC; }
#pragma unroll
                for (int j = 0; j < 8; ++j) pl[j] = v[j] * SC;
                qrot[d0] = __builtin_bit_cast(bf16x8, pack8(o)); qplain[d0] = __builtin_bit_cast(bf16x8, pack8(pl)); }
            int dco[16];
#pragma unroll
            for (int i = 0; i < 16; ++i) { const int kc = 32 * g + (i & 3) + 8 * (i >> 2) + 4 * hl; const bool ok = kc >= cstart && kc < cstart + 16; dco[i] = ok ? (kc - cq + 15) * 4 : 31 * 4; }
            f32x16 o0, o1;
#pragma unroll
            for (int i = 0; i < 16; ++i) { o0[i] = 0.f; o1[i] = 0.f; }
            float m = -1e30f, l = 0.f;
#define ATT_TILE(kp_, vb_, vsk_, ve_, qf) do { \
            _Pragma("unroll") for (int d0 = 0; d0 < 4; ++d0) s = __builtin_amdgcn_mfma_f32_32x32x16_bf16(*(const LAS bf16x8*)((kp_) + (((2 * d0 + hl) ^ (ql & 7)) * 16)), qf[d0], s, 0, 0, 0); \
            float mt = fmaxf(fmaxf(s[0], s[1]), s[2]); \
            _Pragma("unroll") for (int i = 3; i < 15; i += 2) mt = fmaxf(fmaxf(mt, s[i]), s[i + 1]); \
            mt = half_max(fmaxf(mt, s[15])); \
            if (__any(mt > m)) { const float mn = fmaxf(m, mt), alpha = __builtin_amdgcn_exp2f(m - mn); m = mn; l *= alpha; \
                _Pragma("unroll") for (int i = 0; i < 16; ++i) { o0[i] *= alpha; o1[i] *= alpha; } } \
            float ps = 0.f; \
            _Pragma("unroll") for (int i = 0; i < 16; ++i) { s[i] = __builtin_amdgcn_exp2f(s[i] - m); ps += s[i]; } \
            l += ps; \
            bf16x8 pb[2]; \
            _Pragma("unroll") for (int sk = 0; sk < 2; ++sk) { u32x4 w; w.x = pk2(s[8 * sk], s[8 * sk + 1]); w.y = pk2(s[8 * sk + 2], s[8 * sk + 3]); w.z = pk2(s[8 * sk + 4], s[8 * sk + 5]); w.w = pk2(s[8 * sk + 6], s[8 * sk + 7]); \
                pb[sk] = __builtin_bit_cast(bf16x8, w); } \
            _Pragma("unroll") for (int dt = 0; dt < 2; ++dt) _Pragma("unroll") for (int sk = 0; sk < 2; ++sk) { \
                const v4i16_t lo = __builtin_amdgcn_ds_read_tr16_b64_v4i16((LAS v4i16_t*)((vb_) + sk * (vsk_) + dt * 64)); \
                const v4i16_t hi = __builtin_amdgcn_ds_read_tr16_b64_v4i16((LAS v4i16_t*)((vb_) + sk * (vsk_) + (ve_) + dt * 64)); \
                const bf16x8 va = (bf16x8){lo[0], lo[1], lo[2], lo[3], hi[0], hi[1], hi[2], hi[3]}; \
                if (dt == 0) o0 = __builtin_amdgcn_mfma_f32_32x32x16_bf16(va, pb[sk], o0, 0, 0, 0); else o1 = __builtin_amdgcn_mfma_f32_32x32x16_bf16(va, pb[sk], o1, 0, 0, 0); } } while (0)
            __syncthreads();
#pragma unroll 1
            for (int st = 0; st < nsteps; ++st) {
                const int kr = kmin + st, slot = ATT_RING_OFF + (st & 1) * 16384;
                u32x4 nk, nv; const bool more = st + 1 < nsteps;
                if (more) { const size_t row = (size_t)(b * SEQ + (kr + 1) * 64 + skey) * 512 + h * 64 + 8 * sch; nk = *(const u32x4*)(Kb + row); nv = *(const u32x4*)(Vb + row); }
                if (kr >= rs && kr < rs + 8) {
                    const LAS unsigned char* brow = (const LAS unsigned char*)(rpbL + (kr - r + 7) * 32);
                    f32x16 s;
#pragma unroll
                    for (int i = 0; i < 16; ++i) s[i] = *(const LAS float*)(brow + dco[i]);
                    const LAS unsigned char* kp = lds + slot + g * 4096 + ql * 128; const LAS unsigned char* vb = lds + slot + 8192 + g * 4096 + (4 * hl + vq) * 128 + vcol;
                    ATT_TILE(kp, vb, 2048, 1024, qrot);
                }
                if (more) { const int ns = ATT_RING_OFF + ((st + 1) & 1) * 16384; ATT_PUT(ns, st + 1, nk, nv); }
                __syncthreads();
            }
#pragma unroll 1
            for (int x = 0; x < 2; ++x) {
                const int cb = g == 0 ? 8 : 0, krel0 = rs + 4 * x - kmin;
                f32x16 s;
#pragma unroll
                for (int i = 0; i < 16; ++i) { const int kc = 24 + cb + (i & 3) + 4 * hl, dr = rs + 4 * x + (i >> 2) - r + 7; const bool ok = kc >= cstart && kc < cstart + 16;
                    s[i] = ok ? rpbL[dr * 32 + (kc - cq + 15)] : -1e30f; }
                const LAS unsigned char* kp = lds + ATT_SK_OFF + ((krel0 + (ql >> 3)) * 16 + cb + (ql & 7)) * 128;
                const LAS unsigned char* vb = lds + ATT_SV_OFF + (krel0 * 16 + cb + 4 * hl + vq) * 128 + vcol;
                ATT_TILE(kp, vb, 4096, 2048, qrot);
            }
            __syncthreads();
#pragma unroll 1
            for (int ct = 0; ct < 8; ++ct) { f32x16 s;
#pragma unroll
                for (int i = 0; i < 16; ++i) s[i] = 0.f;
                const LAS unsigned char* kp = lds + ATT_CK_OFF + ct * 4096 + ql * 128; const LAS unsigned char* vb = lds + ATT_CV_OFF + ct * 4096 + (4 * hl + vq) * 128 + vcol;
                ATT_TILE(kp, vb, 2048, 1024, qplain); }
#undef ATT_TILE
#undef ATT_PUT
            l = half_sum(l);
            const float il = 1.0f / l;
#pragma unroll
            for (int dt = 0; dt < 2; ++dt)
#pragma unroll
                for (int g4 = 0; g4 < 4; ++g4) { u32x2 w;
                    if (dt == 0) { w.x = pk2(o0[4 * g4] * il, o0[4 * g4 + 1] * il); w.y = pk2(o0[4 * g4 + 2] * il, o0[4 * g4 + 3] * il); }
                    else { w.x = pk2(o1[4 * g4] * il, o1[4 * g4 + 1] * il); w.y = pk2(o1[4 * g4 + 2] * il, o1[4 * g4 + 3] * il); }
                    *(u32x2*)(op + 32 * dt + 8 * g4 + 4 * hl) = w; }
        }
    }
}

constexpr int LRU_WLDS = 8192;
constexpr int LRU_TILES = 72;
__device__ __forceinline__ void lru_conv_frags(const bf16_t* LX, const LAS float* cw, size_t rowbase, int L, int s0, int n, int lane, bf16x8 (&afr)[8], bf16_t* XC) {
    const int token = lane & 31, hl = lane >> 5, s = s0 + token;
    const bool v0 = s >= 2, v1 = s >= 1, v3 = s + 1 < L;
    const bf16_t* rp = LX + (rowbase + s) * 1024 + n * 128 + 8 * hl;
    const bf16_t* r0 = v0 ? rp - 2048 : rp; const bf16_t* r1 = v1 ? rp - 1024 : rp; const bf16_t* r3 = v3 ? rp + 1024 : rp;
    u32x4 xr[2][2][4];
#define LRU_LDPAIR(pp, buf) do { _Pragma("unroll") for (int q = 0; q < 2; ++q) { const int co = 16 * (2 * (pp) + q); \
        xr[buf][q][0] = *(const u32x4*)(r0 + co); xr[buf][q][1] = *(const u32x4*)(r1 + co); xr[buf][q][2] = *(const u32x4*)(rp + co); xr[buf][q][3] = *(const u32x4*)(r3 + co); } } while (0)
    LRU_LDPAIR(0, 0);
#pragma unroll
    for (int pp = 0; pp < 4; ++pp) {
        if (pp < 3) LRU_LDPAIR(pp + 1, (pp + 1) & 1);
        __builtin_amdgcn_sched_barrier(0);
#pragma unroll
        for (int q = 0; q < 2; ++q) { const int chl = 16 * (2 * pp + q) + 8 * hl;
            float acc[8];
            { const f32x4 b0 = *(const LAS f32x4*)(cw + 512 + chl), b1 = *(const LAS f32x4*)(cw + 512 + chl + 4); acc[0] = b0.x; acc[1] = b0.y; acc[2] = b0.z; acc[3] = b0.w; acc[4] = b1.x; acc[5] = b1.y; acc[6] = b1.z; acc[7] = b1.w; }
#pragma unroll
            for (int j = 0; j < 4; ++j) { u32x4 raw = xr[pp & 1][q][j]; const bool ok = j == 0 ? v0 : j == 1 ? v1 : j == 3 ? v3 : true;
                if (j != 2) { raw.x = ok ? raw.x : 0u; raw.y = ok ? raw.y : 0u; raw.z = ok ? raw.z : 0u; raw.w = ok ? raw.w : 0u; }
                float xv[8]; unpack8(raw, xv);
                const f32x4 w0 = *(const LAS f32x4*)(cw + j * 128 + chl), w1 = *(const LAS f32x4*)(cw + j * 128 + chl + 4);
                acc[0] += w0.x * xv[0]; acc[1] += w0.y * xv[1]; acc[2] += w0.z * xv[2]; acc[3] += w0.w * xv[3]; acc[4] += w1.x * xv[4]; acc[5] += w1.y * xv[5]; acc[6] += w1.z * xv[6]; acc[7] += w1.w * xv[7]; }
            const u32x4 pk = pack8(acc); afr[2 * pp + q] = __builtin_bit_cast(bf16x8, pk);
            if (XC) *(u32x4*)(XC + (rowbase + s) * 1024 + n * 128 + chl) = pk; }
        __builtin_amdgcn_sched_barrier(0);
    }
#undef LRU_LDPAIR
}
template <int DIR>
__device__ __forceinline__ void lru_group_dir(const f32x16& accr, const f32x16& acci, const f32x16& xv, float bav, float bxv, float sp, float hin0, int hl, float (&hloc)[16], float& At, float& Ht) {
    float er[16], ei[16], av[16], uv[16];
#pragma unroll
    for (int i = 0; i < 16; ++i) { er[i] = __builtin_amdgcn_exp2f(accr[i] + bav); ei[i] = __builtin_amdgcn_exp2f(acci[i] + bxv); }
    __builtin_amdgcn_sched_barrier(0);
#pragma unroll
    for (int i = 0; i < 16; ++i) { er[i] = __builtin_amdgcn_rcpf(1.0f + er[i]); ei[i] = __builtin_amdgcn_rcpf(1.0f + ei[i]); }
    __builtin_amdgcn_sched_barrier(0);
#pragma unroll
    for (int i = 0; i < 16; ++i) { av[i] = __builtin_amdgcn_exp2f(er[i] * sp); ei[i] *= xv[i]; }
    __builtin_amdgcn_sched_barrier(0);
#pragma unroll
    for (int i = 0; i < 16; ++i) uv[i] = __builtin_amdgcn_sqrtf(__builtin_fmaf(-av[i], av[i], 1.0f));
    __builtin_amdgcn_sched_barrier(0);
#pragma unroll
    for (int i = 0; i < 16; ++i) uv[i] *= ei[i];
    __builtin_amdgcn_sched_barrier(0);
    float aloc[16], As[4], Hs[4];
#pragma unroll
    for (int g = 0; g < 4; ++g) { float h = 0.f, A = 1.f;
#pragma unroll
        for (int ee = 0; ee < 4; ++ee) { const int e4 = DIR == 0 ? ee : 3 - ee, i = 4 * g + e4;
            h = av[i] * h + uv[i]; A *= av[i]; hloc[i] = h; aloc[i] = A; }
        As[g] = A; Hs[g] = h; }
    float Alo[4], Ahi[4], Hlo[4], Hhi[4];
#pragma unroll
    for (int g = 0; g < 4; ++g) { const auto ra = __builtin_amdgcn_permlane32_swap(__float_as_uint(As[g]), __float_as_uint(As[g]), false, false); Alo[g] = __uint_as_float(ra[0]); Ahi[g] = __uint_as_float(ra[1]);
        const auto rh = __builtin_amdgcn_permlane32_swap(__float_as_uint(Hs[g]), __float_as_uint(Hs[g]), false, false); Hlo[g] = __uint_as_float(rh[0]); Hhi[g] = __uint_as_float(rh[1]); }
    float hin[4]; float st = hin0, Ap = 1.f, st0 = 0.f;
#pragma unroll
    for (int gg = 0; gg < 4; ++gg) { const int g = DIR == 0 ? gg : 3 - gg;
        const float A1 = DIR == 0 ? Alo[g] : Ahi[g], H1 = DIR == 0 ? Hlo[g] : Hhi[g], A2 = DIR == 0 ? Ahi[g] : Alo[g], H2 = DIR == 0 ? Hhi[g] : Hlo[g];
        const float in1 = st; st = A1 * st + H1; st0 = A1 * st0 + H1; const float in2 = st; st = A2 * st + H2; st0 = A2 * st0 + H2; Ap *= A1 * A2;
        hin[g] = (DIR == 0) == (hl == 0) ? in1 : in2; }
    At = Ap; Ht = st0;
#pragma unroll
    for (int i = 0; i < 16; ++i) hloc[i] += aloc[i] * hin[i >> 2];
}
constexpr int LRU_CONST_OFF = 131072;
template <int MODE>
__device__ __forceinline__ void p_lru(const bf16_t* LX, const bf16_t* LW, const float* conv_w, const float* conv_b, const float* ba, const float* bx, const float* SP, f32x2* AGG, bf16_t* XC, const bf16_t* LG, bf16_t* OL,
                                      LAS unsigned char* lds, int wave, int lane) {
    constexpr int abl = 0;
    const int G = gridDim.x, n = blockIdx.x & 7, ql = lane & 31, hl = lane >> 5, tid = wave * 64 + lane;
    LAS float* cst = (LAS float*)(lds + LRU_CONST_OFF);
    {
        u32x4 t[16]; float cv[2], cq[2];
#pragma unroll
        for (int it = 0; it < 16; ++it) { const int idx = tid + it * NTHREADS, dir = idx >> 12, j = (idx >> 4) & 255, c = idx & 15; t[it] = *(const u32x4*)(LW + ((size_t)(dir * 8 + n) * 256 + j) * 128 + 8 * c); }
#pragma unroll
        for (int it = 0; it < 2; ++it) { const int idx = tid + it * NTHREADS, dir = idx / 384, w = (idx / 128) % 3, c = idx & 127; const float* src = w == 0 ? ba : w == 1 ? bx : SP; cv[it] = 0.f;
            if (idx < 2 * 3 * 128) cv[it] = src[dir * 1024 + n * 128 + c] * (w == 2 ? -8.0f * 1.4426950408889634f : -1.4426950408889634f); }
#pragma unroll
        for (int it = 0; it < 2; ++it) { const int idx = tid + it * NTHREADS; cq[it] = 0.f; if (MODE == 1 && idx < 640) cq[it] = idx < 512 ? conv_w[(idx >> 7) * 1024 + n * 128 + (idx & 127)] : conv_b[n * 128 + (idx & 127)]; }
#pragma unroll
        for (int it = 0; it < 16; ++it) { const int idx = tid + it * NTHREADS, dir = idx >> 12, j = (idx >> 4) & 255, c = idx & 15; *(LAS u32x4*)(lds + (dir * 256 + j) * 256 + ((c ^ (j & 15)) * 16)) = t[it]; }
#pragma unroll
        for (int it = 0; it < 2; ++it) { const int idx = tid + it * NTHREADS; if (MODE == 1 && idx < 640) cst[768 + idx] = cq[it]; }
#pragma unroll
        for (int it = 0; it < 2; ++it) { const int idx = tid + it * NTHREADS; if (idx < 2 * 3 * 128) cst[idx] = cv[it]; }
    }
    __syncthreads();
    const int tiles_per_b = MODE == 1 ? LRU_TILES : 64, nq = 16 * tiles_per_b, stride = (G >> 3) * NWAVES;
    for (int q = (blockIdx.x >> 3) * NWAVES + wave; q < nq; q += stride) {
        const int b = q / tiles_per_b, tile = MODE == 1 ? q % tiles_per_b : 8 + q % tiles_per_b;
        const size_t rowbase = tile < 8 ? (size_t)(TL + b * CTXL) : (size_t)b * SEQ; const int L = tile < 8 ? CTXL : SEQ, s0 = tile < 8 ? tile * 32 : (tile - 8) * 32;
        bf16x8 afr[8];
        if (MODE == 1) lru_conv_frags(LX, cst + 768, rowbase, L, s0, n, lane, afr, XC);
        else {
#pragma unroll
            for (int ks = 0; ks < 8; ++ks) afr[ks] = *(const bf16x8*)(XC + (abl == 4 ? (size_t)ql * 1024 : (rowbase + s0 + ql) * 1024 + n * 128) + 16 * ks + 8 * hl); }
#pragma unroll 1
        for (int cg = 0; cg < 4; ++cg) {
            const bf16x8 ax0 = cg == 0 ? afr[0] : cg == 1 ? afr[2] : cg == 2 ? afr[4] : afr[6], ax1 = cg == 0 ? afr[1] : cg == 1 ? afr[3] : cg == 2 ? afr[5] : afr[7];
            const int cl = cg * 32 + ql;
            float hinf = 0.f, hinb = 0.f;
            if (MODE == 2) { hinf = AGG[((size_t)b * LRU_TILES + tile) * 1024 + n * 128 + cl].x; hinb = AGG[((size_t)(16 + b) * LRU_TILES + tile) * 1024 + n * 128 + cl].x; }
            unsigned short gq[16];
            if (MODE == 2) {
#pragma unroll
                for (int i = 0; i < 16; ++i) gq[i] = LG[(rowbase + s0 + (i & 3) + 8 * (i >> 2) + 4 * hl) * 1024 + n * 128 + cl];
                __builtin_amdgcn_sched_barrier(0); }
            f32x16 xv;
#pragma unroll
            for (int i = 0; i < 16; ++i) xv[i] = 0.f;
            { bf16x8 idf[2];
#pragma unroll
              for (int kk = 0; kk < 2; ++kk)
#pragma unroll
                  for (int j = 0; j < 8; ++j) idf[kk][j] = (16 * kk + 8 * hl + j == ql) ? (short)0x3F80 : (short)0;
              xv = __builtin_amdgcn_mfma_f32_32x32x16_bf16(ax0, idf[0], xv, 0, 0, 0); xv = __builtin_amdgcn_mfma_f32_32x32x16_bf16(ax1, idf[1], xv, 0, 0, 0); }
            float hsum[16];
#pragma unroll
            for (int dir = 0; dir < 2; ++dir) {
                const LAS unsigned char* wr = lds + (dir * 256 + cl) * 256; const LAS unsigned char* wi = wr + 128 * 256;
                f32x16 accr, acci;
#pragma unroll
                for (int i = 0; i < 16; ++i) { accr[i] = 0.f; acci[i] = 0.f; }
                if (abl != 2) { bf16x8 bw[8];
#pragma unroll
                  for (int k = 0; k < 8; ++k) bw[k] = *(const LAS bf16x8*)(wr + (((2 * k + hl) ^ (cl & 15)) * 16));
#pragma unroll
                  for (int k = 0; k < 8; ++k) accr = __builtin_amdgcn_mfma_f32_32x32x16_bf16(afr[k], bw[k], accr, 0, 0, 0);
                  __builtin_amdgcn_sched_barrier(0);
#pragma unroll
                  for (int k = 0; k < 8; ++k) bw[k] = *(const LAS bf16x8*)(wi + (((2 * k + hl) ^ (cl & 15)) * 16));
#pragma unroll
                  for (int k = 0; k < 8; ++k) acci = __builtin_amdgcn_mfma_f32_32x32x16_bf16(afr[k], bw[k], acci, 0, 0, 0); }
                __builtin_amdgcn_sched_barrier(0);
                const float bav = cst[dir * 384 + cl], bxv = cst[dir * 384 + 128 + cl], sp = cst[dir * 384 + 256 + cl];
                const float hin0 = dir == 0 ? hinf : hinb;
                float hout[16], At, Ht;
                if (abl == 1) { _Pragma("unroll") for (int i = 0; i < 16; ++i) hout[i] = accr[i] + acci[i] * xv[i] + hin0 + bav + bxv + sp; At = 1.f; Ht = 0.f; }
                else if (dir == 0) lru_group_dir<0>(accr, acci, xv, bav, bxv, sp, hin0, hl, hout, At, Ht);
                else lru_group_dir<1>(accr, acci, xv, bav, bxv, sp, hin0, hl, hout, At, Ht);
                if (MODE == 1) { if (hl == 0) AGG[((size_t)(dir * 16 + b) * LRU_TILES + tile) * 1024 + n * 128 + cl] = (f32x2){At, Ht}; }
                else {
#pragma unroll
                    for (int i = 0; i < 16; ++i) hsum[i] = dir == 0 ? hout[i] : hsum[i] + hout[i]; }
            }
            if (MODE == 2) {
                if (abl == 3) { float t_ = 0.f; _Pragma("unroll") for (int i = 0; i < 16; ++i) t_ += hsum[i]; if (t_ == 123.456f) OL[0] = 0; }
                else {
#pragma unroll
                for (int i = 0; i < 16; ++i) OL[(rowbase + s0 + (i & 3) + 8 * (i >> 2) + 4 * hl) * 1024 + n * 128 + cl] = (bf16_t)f2bf(hsum[i] * bf2f(gq[i]));
                }
            }
        }
    }
}
__device__ __forceinline__ void p_lru_carry(f32x2* AGG, int tid) {
    const int gid = blockIdx.x * NTHREADS + tid;
    if (gid >= 2 * 16 * 1024) return;
    const int dir = gid >> 14, b = (gid >> 10) & 15, ch = gid & 1023;
    f32x2* base = AGG + (size_t)(dir * 16 + b) * LRU_TILES * 1024 + ch;
    float h = 0.f;
#pragma unroll 1
    for (int s0 = 0; s0 < LRU_TILES; s0 += 24) {
        f32x2 v[24];
#pragma unroll
        for (int s = 0; s < 24; ++s) { const int st = s0 + s, tile = dir == 0 ? st : (st < 8 ? 7 - st : 79 - st); v[s] = base[(size_t)tile * 1024]; }
#pragma unroll
        for (int s = 0; s < 24; ++s) { const int st = s0 + s, tile = dir == 0 ? st : (st < 8 ? 7 - st : 79 - st); base[(size_t)tile * 1024].x = h; h = v[s].x * h + v[s].y; }
    }
}

constexpr int L2_A_OFF = 65536, L2_CW_OFF = 98304;
__device__ __forceinline__ void p_lru2(const bf16_t* LX, const bf16_t* LW, const float* conv_w, const float* conv_b, const float* ba, const float* bx, const float* SP, u32x4* HB, bf16_t* LG,
                                       LAS unsigned char* lds, int wave, int lane_in) {
    const int G = gridDim.x;
    LAS float* cw = (LAS float*)(lds + L2_CW_OFF);
#define L2_BAR() do { asm volatile("s_waitcnt lgkmcnt(0)" ::: "memory"); __builtin_amdgcn_s_barrier(); asm volatile("" ::: "memory"); } while (0)
    for (int task = blockIdx.x; task < 256; task += G) {
        int lane = lane_in; asm volatile("" : "+v"(lane));
        const int tid = wave * 64 + lane, ql = lane & 31, hl = lane >> 5;
        const int b = task >> 4, n = (task >> 1) & 7, cp = task & 1;
        __syncthreads();
        {
            u32x4 t[8]; float cq[2];
#pragma unroll
            for (int it = 0; it < 8; ++it) { const int idx = tid + it * NTHREADS, w = idx >> 10, r = (idx >> 4) & 63, c = idx & 15; const int j = (r >> 5) * 128 + (2 * cp + (w >> 1)) * 32 + (r & 31);
                t[it] = *(const u32x4*)(LW + ((size_t)((w & 1) * 8 + n) * 256 + j) * 128 + 8 * c); }
#pragma unroll
            for (int it = 0; it < 2; ++it) { const int idx = tid + it * NTHREADS; cq[it] = 0.f; if (idx < 640) cq[it] = idx < 512 ? conv_w[(idx >> 7) * 1024 + n * 128 + (idx & 127)] : conv_b[n * 128 + (idx & 127)]; }
#pragma unroll
            for (int it = 0; it < 8; ++it) { const int idx = tid + it * NTHREADS, w = idx >> 10, r = (idx >> 4) & 63, c = idx & 15; *(LAS u32x4*)(lds + w * 16384 + r * 256 + ((c ^ (r & 15)) * 16)) = t[it]; }
#pragma unroll
            for (int it = 0; it < 2; ++it) { const int idx = tid + it * NTHREADS; if (idx < 640) cw[idx] = cq[it]; }
        }
        __syncthreads();
        if (wave >= 4) {
            const int hw = wave - 4, strm = hw >> 1, half = hw & 1, token = ql;
            u32x4 xa[4][4], xb[4][4]; bool a0 = false, a1 = false, a3 = false, b0 = false, b1 = false, b3 = false;
#define L2_TILE(s_) (strm == 0 ? (s_) : ((s_) < 8 ? 7 - (s_) : 79 - (s_)))
#define L2_LOAD(xr, v0, v1, v3, s_) do { const int tl_ = L2_TILE(s_); const size_t rb_ = tl_ < 8 ? (size_t)(TL + b * CTXL) : (size_t)b * SEQ; const int L_ = tl_ < 8 ? CTXL : SEQ, sa_ = (tl_ < 8 ? tl_ * 32 : (tl_ - 8) * 32) + token; \
                v0 = sa_ >= 2; v1 = sa_ >= 1; v3 = sa_ + 1 < L_; const bf16_t* rp_ = LX + (rb_ + sa_) * 1024 + n * 128 + 64 * half + 8 * hl; \
                const bf16_t* r0_ = v0 ? rp_ - 2048 : rp_; const bf16_t* r1_ = v1 ? rp_ - 1024 : rp_; const bf16_t* r3_ = v3 ? rp_ + 1024 : rp_; \
                _Pragma("unroll") for (int o = 0; o < 4; ++o) { xr[o][0] = *(const u32x4*)(r0_ + 16 * o); xr[o][1] = *(const u32x4*)(r1_ + 16 * o); xr[o][2] = *(const u32x4*)(rp_ + 16 * o); xr[o][3] = *(const u32x4*)(r3_ + 16 * o); } } while (0)
#define L2_CONV(xr, v0, v1, v3, s_) do { LAS unsigned char* At_ = lds + L2_A_OFF + (strm * 2 + ((s_) & 1)) * 8192 + token * 256; \
                _Pragma("unroll") for (int o = 0; o < 4; ++o) { const int chl = 64 * half + 16 * o + 8 * hl; float acc[8]; \
                    { const f32x4 b0_ = *(const LAS f32x4*)(cw + 512 + chl), b1_ = *(const LAS f32x4*)(cw + 512 + chl + 4); acc[0] = b0_.x; acc[1] = b0_.y; acc[2] = b0_.z; acc[3] = b0_.w; acc[4] = b1_.x; acc[5] = b1_.y; acc[6] = b1_.z; acc[7] = b1_.w; } \
                    _Pragma("unroll") for (int j = 0; j < 4; ++j) { u32x4 raw = xr[o][j]; const bool ok = j == 0 ? v0 : j == 1 ? v1 : j == 3 ? v3 : true; \
                        if (j != 2) { raw.x = ok ? raw.x : 0u; raw.y = ok ? raw.y : 0u; raw.z = ok ? raw.z : 0u; raw.w = ok ? raw.w : 0u; } \
                        float xv[8]; unpack8(raw, xv); const f32x4 w0 = *(const LAS f32x4*)(cw + j * 128 + chl), w1 = *(const LAS f32x4*)(cw + j * 128 + chl + 4); \
                        acc[0] += w0.x * xv[0]; acc[1] += w0.y * xv[1]; acc[2] += w0.z * xv[2]; acc[3] += w0.w * xv[3]; acc[4] += w1.x * xv[4]; acc[5] += w1.y * xv[5]; acc[6] += w1.z * xv[6]; acc[7] += w1.w * xv[7]; } \
                    *(LAS u32x4*)(At_ + ((((chl >> 3)) ^ (token & 15)) * 16)) = pack8(acc); __builtin_amdgcn_sched_barrier(0); } } while (0)
            L2_LOAD(xa, a0, a1, a3, 0); L2_CONV(xa, a0, a1, a3, 0); L2_LOAD(xb, b0, b1, b3, 1); L2_LOAD(xa, a0, a1, a3, 2);
            L2_BAR();
#pragma unroll 1
            for (int s = 0; s < 72; s += 2) {
                L2_CONV(xb, b0, b1, b3, s + 1); { const int t3 = min(s + 3, 71); L2_LOAD(xb, b0, b1, b3, t3); }
                L2_BAR();
                L2_CONV(xa, a0, a1, a3, s + 2); { const int t4 = min(s + 4, 71); L2_LOAD(xa, a0, a1, a3, t4); }
                L2_BAR();
            }
#undef L2_TILE
#undef L2_LOAD
#undef L2_CONV
        } else {
            const int cg = 2 * cp + (wave >> 1), dir = wave & 1, cl = cg * 32 + ql;
            const float bav = ba[dir * 1024 + n * 128 + cl] * -1.4426950408889634f, bxv = bx[dir * 1024 + n * 128 + cl] * -1.4426950408889634f, sp = SP[dir * 1024 + n * 128 + cl] * (-8.0f * 1.4426950408889634f);
            const LAS unsigned char* wr = lds + wave * 16384 + ql * 256; const LAS unsigned char* wi = wr + 32 * 256;
            u32x4* hb = HB + ((size_t)((b * 8 + n) * 4 + cg) * 64) * 128 + lane;
            float h = 0.f;
            L2_BAR();
#pragma unroll 1
            for (int s = 0; s < 72; ++s) {
                const int tile = dir == 0 ? s : (s < 8 ? 7 - s : 79 - s), lt = tile - 8;
                const bool second = tile >= 8 && ((dir == 0) == (lt >= 32));
                auto compute = [&](float (&hout)[16]) __attribute__((always_inline)) {
                    const LAS unsigned char* At = lds + L2_A_OFF + (dir * 2 + (s & 1)) * 8192 + ql * 256;
                    bf16x8 afr[8];
#pragma unroll
                    for (int ks = 0; ks < 8; ++ks) afr[ks] = *(const LAS bf16x8*)(At + (((2 * ks + hl) ^ (ql & 15)) * 16));
                    const bf16x8 ax0 = cg == 0 ? afr[0] : cg == 1 ? afr[2] : cg == 2 ? afr[4] : afr[6], ax1 = cg == 0 ? afr[1] : cg == 1 ? afr[3] : cg == 2 ? afr[5] : afr[7];
                    f32x16 xv, accr, acci;
#pragma unroll
                    for (int i = 0; i < 16; ++i) { xv[i] = 0.f; accr[i] = 0.f; acci[i] = 0.f; }
                    { bf16x8 idf[2];
#pragma unroll
                      for (int kk = 0; kk < 2; ++kk)
#pragma unroll
                          for (int j = 0; j < 8; ++j) idf[kk][j] = (16 * kk + 8 * hl + j == ql) ? (short)0x3F80 : (short)0;
                      xv = __builtin_amdgcn_mfma_f32_32x32x16_bf16(ax0, idf[0], xv, 0, 0, 0); xv = __builtin_amdgcn_mfma_f32_32x32x16_bf16(ax1, idf[1], xv, 0, 0, 0); }
#pragma unroll
                    for (int kh = 0; kh < 2; ++kh) { bf16x8 bwr[4], bwi[4];
#pragma unroll
                      for (int k = 0; k < 4; ++k) { bwr[k] = *(const LAS bf16x8*)(wr + (((2 * (4 * kh + k) + hl) ^ (ql & 15)) * 16)); bwi[k] = *(const LAS bf16x8*)(wi + (((2 * (4 * kh + k) + hl) ^ (ql & 15)) * 16)); }
#pragma unroll
                      for (int k = 0; k < 4; ++k) { accr = __builtin_amdgcn_mfma_f32_32x32x16_bf16(afr[4 * kh + k], bwr[k], accr, 0, 0, 0); acci = __builtin_amdgcn_mfma_f32_32x32x16_bf16(afr[4 * kh + k], bwi[k], acci, 0, 0, 0); }
                      __builtin_amdgcn_sched_barrier(0); }
                    float At_, Ht_;
                    if (dir == 0) lru_group_dir<0>(accr, acci, xv, bav, bxv, sp, h, hl, hout, At_, Ht_);
                    else lru_group_dir<1>(accr, acci, xv, bav, bxv, sp, h, hl, hout, At_, Ht_);
                    h = At_ * h + Ht_;
                };
                if (second) {
                    bf16_t* orow = LG + ((size_t)b * SEQ + (size_t)lt * 32 + 4 * hl) * 1024 + n * 128 + cl;
                    const u32x4 hp0 = hb[(size_t)lt * 128], hp1 = hb[(size_t)lt * 128 + 64];
                    unsigned gq[16];
#pragma unroll
                    for (int i = 0; i < 16; ++i) gq[i] = orow[((i & 3) + 8 * (i >> 2)) * 1024];
                    __builtin_amdgcn_sched_barrier(0);
                    float hout[16]; compute(hout);
                    float hp[16]; hp[0] = bflo(hp0.x); hp[1] = bfhi(hp0.x); hp[2] = bflo(hp0.y); hp[3] = bfhi(hp0.y); hp[4] = bflo(hp0.z); hp[5] = bfhi(hp0.z); hp[6] = bflo(hp0.w); hp[7] = bfhi(hp0.w);
                    hp[8] = bflo(hp1.x); hp[9] = bfhi(hp1.x); hp[10] = bflo(hp1.y); hp[11] = bfhi(hp1.y); hp[12] = bflo(hp1.z); hp[13] = bfhi(hp1.z); hp[14] = bflo(hp1.w); hp[15] = bfhi(hp1.w);
#pragma unroll
                    for (int i = 0; i < 16; ++i) orow[((i & 3) + 8 * (i >> 2)) * 1024] = (bf16_t)f2bf((hout[i] + hp[i]) * __uint_as_float(gq[i] << 16));
                } else {
                    float hout[16]; compute(hout);
                    if (tile >= 8) {
                        asm volatile("s_waitcnt vmcnt(0)" ::: "memory");
                        u32x4 w0, w1; w0.x = pk2(hout[0], hout[1]); w0.y = pk2(hout[2], hout[3]); w0.z = pk2(hout[4], hout[5]); w0.w = pk2(hout[6], hout[7]);
                        w1.x = pk2(hout[8], hout[9]); w1.y = pk2(hout[10], hout[11]); w1.z = pk2(hout[12], hout[13]); w1.w = pk2(hout[14], hout[15]);
                        hb[(size_t)lt * 128] = w0; hb[(size_t)lt * 128 + 64] = w1;
                        if (s >= 36) asm volatile("s_waitcnt vmcnt(0)" ::: "memory");
                    }
                }
                L2_BAR();
            }
        }
    }
#undef L2_BAR
}

__device__ __forceinline__ unsigned char* lds_ptr(LAS unsigned char* ldsl, int i) {
    const LAS unsigned* t = (const LAS unsigned*)(ldsl + MISC_OFF + 1024) + 2 * i;
    const unsigned lo = __builtin_amdgcn_readfirstlane(t[0]), hi = __builtin_amdgcn_readfirstlane(t[1]);
    return (unsigned char*)(__attribute__((address_space(1))) unsigned char*)(((unsigned long long)hi << 32) | lo);
}
struct MArgs { const float* in[28]; float* out; unsigned char* ws; int ph_lo, ph_hi, li, extra; };
__global__ void __launch_bounds__(NTHREADS, 2) mega(MArgs a) {
    extern __shared__ __attribute__((aligned(16))) unsigned char lds[];
    const int wave = __builtin_amdgcn_readfirstlane(threadIdx.x >> 6);
#define LANE ((int)__builtin_amdgcn_mbcnt_hi(~0u, __builtin_amdgcn_mbcnt_lo(~0u, 0u)))
#define TID (wave * 64 + LANE)
    const int G = gridDim.x, gw = blockIdx.x * NWAVES + wave, ngw = G * NWAVES;
    LAS unsigned char* ldsl = (LAS unsigned char*)lds;
    volatile LAS unsigned* MISC = (volatile LAS unsigned*)(ldsl + MISC_OFF);
    for (int u = TID; u < (LDS_BYTES - MISC_OFF) / 4; u += NTHREADS) ((LAS unsigned*)(ldsl + MISC_OFF))[u] = 0u;
    __syncthreads();
    { LAS unsigned long long* pt = (LAS unsigned long long*)(ldsl + MISC_OFF + 1024);
      const int tid = TID;
      if (tid < 28) pt[tid] = (unsigned long long)a.in[tid];
      if (tid == 28) pt[28] = (unsigned long long)(a.extra ? (float*)(a.ws + WS_XB) : a.out);
      if (tid == 29) pt[29] = (unsigned long long)a.ws; }
    XcdBarrier bar = xcd_barrier_post((unsigned*)(a.ws + WS_CTL) + CW_BAR + a.li * XCD_BAR_WORDS, MISC + 8, wave == 0 && LANE == 0);
    const int lo = a.ph_lo, hi = a.ph_hi, extra = a.extra;
    __syncthreads();
#define PTR(i) ((const float*)lds_ptr(ldsl, (i)))
#define OUTP ((float*)lds_ptr(ldsl, 28))
#define WSP(off) (lds_ptr(ldsl, 29) + (off))
#define IN(k) (lo <= (k) && (k) < hi)
#define SEAM(k) do { if (IN(k) && IN((k) + 1)) xcd_barrier(bar, wave); } while (0)
    if (IN(0)) { unsigned char* ws = WSP(0); p0_prep(ws, ldsl, gw, ngw, LANE, wave); __syncthreads();
        p0_mod(PTR(1), PTR(3), PTR(4), PTR(5), PTR(20), PTR(22), (f32x4*)(ws + WS_MOD + 600 * 1024), PTR(16), (float*)(ws + WS_MOD + 760 * 1024), (float*)(ws + WS_MOD), (f32x2*)(ws + WS_MOD + 512 * 1024), (LAS float*)ldsl, TID); }
    SEAM(0);
    if (IN(1)) { unsigned char* ws = WSP(0); p1_router_tables(PTR(7), (const float*)(ws + WS_MOD), (const f32x4*)(ws + WS_MOD + 600 * 1024), PTR(21), PTR(23), (float*)(ws + WS_RWT), (float*)(ws + WS_RWT + 3 * MiB), gw, ngw, LANE);
        p1_adanorm(PTR(0), PTR(2), PTR(6), (const float*)(ws + WS_MOD), (bf16_t*)OUTP, gw, ngw, LANE); }
    SEAM(1);
    if (IN(2)) { unsigned char* ws = WSP(0); pg8::Gemm g{(const bf16_t*)OUTP, (const bf16_t*)(ws + WS_WIN), TALL, PROJ, 1024}; ProjOrder S; S.init(G, (int)blockIdx.x);
        EpiF<EpiProj> E{{(bf16_t*)(ws + WS_K), (bf16_t*)(ws + WS_V), (bf16_t*)(ws + WS_LX), (bf16_t*)(ws + WS_Q), (bf16_t*)(ws + WS_LG), ws + WS_GA, ws + WS_GB, (const f32x2*)(ws + WS_MOD + 512 * 1024)}};
        pg8::gemm_phase<EpiF<EpiProj>, ProjOrder, true, true>(ldsl, g, S, E, wave); }
    SEAM(2);
    if (IN(3)) { unsigned char* ws = WSP(0);
        p_lru2((const bf16_t*)(ws + WS_LX), (const bf16_t*)(ws + WS_LW), PTR(10), PTR(11), PTR(13), PTR(15), (const float*)(ws + WS_MOD + 760 * 1024), (u32x4*)((unsigned char*)OUTP + 24 * MiB), (bf16_t*)(ws + WS_LG), ldsl, wave, LANE);
        __syncthreads(); }
    if (IN(3) || extra == 2) { unsigned char* ws = WSP(0); bf16_t* Qb = (bf16_t*)(ws + WS_Q);
        p3_attn(Qb, Qb, (const bf16_t*)(ws + WS_K), (const bf16_t*)(ws + WS_V), PTR(9), (const f32x2*)(ws + WS_MOD + 512 * 1024), ldsl, wave, LANE); }
    SEAM(3);
    if (IN(4)) { unsigned char* ws = WSP(0); pg8::Gemm g{(const bf16_t*)(ws + WS_Q), (const bf16_t*)(ws + WS_WA), TL, 1024, 512}; pg8::StaticOrder S; S.init(TL, 1024, G, (int)blockIdx.x); EpiF2<EpiUpAttn> E{{ws + WS_GA, (bf16_t*)(ws + WS_Y)}};
        pg8::gemm_phase<EpiF2<EpiUpAttn>, pg8::StaticOrder, true, true>(ldsl, g, S, E, wave); }
    SEAM(4);
    if (IN(6)) { unsigned char* ws = WSP(0); bf16_t* Yb = (bf16_t*)(ws + WS_Y); pg8::Gemm g{(const bf16_t*)(ws + WS_LG), (const bf16_t*)(ws + WS_WL), TL, 1024, 1024}; pg8::StaticOrder S; S.init(TL, 1024, G, (int)blockIdx.x);
        EpiF2<EpiUpLru> E{{Yb, ws + WS_GB, Yb}};
        pg8::gemm_phase<EpiF2<EpiUpLru>, pg8::StaticOrder, true, true>(ldsl, g, S, E, wave); }
    SEAM(6);
    if (IN(7)) { unsigned char* ws = WSP(0); pg8::Gemm g{(const bf16_t*)(ws + WS_Y), (const bf16_t*)(ws + WS_WO), TL, 1024, 1024}; pg8::StaticOrder S; S.init(TL, 1024, G, (int)blockIdx.x);
        EpiF2<EpiOut> E{{PTR(0), (const float*)(ws + WS_MOD), (bf16_t*)(ws + WS_X1B)}};
        pg8::gemm_phase<EpiF2<EpiOut>, pg8::StaticOrder, true, true>(ldsl, g, S, E, wave); }
    SEAM(7);
    if (IN(8)) { unsigned char* ws = WSP(0);
        p8_route((const bf16_t*)(ws + WS_X1B), (const float*)(ws + WS_RWT), (const float*)(ws + WS_RWT + 3 * MiB), (unsigned*)(ws + WS_CTL), (int*)(ws + WS_TOK), ldsl, LANE, TID, wave); }
    SEAM(8);
    if (IN(9)) { unsigned char* ws = WSP(0); p9_scatter((const bf16_t*)(ws + WS_X1B), PTR(7), (const float*)(ws + WS_MOD), (unsigned*)(ws + WS_CTL), (int*)(ws + WS_TOK), (bf16_t*)(ws + WS_XB), (LAS unsigned*)ldsl, gw, ngw, LANE, TID); }
    SEAM(9);
    if (IN(10)) { unsigned char* ws = WSP(0); pg8::Gemm g{(const bf16_t*)(ws + WS_XB), (const bf16_t*)(ws + WS_W13), MOE_ROWS, 1024, 1024}; MoeOrder S; S.init((const unsigned*)(ws + WS_CTL), G, (int)blockIdx.x, (size_t)1024 * 1024 * 2);
        EpiF<EpiMoe1> E{{(bf16_t*)OUTP}};
        pg8::gemm_phase<EpiF<EpiMoe1>, MoeOrder, true, true>(ldsl, g, S, E, wave); }
    SEAM(10);
    if (IN(11)) { unsigned char* ws = WSP(0); pg8::Gemm g{(const bf16_t*)OUTP, (const bf16_t*)(ws + WS_W2), MOE_ROWS, 1024, 512}; MoeOrder S; S.init((const unsigned*)(ws + WS_CTL), G, (int)blockIdx.x, (size_t)1024 * 512 * 2);
        EpiF<EpiMoe2> E{{(bf16_t*)(ws + WS_YB)}};
        pg8::gemm_phase<EpiF<EpiMoe2>, MoeOrder, true, true>(ldsl, g, S, E, wave); }
    SEAM(11);
    if (IN(12)) { unsigned char* ws = WSP(0); p12_final((const bf16_t*)(ws + WS_X1B), OUTP, (const float*)(ws + WS_MOD), (const int*)(ws + WS_TOK), (const bf16_t*)(ws + WS_YB), PTR(27), gw, ngw, LANE); }
#undef PTR
#undef OUTP
#undef WSP
#undef LANE
#undef TID
#undef IN
#undef SEAM
}

extern "C" void kernel_launch(void* const* d_in, const int* in_sizes, int n_in, void* d_out, int out_size, void* d_ws, size_t ws_size, hipStream_t stream) {
    static int grid = 0;
    if (grid == 0) {
        if (n_in != 28 || out_size != TL * D || ws_size < WS_END) { fprintf(stderr, "kernel_launch: unexpected problem (n_in %d, out %d, ws %zu < %zu)\n", n_in, out_size, ws_size, (size_t)WS_END); grid = -1; return; }
        int dev = 0, cus = 0, per_cu = 0;
        if (hipGetDevice(&dev) != hipSuccess || hipDeviceGetAttribute(&cus, hipDeviceAttributeMultiprocessorCount, dev) != hipSuccess) { grid = -1; return; }
        if (hipFuncSetAttribute((const void*)mega, hipFuncAttributeMaxDynamicSharedMemorySize, LDS_BYTES) != hipSuccess) { fprintf(stderr, "kernel_launch: hipFuncSetAttribute failed\n"); grid = -1; return; }
        if (hipOccupancyMaxActiveBlocksPerMultiprocessor(&per_cu, (const void*)mega, NTHREADS, LDS_BYTES) != hipSuccess || per_cu < 1) { fprintf(stderr, "kernel_launch: occupancy query says %d blocks per CU\n", per_cu); grid = -1; return; }
        (void)hipGetLastError();
        grid = cus;
    }
    if (grid < 0) return;
    const float* const* in = (const float* const*)d_in;
    unsigned char* ws = (unsigned char*)d_ws; float* out = (float*)d_out;
    (void)hipMemsetAsync(ws + WS_CTL, 0, CTL_ZERO_BYTES, stream);
    MArgs a{};
    for (int i = 0; i < 28; ++i) a.in[i] = in[i];
    a.out = out; a.ws = ws;
    auto launch = [&](int lo, int hi, int li, int extra) {
        a.ph_lo = lo; a.ph_hi = hi; a.li = li; a.extra = extra; void* args[] = {&a};
        const hipError_t e = hipLaunchCooperativeKernel((const void*)mega, dim3(grid), dim3(NTHREADS), args, LDS_BYTES, stream);
        if (e != hipSuccess) fprintf(stderr, "kernel_launch: cooperative launch failed: %s (grid %d)\n", hipGetErrorString(e), grid);
    };
    launch(0, 13, 0, 0);
    EXTRA_LAUNCHES
}
```
